# Optimizing an MI355X kernel written in HIP

```python
import math
import jax, jax.numpy as jnp
from jax import lax
import numpy as np

D_MODEL = 1024
BATCH = 4
SEQ = 4096
DEPTH = 4

ATT_Q_HEADS = 8
ATT_KV_HEADS = 2
ATT_HEAD_DIM = 64
WINDOW = 128
ATT_BLOCK = 128
REL_BUCKETS = 32
REL_MAX_DIST = 128
HG_HEADS = 4
HG_DK = 128
HG_DV = 128
HG_CHUNK = 16
ATT_Q_W = ATT_Q_HEADS * ATT_HEAD_DIM
ATT_KV_W = ATT_KV_HEADS * ATT_HEAD_DIM
HG_K_W = HG_HEADS * HG_DK
HG_V_W = HG_HEADS * HG_DV
IN_SPLITS = (ATT_Q_W, ATT_KV_W, ATT_KV_W, HG_K_W, HG_K_W, HG_V_W, HG_V_W, D_MODEL, D_MODEL)
IN_WIDTH = sum(IN_SPLITS)
FFN_DENSE = 2816
N_EXPERTS = 8
TOP_K = 2
FFN_EXPERT = 3584
N_DENSE = (DEPTH + 1) // 2
N_MOE = DEPTH // 2
PLE_DIM = 256
EPS = 1e-6

kernel_name = 'hybrid_swa_hgrn2_moe_ple_trunk'


def _rmsnorm(x, g):
    xf = x.astype(jnp.float32)
    y = xf * lax.rsqrt(jnp.mean(xf * xf, axis=-1, keepdims=True) + EPS)
    return (y * g.astype(jnp.float32)).astype(x.dtype)


def _t5_bucket(dist):
    max_exact = REL_BUCKETS // 2
    d = jnp.maximum(dist, 0)
    large = max_exact + (jnp.log(jnp.maximum(d, 1).astype(jnp.float32) / max_exact)
                         / math.log(REL_MAX_DIST / max_exact)
                         * (REL_BUCKETS - max_exact)).astype(jnp.int32)
    large = jnp.minimum(large, REL_BUCKETS - 1)
    return jnp.where(d < max_exact, d, large)


def _split(z):
    outs = []
    off = 0
    for w in IN_SPLITS:
        outs.append(z[..., off:off + w])
        off += w
    return outs


def _sliding_window_attention(q, k, v, sinks, band_bias):
    B, S = q.shape[0], q.shape[1]
    nb = S // ATT_BLOCK
    G = ATT_Q_HEADS // ATT_KV_HEADS
    qb = q.reshape(B, nb, ATT_BLOCK, ATT_KV_HEADS, G, ATT_HEAD_DIM)

    def band(t):
        tp = jnp.pad(t, ((0, 0), (ATT_BLOCK, 0), (0, 0), (0, 0)))
        tb = tp.reshape(B, nb + 1, ATT_BLOCK, ATT_KV_HEADS, ATT_HEAD_DIM)
        return jnp.concatenate([tb[:, :-1], tb[:, 1:]], axis=2)

    kb, vb = band(k), band(v)
    s = jnp.einsum('bnqhgd,bnkhd->bnhgqk', qb, kb).astype(jnp.float32) * (ATT_HEAD_DIM ** -0.5)
    s = s + band_bias.astype(jnp.float32).reshape(ATT_KV_HEADS, G, ATT_BLOCK, 2 * ATT_BLOCK)
    qi = jnp.arange(ATT_BLOCK)[:, None]
    kj = jnp.arange(2 * ATT_BLOCK)[None, :]
    dist = qi + ATT_BLOCK - kj
    kpos = jnp.arange(nb)[:, None, None] * ATT_BLOCK - ATT_BLOCK + kj
    valid = (dist >= 0) & (dist < WINDOW) & (kpos >= 0)
    s = jnp.where(valid[None, :, None, None], s, -1e30)
    sink = sinks.astype(jnp.float32).reshape(ATT_KV_HEADS, G)[None, None, :, :, None, None]
    m = jnp.maximum(jnp.max(s, axis=-1, keepdims=True), sink)
    pr = jnp.exp(s - m)
    denom = jnp.sum(pr, axis=-1, keepdims=True) + jnp.exp(sink - m)
    pr = (pr / denom).astype(v.dtype)
    o = jnp.einsum('bnhgqk,bnkhd->bnqhgd', pr, vb)
    return o.reshape(B, S, ATT_Q_W)


def _hgrn2(q, f_logit, v, g, lb, norm_g):
    B, S = q.shape[0], q.shape[1]
    nc = S // HG_CHUNK
    dt = q.dtype
    lbh = lb.astype(jnp.float32).reshape(HG_HEADS, HG_DK)
    f = lbh + (1.0 - lbh) * jax.nn.sigmoid(f_logit.astype(jnp.float32))
    log_f = jnp.log(f)
    k = 1.0 - f

    def chunk(t):
        return t.reshape(B, nc, HG_CHUNK, HG_HEADS, t.shape[-1])

    qc, kc, vc = chunk(q.astype(jnp.float32)), chunk(k), chunk(v.astype(jnp.float32))
    A = jnp.cumsum(chunk(log_f), axis=2)
    A_last = A[:, :, -1:]
    q_dec = qc * jnp.exp(A)
    k_in = kc * jnp.exp(-A)
    k_end = kc * jnp.exp(A_last - A)
    causal = jnp.tril(jnp.ones((HG_CHUNK, HG_CHUNK), dtype=bool))
    P = jnp.where(causal, jnp.einsum('bnthd,bnshd->bnhts', q_dec, k_in), 0.0)
    o_intra = jnp.einsum('bnhts,bnshe->bnthe', P, vc)
    decay = jnp.exp(A_last[:, :, 0])

    def step(state, inp):
        qd, ke, vv, a = inp
        o_int = jnp.einsum('bthd,bhde->bthe', qd, state)
        state = a[..., None] * state + jnp.einsum('bshd,bshe->bhde', ke, vv)
        return state, o_int

    s0 = jnp.zeros((B, HG_HEADS, HG_DK, HG_DV), jnp.float32)
    xs = (jnp.moveaxis(q_dec, 1, 0), jnp.moveaxis(k_end, 1, 0),
          jnp.moveaxis(vc, 1, 0), jnp.moveaxis(decay, 1, 0))
    _, o_inter = lax.scan(step, s0, xs)
    o = (o_intra + jnp.moveaxis(o_inter, 0, 1)).reshape(B, S, HG_HEADS, HG_DV)
    o = o * lax.rsqrt(jnp.mean(o * o, axis=-1, keepdims=True) + EPS) * norm_g.astype(jnp.float32)
    o = o.reshape(B, S, HG_V_W) * jax.nn.silu(g.astype(jnp.float32))
    return o.astype(dt)


def _swiglu(u, w1, w3, w2):
    return (jax.nn.silu(u @ w1) * (u @ w3)) @ w2


def _moe(u, router_w, w1, w3, w2):
    logits = (u @ router_w).astype(jnp.float32)
    top_val, top_idx = lax.top_k(logits, TOP_K)
    wts = jax.nn.softmax(top_val, axis=-1)
    gate = jnp.sum(jax.nn.one_hot(top_idx, N_EXPERTS, dtype=jnp.float32) * wts[..., None], axis=-2)
    gate = gate.astype(u.dtype)
    out = jnp.zeros_like(u)
    for e in range(N_EXPERTS):
        out = out + gate[..., e:e + 1] * _swiglu(u, w1[e], w3[e], w2[e])
    return out


def setup_inputs(seed: int = 0) -> dict:
    key = jax.random.key(seed)
    ks = jax.random.split(key, 24)
    f32 = jnp.float32
    nrm = lambda k, shp, s: jax.random.normal(k, shp, f32) * s
    return {
        'x': nrm(ks[0], (BATCH, SEQ, D_MODEL), 1.0),
        'p': nrm(ks[1], (DEPTH, BATCH, SEQ, PLE_DIM), 1.0),
        'w_in': nrm(ks[2], (DEPTH, D_MODEL, IN_WIDTH), D_MODEL ** -0.5),
        'sinks': nrm(ks[3], (DEPTH, ATT_Q_HEADS), 0.5),
        'rel_bias': nrm(ks[4], (REL_BUCKETS, ATT_Q_HEADS), 0.5),
        'lb_logits': nrm(ks[5], (DEPTH, HG_K_W), 1.0),
        'hgrn_norm': 1.0 + nrm(ks[6], (DEPTH, HG_DV), 0.01),
        'w_branch_a': nrm(ks[7], (DEPTH, ATT_Q_W, D_MODEL), ATT_Q_W ** -0.5),
        'w_branch_b': nrm(ks[8], (DEPTH, HG_V_W, D_MODEL), HG_V_W ** -0.5),
        'w_out': nrm(ks[9], (DEPTH, D_MODEL, D_MODEL), D_MODEL ** -0.5),
        'norm_mix': 1.0 + nrm(ks[10], (DEPTH, D_MODEL), 0.01),
        'norm_ffn': 1.0 + nrm(ks[11], (DEPTH, D_MODEL), 0.01),
        'norm_ple': 1.0 + nrm(ks[12], (DEPTH, D_MODEL), 0.01),
        'dense_w1': nrm(ks[13], (N_DENSE, D_MODEL, FFN_DENSE), D_MODEL ** -0.5),
        'dense_w3': nrm(ks[14], (N_DENSE, D_MODEL, FFN_DENSE), D_MODEL ** -0.5),
        'dense_w2': nrm(ks[15], (N_DENSE, FFN_DENSE, D_MODEL), FFN_DENSE ** -0.5),
        'router_w': nrm(ks[16], (N_MOE, D_MODEL, N_EXPERTS), D_MODEL ** -0.5),
        'moe_w1': nrm(ks[17], (N_MOE, N_EXPERTS, D_MODEL, FFN_EXPERT), D_MODEL ** -0.5),
        'moe_w3': nrm(ks[18], (N_MOE, N_EXPERTS, D_MODEL, FFN_EXPERT), D_MODEL ** -0.5),
        'moe_w2': nrm(ks[19], (N_MOE, N_EXPERTS, FFN_EXPERT, D_MODEL), FFN_EXPERT ** -0.5),
        'ple_proj': nrm(ks[20], (DEPTH, PLE_DIM, D_MODEL), PLE_DIM ** -0.5),
        'ple_gate': nrm(ks[21], (DEPTH, D_MODEL, D_MODEL), D_MODEL ** -0.5),
        'final_norm': 1.0 + nrm(ks[22], (D_MODEL,), 0.01),
    }


def reference(x, p, w_in, sinks, rel_bias, lb_logits, hgrn_norm, w_branch_a, w_branch_b,
              w_out, norm_mix, norm_ffn, norm_ple, dense_w1, dense_w3, dense_w2, router_w,
              moe_w1, moe_w3, moe_w2, ple_proj, ple_gate, final_norm):
    B, S = x.shape[0], x.shape[1]
    qi = jnp.arange(ATT_BLOCK)[:, None]
    kj = jnp.arange(2 * ATT_BLOCK)[None, :]
    band_bias = jnp.transpose(rel_bias[_t5_bucket(qi + ATT_BLOCK - kj)], (2, 0, 1))
    sm = jax.nn.softmax(lb_logits.astype(jnp.float32), axis=0)
    lower_bounds = jnp.cumsum(sm, axis=0) - sm[0:1]

    h = x
    for l in range(DEPTH):
        u = _rmsnorm(h, norm_mix[l])
        aq, ak, av, hq, hf, hi, hg, ga, gb = _split(u @ w_in[l])
        ya = _sliding_window_attention(
            aq.reshape(B, S, ATT_Q_HEADS, ATT_HEAD_DIM),
            ak.reshape(B, S, ATT_KV_HEADS, ATT_HEAD_DIM),
            av.reshape(B, S, ATT_KV_HEADS, ATT_HEAD_DIM),
            sinks[l], band_bias) @ w_branch_a[l]
        yb = _hgrn2(
            hq.reshape(B, S, HG_HEADS, HG_DK),
            hf.reshape(B, S, HG_HEADS, HG_DK),
            hi.reshape(B, S, HG_HEADS, HG_DV),
            hg, lower_bounds[l], hgrn_norm[l]) @ w_branch_b[l]
        merged = jax.nn.sigmoid(ga) * ya + jax.nn.sigmoid(gb) * yb
        h = h + merged @ w_out[l]

        u = _rmsnorm(h, norm_ffn[l])
        if l % 2 == 0:
            h = h + _swiglu(u, dense_w1[l // 2], dense_w3[l // 2], dense_w2[l // 2])
        else:
            h = h + _moe(u, router_w[l // 2], moe_w1[l // 2], moe_w3[l // 2], moe_w2[l // 2])

        u = _rmsnorm(h, norm_ple[l])
        h = h + jax.nn.sigmoid(u @ ple_gate[l]) * (p[l] @ ple_proj[l])
    return _rmsnorm(h, final_norm)
```

```cpp
#include <hip/hip_runtime.h>
#include <cstdio>
#include <cstdint>
#include <cmath>
#define DBG_STOP 0
namespace pg8 {
#define PG8_LAS __attribute__((address_space(3)))
typedef unsigned short bf16_t;
typedef short bf16x8 __attribute__((ext_vector_type(8)));
typedef float f32x4 __attribute__((ext_vector_type(4)));
typedef unsigned u32x4 __attribute__((ext_vector_type(4)));
constexpr int BM = 256, BK = 64, HALF = 128, HTB = HALF * BK * 2  , STAGE_BYTES = 8 * HTB, NXCD = 8, WGM = 8;

__host__ __device__ __forceinline__ int lds_byte(int r, int c) { const int st = (r >> 4) * 2 + (c >> 5), rr = r & 15, cc = c & 31, ob = rr * 64 + cc * 2; return st * 1024 + (ob ^ (((ob >> 9) & 1) << 5)); }
__host__ __device__ __forceinline__ void stage_rc(int b, int& R, int& C) { const int st = b / 1024, sb = b % 1024, swz = sb ^ (((sb >> 9) & 1) << 5); R = (st >> 1) * 16 + swz / 64; C = (st & 1) * 32 + (swz % 64) / 2; }
__host__ __device__ __forceinline__ int perm32(int rho) { const int n = rho >> 4, i = rho & 15; return 8 * (i >> 2) + 4 * n + (i & 3); }

struct Unit { int pm, pn; };
struct Gemm { const bf16_t* A; const bf16_t* Bt; int M, N, K; };

struct StaticOrder {
    int nM, nN, nwg, G, c;
    __host__ __device__ void init(int M, int N, int G_, int c_) { nM = M / BM; nN = N / BM; nwg = nM * nN; G = G_; c = c_; }
    __host__ __device__ bool next(int i, Unit& u) const {
        const long L = (long)i * G + c; if (L >= nwg) return false;
        int wgid = (int)L; { const int q = nwg / NXCD, r = nwg % NXCD, xcd = wgid % NXCD, off = wgid / NXCD; wgid = (xcd < r ? xcd * (q + 1) : r * (q + 1) + (xcd - r) * q) + off; }
        const int nig = WGM * nN, gid = wgid / nig, fm = gid * WGM, gsz = (nM - fm) < WGM ? (nM - fm) : WGM;
        u.pm = fm + ((wgid % nig) % gsz); u.pn = (wgid % nig) / gsz; return true;
    }
    __device__ __forceinline__ void a_ready(const Unit&) const {}
    __device__ __forceinline__ void done(const Unit&) const {}
};

__device__ __forceinline__ unsigned cvt_pk_bf16(float lo, float hi) { unsigned r; asm volatile("v_cvt_pk_bf16_f32 %0, %1, %2" : "=v"(r) : "v"(lo), "v"(hi)); return r; }
typedef float f32x2 __attribute__((ext_vector_type(2)));
__device__ __forceinline__ f32x2 gelu_pk(f32x2 v) {
    const f32x2 av = __builtin_elementwise_abs(v), d = av * 0.2316418882f + 1.0f;
    f32x2 t; t.x = __builtin_amdgcn_rcpf(d.x); t.y = __builtin_amdgcn_rcpf(d.y);
    f32x2 q = t * 0.5307027145f + (-0.7265760135f); q = q * t + 0.7107068705f; q = q * t + (-0.142248368f); q = q * t + 0.127414796f; q = q * t;
    const f32x2 s = (v * v) * (-0.72134752044f);
    f32x2 e; e.x = __builtin_amdgcn_exp2f(s.x); e.y = __builtin_amdgcn_exp2f(s.y);
    const f32x2 m = v * (q * e), r = v - m;
    f32x2 o; o.x = v.x < 0.f ? m.x : r.x; o.y = v.y < 0.f ? m.y : r.y; return o;
}

template <int ACT  > struct EpiBf16 {
    static constexpr bool PERM = true, AFTER_DRAIN = false; static_assert(ACT == 0 || ACT == 1, "EpiBf16: ACT is 0 (none) or 1 (gelu_pk)");
    bf16_t* O; int ldc; const float* bias; int split_cols; size_t split_stride; float scale0;
    __device__ __forceinline__ void operator()(const f32x4 (&acc)[2][2][4][2], const Unit& u, int wr, int wc, int fr, int fq) const {
        const int row0 = u.pm * BM + wr * 64 + fr; int colt = u.pn * BM; bf16_t* base = O;
        float sc = 1.f; if (split_cols) { const int t = colt / split_cols; base += (size_t)t * split_stride; colt -= t * split_cols; if (t == 0) sc = scale0; }
        const int col0 = colt + wc * 32 + 8 * fq, bcol0 = u.pn * BM + wc * 32 + 8 * fq;
        f32x4 bv[2][2];
#pragma unroll
        for (int bj = 0; bj < 2; ++bj)
#pragma unroll
            for (int n = 0; n < 2; ++n) bv[bj][n] = bias ? *(const f32x4*)(bias + bcol0 + bj * HALF + 4 * n) : (f32x4){0.f, 0.f, 0.f, 0.f};
#pragma unroll
        for (int ai = 0; ai < 2; ++ai)
#pragma unroll
            for (int m = 0; m < 4; ++m) { bf16_t* rowp = base + (size_t)(row0 + ai * HALF + m * 16) * ldc + col0;
#pragma unroll
                for (int bj = 0; bj < 2; ++bj) { f32x4 v0 = acc[ai][bj][m][0] + bv[bj][0], v1 = acc[ai][bj][m][1] + bv[bj][1];
                    if (ACT == 1) { f32x2 a = gelu_pk((f32x2){v0[0], v0[1]}), b = gelu_pk((f32x2){v0[2], v0[3]}), c = gelu_pk((f32x2){v1[0], v1[1]}), d = gelu_pk((f32x2){v1[2], v1[3]});
                        v0 = (f32x4){a.x, a.y, b.x, b.y}; v1 = (f32x4){c.x, c.y, d.x, d.y}; }
                    v0 = v0 * sc; v1 = v1 * sc; u32x4 w; w.x = cvt_pk_bf16(v0[0], v0[1]); w.y = cvt_pk_bf16(v0[2], v0[3]); w.z = cvt_pk_bf16(v1[0], v1[1]); w.w = cvt_pk_bf16(v1[2], v1[3]);
                    *(u32x4*)(rowp + bj * HALF) = w; } }
    }
};
typedef _Float16 pg8_h8 __attribute__((ext_vector_type(8)));
typedef int pg8_v8i __attribute__((ext_vector_type(8))); typedef int pg8_v4i __attribute__((ext_vector_type(4)));
__device__ __forceinline__ pg8_v8i pg8_ld8(const PG8_LAS unsigned char* p) { const pg8_v4i a = *(const PG8_LAS pg8_v4i*)p, c = *(const PG8_LAS pg8_v4i*)(p + 1024); return __builtin_shufflevector(a, c, 0, 1, 2, 3, 4, 5, 6, 7); }
template <class Epi, class Sched, bool ALIGN_EPI = false, bool SP2 = false, int DT = 0, bool MID = false>
__device__ __forceinline__ void gemm_phase(PG8_LAS unsigned char* lds, const Gemm g, const Sched& S, const Epi& E, int tid_in) {
    constexpr bool FP8 = (DT == 1);
    int tid_o = tid_in; asm volatile("" : "+v"(tid_o));
    const int tid = tid_o, wid = __builtin_amdgcn_readfirstlane(tid >> 6), lane = tid & 63, wr = wid >> 2, wc = wid & 3, fr = lane & 15, fq = lane >> 4;
    const int K = g.K, nt = K / BK;
    unsigned voffA[2], voffB[2];
#pragma unroll
    for (int i = 0; i < 2; ++i) { int R, C; stage_rc(tid * 16 + i * 8192, R, C); const int Rb = Epi::PERM ? ((R & ~31) + perm32(R & 31)) : R;
        voffA[i] = (unsigned)(R * K + C) * 2u; voffB[i] = (unsigned)(Rb * K + C) * 2u; }
    const size_t kstep = (size_t)(BK * 2);
    const size_t hstep = (size_t)HALF * K * 2;
    const size_t tstep = 2 * hstep;
    const unsigned ldsw = (unsigned)wid * 1024u;
    const int aoff = lds_byte(wr * 64 + fr, fq * 8), boff = lds_byte(wc * 32 + fr, fq * 8);
#define PG8_SA(b, h) (((b) * 2 + (h)) * HTB)
#define PG8_SB(b, h) ((4 + (b) * 2 + (h)) * HTB)
#define PG8_STAGE(bufoff, gbase, voff) do { _Pragma("unroll") for (int _i = 0; _i < 2; ++_i) \
        __builtin_amdgcn_global_load_lds((const unsigned*)((const char*)(gbase) + (voff)[_i]), (PG8_LAS unsigned*)(lds + (bufoff) + ldsw + _i * 8192), 16, 0, 0); } while (0)
#define PG8_LDA(dst, b, h) do { if constexpr (FP8) { _Pragma("unroll") for (int m = 0; m < 4; ++m) dst##8[m] = pg8_ld8(lds + PG8_SA(b, h) + aoff + m * 2048); } \
        else { _Pragma("unroll") for (int m = 0; m < 4; ++m) _Pragma("unroll") for (int k = 0; k < 2; ++k) dst[m][k] = *(const PG8_LAS bf16x8*)(lds + PG8_SA(b, h) + aoff + m * 2048 + k * 1024); } } while (0)
#define PG8_LDB(dst, b, h) do { if constexpr (FP8) { _Pragma("unroll") for (int n = 0; n < 2; ++n) dst##8[n] = pg8_ld8(lds + PG8_SB(b, h) + boff + n * 2048); } \
        else { _Pragma("unroll") for (int n = 0; n < 2; ++n) _Pragma("unroll") for (int k = 0; k < 2; ++k) dst[n][k] = *(const PG8_LAS bf16x8*)(lds + PG8_SB(b, h) + boff + n * 2048 + k * 1024); } } while (0)
#define PG8_MMA(ai, bj, At, Bt) do { __builtin_amdgcn_s_setprio(1); _Pragma("unroll") for (int m = 0; m < 4; ++m) _Pragma("unroll") for (int n = 0; n < 2; ++n) { \
        if constexpr (FP8) asm volatile("v_mfma_scale_f32_16x16x128_f8f6f4 %0, %1, %2, %0, %3, %3 op_sel_hi:[0,0,0]" : "+v"(acc[ai][bj][m][n]) : "v"(Bt##8[n]), "v"(At##8[m]), "v"(sc7f));     \
        else { _Pragma("unroll") for (int k = 0; k < 2; ++k) { if constexpr (DT == 2) acc[ai][bj][m][n] = __builtin_amdgcn_mfma_f32_16x16x32_f16(__builtin_bit_cast(pg8_h8, Bt[n][k]), __builtin_bit_cast(pg8_h8, At[m][k]), acc[ai][bj][m][n], 0, 0, 0); \
            else acc[ai][bj][m][n] = __builtin_amdgcn_mfma_f32_16x16x32_bf16(Bt[n][k], At[m][k], acc[ai][bj][m][n], 0, 0, 0); } } } __builtin_amdgcn_s_setprio(0); } while (0)
#define PG8_WAIT_V(n) asm volatile("s_waitcnt vmcnt(" #n ")" ::: "memory")
#define PG8_WAIT_L(n) asm volatile("s_waitcnt lgkmcnt(" #n ")" ::: "memory")
#define PG8_BAR __builtin_amdgcn_s_barrier()
#define PG8_SCHED __builtin_amdgcn_sched_barrier(0)
    Unit cur, nxt; int ui = 0;
    if (!S.next(0, cur)) return;
    f32x4 acc[2][2][4][2];
#pragma unroll
    for (int a = 0; a < 2; ++a)
#pragma unroll
        for (int b = 0; b < 2; ++b)
#pragma unroll
            for (int m = 0; m < 4; ++m)
#pragma unroll
                for (int n = 0; n < 2; ++n) acc[a][b][m][n] = (f32x4){0.f, 0.f, 0.f, 0.f};
    bf16x8 At[4][2], B0[2][2], B1[2][2];
    int sc7f = 0x7F7F7F7F; asm volatile("" : "+v"(sc7f));
    pg8_v8i At8[4], B08[2], B18[2];
    const char* cA = (const char*)g.A + (size_t)cur.pm * tstep; const char* cB = (const char*)g.Bt + (size_t)cur.pn * tstep;
    S.a_ready(cur);
    if constexpr (SP2) {
        PG8_STAGE(PG8_SB(0, 0), cB, voffB); PG8_STAGE(PG8_SB(0, 1), cB + hstep, voffB); PG8_STAGE(PG8_SA(0, 0), cA, voffA); PG8_STAGE(PG8_SA(0, 1), cA + hstep, voffA);
        if (wr == 1) PG8_BAR;
        PG8_WAIT_V(2); PG8_BAR;
        PG8_STAGE(PG8_SB(1, 0), cB + kstep, voffB); PG8_STAGE(PG8_SA(1, 0), cA + kstep, voffA); PG8_STAGE(PG8_SB(1, 1), cB + hstep + kstep, voffB);
        PG8_WAIT_V(6); PG8_BAR;
    } else {
        PG8_STAGE(PG8_SB(0, 0), cB, voffB); PG8_STAGE(PG8_SA(0, 0), cA, voffA); PG8_STAGE(PG8_SB(0, 1), cB + hstep, voffB); PG8_STAGE(PG8_SA(0, 1), cA + hstep, voffA);
        if (wr == 1) PG8_BAR;
        PG8_WAIT_V(4); PG8_BAR;
        PG8_STAGE(PG8_SB(1, 0), cB + kstep, voffB); PG8_STAGE(PG8_SA(1, 0), cA + kstep, voffA); PG8_STAGE(PG8_SB(1, 1), cB + hstep + kstep, voffB);
        PG8_WAIT_V(6); PG8_BAR;
    }
    for (;;) {
        const bool has_next = S.next(ui + 1, nxt);
        const char* nA = has_next ? (const char*)g.A + (size_t)nxt.pm * tstep : cA; const char* nB = has_next ? (const char*)g.Bt + (size_t)nxt.pn * tstep : cB;
        for (int t = 0; t < nt; t += 2) {
            if constexpr (MID) { if (t == (nt >> 1)) E.mid(acc, cur, wr, wc); }
            const bool last = (t == nt - 2);
            const char* a1 = cA + (size_t)(t + 1) * kstep;
            const char* a2 = last ? nA : cA + (size_t)(t + 2) * kstep; const char* b2 = last ? nB : cB + (size_t)(t + 2) * kstep;
            const char* a3 = a2 + kstep; const char* b3 = b2 + kstep;
            if (last && has_next) S.a_ready(nxt);
            if constexpr (SP2) {
            PG8_LDB(B0, 0, 0); PG8_LDB(B1, 0, 1); PG8_SCHED; PG8_LDA(At, 0, 0); PG8_STAGE(PG8_SA(1, 1), a1 + hstep, voffA);
            PG8_WAIT_V(8); PG8_WAIT_L(0); PG8_BAR; PG8_MMA(0, 0, At, B0); PG8_MMA(0, 1, At, B1); PG8_BAR; PG8_SCHED;
            PG8_LDA(At, 0, 1); PG8_STAGE(PG8_SB(0, 0), b2, voffB); PG8_STAGE(PG8_SB(0, 1), b2 + hstep, voffB); PG8_STAGE(PG8_SA(0, 0), a2, voffA);
            PG8_WAIT_V(8); PG8_WAIT_L(0); PG8_BAR; PG8_MMA(1, 0, At, B0); PG8_MMA(1, 1, At, B1); PG8_BAR; PG8_SCHED;
            PG8_LDB(B0, 1, 0); PG8_LDB(B1, 1, 1); PG8_SCHED; PG8_LDA(At, 1, 0); PG8_STAGE(PG8_SA(0, 1), a2 + hstep, voffA);
            PG8_WAIT_V(8); PG8_WAIT_L(0); PG8_BAR; PG8_MMA(0, 0, At, B0); PG8_MMA(0, 1, At, B1); PG8_BAR; PG8_SCHED;
            PG8_LDA(At, 1, 1); PG8_STAGE(PG8_SB(1, 0), b3, voffB); PG8_STAGE(PG8_SB(1, 1), b3 + hstep, voffB); PG8_STAGE(PG8_SA(1, 0), a3, voffA);
            PG8_WAIT_V(8); PG8_WAIT_L(0); PG8_BAR; PG8_MMA(1, 0, At, B0); PG8_MMA(1, 1, At, B1); PG8_BAR; PG8_SCHED;
            } else {
            PG8_LDB(B0, 0, 0); PG8_SCHED; PG8_LDA(At, 0, 0); PG8_STAGE(PG8_SA(1, 1), a1 + hstep, voffA);
            PG8_WAIT_L(8); PG8_BAR; PG8_WAIT_L(0); PG8_MMA(0, 0, At, B0); PG8_BAR; PG8_SCHED;
            PG8_LDB(B1, 0, 1); PG8_STAGE(PG8_SB(0, 0), b2, voffB);
            PG8_BAR; PG8_WAIT_L(0); PG8_MMA(0, 1, At, B1); PG8_BAR;
            PG8_LDA(At, 0, 1); PG8_STAGE(PG8_SA(0, 0), a2, voffA);
            PG8_BAR; PG8_WAIT_L(0); PG8_MMA(1, 0, At, B0); PG8_BAR; PG8_SCHED;
            PG8_STAGE(PG8_SB(0, 1), b2 + hstep, voffB);
            PG8_WAIT_V(6); PG8_BAR; PG8_MMA(1, 1, At, B1); PG8_BAR;
            PG8_LDB(B0, 1, 0); PG8_SCHED; PG8_LDA(At, 1, 0); PG8_STAGE(PG8_SA(0, 1), a2 + hstep, voffA);
            PG8_WAIT_L(8); PG8_BAR; PG8_WAIT_L(0); PG8_MMA(0, 0, At, B0); PG8_BAR; PG8_SCHED;
            PG8_LDB(B1, 1, 1); PG8_STAGE(PG8_SB(1, 0), b3, voffB);
            PG8_BAR; PG8_WAIT_L(0); PG8_MMA(0, 1, At, B1); PG8_BAR;
            PG8_LDA(At, 1, 1); PG8_STAGE(PG8_SA(1, 0), a3, voffA);
            PG8_BAR; PG8_WAIT_L(0); PG8_MMA(1, 0, At, B0); PG8_BAR; PG8_SCHED;
            PG8_STAGE(PG8_SB(1, 1), b3 + hstep, voffB);
            PG8_WAIT_V(6); PG8_BAR; PG8_MMA(1, 1, At, B1); PG8_BAR;
            }
        }
        if constexpr (FP8) asm volatile("s_nop 15\n\ts_nop 15" ::: "memory");
        if constexpr (ALIGN_EPI) { if (wr == 0) PG8_BAR; }
        if constexpr (!Epi::AFTER_DRAIN) { E(acc, cur, wr, wc, fr, fq); S.done(cur); }
        if (!has_next) break;
#pragma unroll
        for (int a = 0; a < 2; ++a)
#pragma unroll
            for (int b = 0; b < 2; ++b)
#pragma unroll
                for (int m = 0; m < 4; ++m)
#pragma unroll
                    for (int n = 0; n < 2; ++n) acc[a][b][m][n] = (f32x4){0.f, 0.f, 0.f, 0.f};
        cur = nxt; cA = nA; cB = nB; ++ui;
        if constexpr (ALIGN_EPI) { if (wr == 1) PG8_BAR; }
    }
    PG8_WAIT_V(0);
    if constexpr (!ALIGN_EPI) { if (wr == 0) PG8_BAR; }
    PG8_BAR;
    if constexpr (Epi::AFTER_DRAIN) { E.fused(acc, cur, wr, wc, fr, fq, lds, wid, lane); S.done(cur); }
#undef PG8_SA
#undef PG8_SB
#undef PG8_STAGE
#undef PG8_LDA
#undef PG8_LDB
#undef PG8_MMA
#undef PG8_WAIT_V
#undef PG8_WAIT_L
#undef PG8_BAR
#undef PG8_SCHED
}
}
namespace pg8 {
typedef unsigned u32x2 __attribute__((ext_vector_type(2)));
typedef float f32x2_t __attribute__((ext_vector_type(2))); typedef __bf16 bf16x2_t __attribute__((ext_vector_type(2)));
__device__ __forceinline__ unsigned cvtpk(float lo, float hi) { f32x2_t v = {lo, hi}; bf16x2_t b = __builtin_convertvector(v, bf16x2_t); return __builtin_bit_cast(unsigned, b); }
__device__ __forceinline__ float bf_lo(unsigned u) { return __uint_as_float(u << 16); }
__device__ __forceinline__ float bf_hi(unsigned u) { return __uint_as_float(u & 0xffff0000u); }
__device__ __forceinline__ float sigm(float x) { return __builtin_amdgcn_rcpf(1.f + __expf(-x)); }
__device__ __forceinline__ float silu(float x) { return x * sigm(x); }
typedef float f32x2v __attribute__((ext_vector_type(2)));
__device__ __forceinline__ f32x4 swiglu4(f32x4 a, f32x4 b, float k1, float k3) {
    const f32x2v a0 = {a[0], a[1]}, a1 = {a[2], a[3]}, b0 = {b[0], b[1]}, b1 = {b[2], b[3]};
    const f32x2v t0 = a0 * k1, t1 = a1 * k1;
    const f32x2v e0 = {__builtin_amdgcn_exp2f(t0[0]), __builtin_amdgcn_exp2f(t0[1])}, e1 = {__builtin_amdgcn_exp2f(t1[0]), __builtin_amdgcn_exp2f(t1[1])};
    const f32x2v d0 = e0 * k3 + k3, d1 = e1 * k3 + k3;
    const f32x2v r0 = {__builtin_amdgcn_rcpf(d0[0]), __builtin_amdgcn_rcpf(d0[1])}, r1 = {__builtin_amdgcn_rcpf(d1[0]), __builtin_amdgcn_rcpf(d1[1])};
    const f32x2v y0 = (a0 * b0) * r0, y1 = (a1 * b1) * r1;
    return (f32x4){y0[0], y0[1], y1[0], y1[1]};
}

template <int ADD> struct EpiGate {
    static constexpr bool PERM = true, AFTER_DRAIN = false;
    bf16_t* O; int ldc; const bf16_t* G; int ldg;
    __device__ __forceinline__ void operator()(const f32x4 (&acc)[2][2][4][2], const Unit& u, int wr, int wc, int fr, int fq) const {
        { int z_ = 0; asm volatile("" : "+v"(z_)); const int l_ = (int)__builtin_amdgcn_mbcnt_hi(~0u, __builtin_amdgcn_mbcnt_lo(~0u, (unsigned)z_)); fr = l_ & 15; fq = l_ >> 4; }
        const int row0 = u.pm * BM + wr * 64 + fr, col0 = u.pn * BM + wc * 32 + 8 * fq;
        u32x4 g[2][2][2], p[2][2][2];
#define EG_LOAD(bt, buf) _Pragma("unroll") for (int mm = 0; mm < 2; ++mm) _Pragma("unroll") for (int bj = 0; bj < 2; ++bj) { const size_t r = (size_t)(row0 + ((bt) >> 1) * HALF + (2 * ((bt) & 1) + mm) * 16); const int c = col0 + bj * HALF; \
            g[buf][mm][bj] = *(const u32x4*)(G + r * ldg + c); if (ADD) p[buf][mm][bj] = *(const u32x4*)(O + r * ldc + c); }
        EG_LOAD(0, 0);
#pragma unroll
        for (int bt = 0; bt < 4; ++bt) { const int buf = bt & 1, ai = bt >> 1, mp = bt & 1;
            if (bt == 0) { EG_LOAD(1, 1); } else if (bt == 1) { EG_LOAD(2, 0); } else if (bt == 2) { EG_LOAD(3, 1); }
#pragma unroll
            for (int mm = 0; mm < 2; ++mm)
#pragma unroll
                for (int bj = 0; bj < 2; ++bj) { const int m = 2 * mp + mm; const size_t r = (size_t)(row0 + ai * HALF + m * 16); const int c = col0 + bj * HALF;
                    const u32x4 gg = g[buf][mm][bj]; f32x4 v0 = acc[ai][bj][m][0], v1 = acc[ai][bj][m][1];
                    v0[0] *= sigm(bf_lo(gg.x)); v0[1] *= sigm(bf_hi(gg.x)); v0[2] *= sigm(bf_lo(gg.y)); v0[3] *= sigm(bf_hi(gg.y));
                    v1[0] *= sigm(bf_lo(gg.z)); v1[1] *= sigm(bf_hi(gg.z)); v1[2] *= sigm(bf_lo(gg.w)); v1[3] *= sigm(bf_hi(gg.w));
                    if (ADD) { const u32x4 pp = p[buf][mm][bj]; v0[0] += bf_lo(pp.x); v0[1] += bf_hi(pp.x); v0[2] += bf_lo(pp.y); v0[3] += bf_hi(pp.y);
                                                      v1[0] += bf_lo(pp.z); v1[1] += bf_hi(pp.z); v1[2] += bf_lo(pp.w); v1[3] += bf_hi(pp.w); }
                    u32x4 w; w.x = cvtpk(v0[0], v0[1]); w.y = cvtpk(v0[2], v0[3]); w.z = cvtpk(v1[0], v1[1]); w.w = cvtpk(v1[2], v1[3]);
                    *(u32x4*)(O + r * ldc + c) = w; }
        }
#undef EG_LOAD
    }
};
struct EpiRes {
    static constexpr bool PERM = false, AFTER_DRAIN = false;
    const float* base; float* out; int ldc;
    __device__ __forceinline__ void operator()(const f32x4 (&acc)[2][2][4][2], const Unit& u, int wr, int wc, int fr, int fq) const {
        const int row0 = u.pm * BM + wr * 64 + fr, col0 = u.pn * BM + wc * 32 + 4 * fq;
#pragma unroll
        for (int ai = 0; ai < 2; ++ai)
#pragma unroll
            for (int m = 0; m < 4; ++m) { const size_t off = (size_t)(row0 + ai * HALF + m * 16) * ldc + col0;
#pragma unroll
                for (int bj = 0; bj < 2; ++bj)
#pragma unroll
                    for (int n = 0; n < 2; ++n) { const f32x4 b = *(const f32x4*)(base + off + bj * HALF + n * 16); *(f32x4*)(out + off + bj * HALF + n * 16) = b + acc[ai][bj][m][n]; } }
    }
};
struct EpiSwiglu {
    static constexpr bool PERM = false, AFTER_DRAIN = false;
    bf16_t* O; int ldc; int nmod;
    __device__ __forceinline__ void operator()(const f32x4 (&acc)[2][2][4][2], const Unit& u, int wr, int wc, int fr, int fq) const {
        const int row0 = u.pm * BM + wr * 64 + fr, hc0 = (u.pn % nmod) * 128 + wc * 16 + 4 * fq;
#pragma unroll
        for (int ai = 0; ai < 2; ++ai)
#pragma unroll
            for (int m = 0; m < 4; ++m) { bf16_t* rowp = O + (size_t)(row0 + ai * HALF + m * 16) * ldc + hc0;
#pragma unroll
                for (int bj = 0; bj < 2; ++bj) { const f32x4 a = acc[ai][bj][m][0], b = acc[ai][bj][m][1];
                    u32x2 w; w.x = cvtpk(silu(a[0]) * b[0], silu(a[1]) * b[1]); w.y = cvtpk(silu(a[2]) * b[2], silu(a[3]) * b[3]);
                    *(u32x2*)(rowp + bj * 64) = w; } }
    }
};
struct EpiSigT {
    static constexpr bool PERM = false, AFTER_DRAIN = false;
    bf16_t* T; int ldc;
    __device__ __forceinline__ void operator()(const f32x4 (&acc)[2][2][4][2], const Unit& u, int wr, int wc, int fr, int fq) const {
        const int row0 = u.pm * BM + wr * 64 + fr, col0 = u.pn * BM + wc * 32 + 4 * fq;
#pragma unroll
        for (int ai = 0; ai < 2; ++ai)
#pragma unroll
            for (int m = 0; m < 4; ++m) { bf16_t* rowp = T + (size_t)(row0 + ai * HALF + m * 16) * ldc + col0;
#pragma unroll
                for (int bj = 0; bj < 2; ++bj)
#pragma unroll
                    for (int n = 0; n < 2; ++n) { const f32x4 a = acc[ai][bj][m][n]; u32x2 w; w.x = cvtpk(sigm(a[0]), sigm(a[1])); w.y = cvtpk(sigm(a[2]), sigm(a[3]));
                        *(u32x2*)(rowp + bj * HALF + n * 16) = w; } }
    }
};
struct EpiPle {
    static constexpr bool PERM = false, AFTER_DRAIN = false;
    const float* base; float* out; const bf16_t* T; int ldc;
    __device__ __forceinline__ void operator()(const f32x4 (&acc)[2][2][4][2], const Unit& u, int wr, int wc, int fr, int fq) const {
        const int row0 = u.pm * BM + wr * 64 + fr, col0 = u.pn * BM + wc * 32 + 4 * fq;
#pragma unroll
        for (int ai = 0; ai < 2; ++ai)
#pragma unroll
            for (int m = 0; m < 4; ++m) { const size_t off = (size_t)(row0 + ai * HALF + m * 16) * ldc + col0;
#pragma unroll
                for (int bj = 0; bj < 2; ++bj)
#pragma unroll
                    for (int n = 0; n < 2; ++n) { const size_t o = off + bj * HALF + n * 16; const u32x2 t = *(const u32x2*)(T + o); const f32x4 b = *(const f32x4*)(base + o); const f32x4 a = acc[ai][bj][m][n];
                        f32x4 r; r[0] = b[0] + bf_lo(t.x) * a[0]; r[1] = b[1] + bf_hi(t.x) * a[1]; r[2] = b[2] + bf_lo(t.y) * a[2]; r[3] = b[3] + bf_hi(t.y) * a[3];
                        *(f32x4*)(out + o) = r; } }
    }
};
struct EpiMoeDown {
    static constexpr bool PERM = true, AFTER_DRAIN = false;
    bf16_t* Y; int ldc; const float* gw; int nmod; float sc;
    __device__ __forceinline__ void operator()(const f32x4 (&acc)[2][2][4][2], const Unit& u, int wr, int wc, int fr, int fq) const {
        const int row0 = u.pm * BM + wr * 64 + fr, col0 = (u.pn % nmod) * BM + wc * 32 + 8 * fq;
#pragma unroll
        for (int ai = 0; ai < 2; ++ai)
#pragma unroll
            for (int m = 0; m < 4; ++m) { const size_t r = (size_t)(row0 + ai * HALF + m * 16); const float s = gw[r] * sc; bf16_t* rowp = Y + r * ldc + col0;
#pragma unroll
                for (int bj = 0; bj < 2; ++bj) { const f32x4 v0 = acc[ai][bj][m][0] * s, v1 = acc[ai][bj][m][1] * s;
                    u32x4 w; w.x = cvtpk(v0[0], v0[1]); w.y = cvtpk(v0[2], v0[3]); w.z = cvtpk(v1[0], v1[1]); w.w = cvtpk(v1[2], v1[3]);
                    *(u32x4*)(rowp + bj * HALF) = w; } }
    }
};

__device__ __forceinline__ float row_rstd(const float* ssp, size_t row) {
    const f32x4* p = (const f32x4*)(ssp + row * 16); const f32x4 a = p[0], b = p[1], c = p[2], d = p[3];
    const float s = (((a[0] + a[1]) + (a[2] + a[3])) + ((b[0] + b[1]) + (b[2] + b[3]))) + (((c[0] + c[1]) + (c[2] + c[3])) + ((d[0] + d[1]) + (d[2] + d[3])));
    return rsqrtf(s * (1.f / 1024.f) + 1e-6f);
}
__device__ __forceinline__ float xor_add(float v, int lane, int o) { return v + __builtin_bit_cast(float, __builtin_amdgcn_ds_bpermute((lane ^ o) << 2, __builtin_bit_cast(int, v))); }
struct EpiZn {
    static constexpr bool PERM = true, AFTER_DRAIN = false;
    bf16_t* O; int ldc; const float* ssp; const PG8_LAS float* tbl; int tpm;
    __device__ __forceinline__ void operator()(const f32x4 (&acc)[2][2][4][2], const Unit& u, int wr, int wc, int fr, int fq) const {
        const int row0 = u.pm * BM + wr * 64 + fr, col0 = u.pn * BM + wc * 32 + 8 * fq;
#pragma unroll
        for (int ai = 0; ai < 2; ++ai)
#pragma unroll
            for (int m = 0; m < 4; ++m) { const size_t r = (size_t)(row0 + ai * HALF + m * 16); const float s = tbl[wr * 64 + fr + ai * HALF + m * 16];     bf16_t* rowp = O + r * ldc + col0;
#pragma unroll
                for (int bj = 0; bj < 2; ++bj) { const f32x4 v0 = acc[ai][bj][m][0] * s, v1 = acc[ai][bj][m][1] * s;
                    u32x4 w; w.x = cvtpk(v0[0], v0[1]); w.y = cvtpk(v0[2], v0[3]); w.z = cvtpk(v1[0], v1[1]); w.w = cvtpk(v1[2], v1[3]);
                    *(u32x4*)(rowp + bj * HALF) = w; } }
    }
};
struct EpiSwigluN {
    static constexpr bool PERM = false, AFTER_DRAIN = false;
    bf16_t* O; int ldc; const float* ssp; const PG8_LAS float* tbl; int tpm;
    __device__ __forceinline__ void operator()(const f32x4 (&acc)[2][2][4][2], const Unit& u, int wr, int wc, int fr, int fq) const {
        const int row0 = u.pm * BM + wr * 64 + fr, hc0 = u.pn * 128 + wc * 16 + 8 * (fq >> 1);
#pragma unroll
        for (int ai = 0; ai < 2; ++ai)
#pragma unroll
            for (int mp = 0; mp < 2; ++mp) { const float s0 = tbl[wr * 64 + fr + ai * HALF + (2 * mp) * 16], s1 = tbl[wr * 64 + fr + ai * HALF + (2 * mp + 1) * 16];
                const float k10 = s0 * -1.44269504f, k30 = __builtin_amdgcn_rcpf(s0 * s0), k11 = s1 * -1.44269504f, k31 = __builtin_amdgcn_rcpf(s1 * s1);
                bf16_t* rowp = O + (size_t)(row0 + ai * HALF + (2 * mp + (fq & 1)) * 16) * ldc + hc0;
#pragma unroll
                for (int bj = 0; bj < 2; ++bj) { const f32x4 y0 = swiglu4(acc[ai][bj][2 * mp][0], acc[ai][bj][2 * mp][1], k10, k30), y1 = swiglu4(acc[ai][bj][2 * mp + 1][0], acc[ai][bj][2 * mp + 1][1], k11, k31);
                    const auto x = __builtin_amdgcn_permlane16_swap(cvtpk(y0[0], y0[1]), cvtpk(y1[0], y1[1]), false, false), y = __builtin_amdgcn_permlane16_swap(cvtpk(y0[2], y0[3]), cvtpk(y1[2], y1[3]), false, false);
                    u32x4 w; w.x = x[0]; w.y = y[0]; w.z = x[1]; w.w = y[1];
                    *(u32x4*)(rowp + bj * 64) = w; } }
    }
};
struct EpiSigTN {
    static constexpr bool PERM = false, AFTER_DRAIN = false;
    bf16_t* T; int ldc; const float* ssp; const PG8_LAS float* tbl; int tpm;
    __device__ __forceinline__ void operator()(const f32x4 (&acc)[2][2][4][2], const Unit& u, int wr, int wc, int fr, int fq) const {
        const int row0 = u.pm * BM + wr * 64 + fr, col0 = u.pn * BM + wc * 32 + 4 * fq;
#pragma unroll
        for (int ai = 0; ai < 2; ++ai)
#pragma unroll
            for (int m = 0; m < 4; ++m) { const size_t r = (size_t)(row0 + ai * HALF + m * 16); const float s = tbl[wr * 64 + fr + ai * HALF + m * 16];     bf16_t* rowp = T + r * ldc + col0;
#pragma unroll
                for (int bj = 0; bj < 2; ++bj)
#pragma unroll
                    for (int n = 0; n < 2; ++n) { const f32x4 a = acc[ai][bj][m][n] * s; u32x2 w; w.x = cvtpk(sigm(a[0]), sigm(a[1])); w.y = cvtpk(sigm(a[2]), sigm(a[3]));
                        *(u32x2*)(rowp + bj * HALF + n * 16) = w; } }
    }
};
struct EpiResSS {
    static constexpr bool PERM = false, AFTER_DRAIN = false;
    const float* base; float* out; bf16_t* hb; float* ssp; int ldc;
    __device__ __forceinline__ void operator()(const f32x4 (&acc)[2][2][4][2], const Unit& u, int wr, int wc, int fr, int fq) const {
        { int z_ = 0; asm volatile("" : "+v"(z_)); const int l_ = (int)__builtin_amdgcn_mbcnt_hi(~0u, __builtin_amdgcn_mbcnt_lo(~0u, (unsigned)z_)); fr = l_ & 15; fq = l_ >> 4; }
        const int row0 = u.pm * BM + wr * 64 + fr, col0 = u.pn * BM + wc * 32 + 4 * fq, lane = fq * 16 + fr;
#pragma unroll
        for (int ai = 0; ai < 2; ++ai)
#pragma unroll
            for (int mp = 0; mp < 2; ++mp) {
                f32x4 bsv[2][2][2];
#pragma unroll
                for (int mm = 0; mm < 2; ++mm)
#pragma unroll
                    for (int bj = 0; bj < 2; ++bj)
#pragma unroll
                        for (int n = 0; n < 2; ++n) bsv[mm][bj][n] = *(const f32x4*)(base + (size_t)(row0 + ai * HALF + (2 * mp + mm) * 16) * ldc + col0 + bj * HALF + n * 16);
#pragma unroll
                for (int mm = 0; mm < 2; ++mm) { const int m = 2 * mp + mm; const size_t r = (size_t)(row0 + ai * HALF + m * 16), off = r * ldc + col0; float ss = 0.f;
#pragma unroll
                    for (int bj = 0; bj < 2; ++bj)
#pragma unroll
                        for (int n = 0; n < 2; ++n) { const size_t o = off + bj * HALF + n * 16; const f32x4 v = bsv[mm][bj][n] + acc[ai][bj][m][n]; *(f32x4*)(out + o) = v;
                            u32x2 w; w.x = cvtpk(v[0], v[1]); w.y = cvtpk(v[2], v[3]); *(u32x2*)(hb + o) = w; ss += (v[0] * v[0] + v[1] * v[1]) + (v[2] * v[2] + v[3] * v[3]); }
                    ss = xor_add(ss, lane, 16); ss = xor_add(ss, lane, 32);
                    if (fq == 0) ssp[r * 16 + (u.pn & 3) * 4 + wc] = ss; }
                asm volatile("" ::: "memory");
            }
    }
};
struct EpiPleSS {
    static constexpr bool PERM = false, AFTER_DRAIN = false;
    const float* base; float* out; const bf16_t* T; bf16_t* hb; float* ssp; int ldc;
    __device__ __forceinline__ void operator()(const f32x4 (&acc)[2][2][4][2], const Unit& u, int wr, int wc, int fr, int fq) const {
        { int z_ = 0; asm volatile("" : "+v"(z_)); const int l_ = (int)__builtin_amdgcn_mbcnt_hi(~0u, __builtin_amdgcn_mbcnt_lo(~0u, (unsigned)z_)); fr = l_ & 15; fq = l_ >> 4; }
        const int row0 = u.pm * BM + wr * 64 + fr, col0 = u.pn * BM + wc * 32 + 4 * fq, lane = fq * 16 + fr;
#pragma unroll
        for (int ai = 0; ai < 2; ++ai)
#pragma unroll
            for (int mp = 0; mp < 2; ++mp) {
                f32x4 bsv[2][2][2]; u32x2 tv[2][2][2];
#pragma unroll
                for (int mm = 0; mm < 2; ++mm)
#pragma unroll
                    for (int bj = 0; bj < 2; ++bj)
#pragma unroll
                        for (int n = 0; n < 2; ++n) { const size_t o = (size_t)(row0 + ai * HALF + (2 * mp + mm) * 16) * ldc + col0 + bj * HALF + n * 16; bsv[mm][bj][n] = *(const f32x4*)(base + o); tv[mm][bj][n] = *(const u32x2*)(T + o); }
#pragma unroll
                for (int mm = 0; mm < 2; ++mm) { const int m = 2 * mp + mm; const size_t r = (size_t)(row0 + ai * HALF + m * 16), off = r * ldc + col0; float ss = 0.f;
#pragma unroll
                    for (int bj = 0; bj < 2; ++bj)
#pragma unroll
                        for (int n = 0; n < 2; ++n) { const size_t o = off + bj * HALF + n * 16; const u32x2 t = tv[mm][bj][n]; const f32x4 b = bsv[mm][bj][n]; const f32x4 a = acc[ai][bj][m][n];
                            f32x4 v; v[0] = b[0] + bf_lo(t.x) * a[0]; v[1] = b[1] + bf_hi(t.x) * a[1]; v[2] = b[2] + bf_lo(t.y) * a[2]; v[3] = b[3] + bf_hi(t.y) * a[3];
                            *(f32x4*)(out + o) = v; u32x2 w; w.x = cvtpk(v[0], v[1]); w.y = cvtpk(v[2], v[3]); *(u32x2*)(hb + o) = w; ss += (v[0] * v[0] + v[1] * v[1]) + (v[2] * v[2] + v[3] * v[3]); }
                    ss = xor_add(ss, lane, 16); ss = xor_add(ss, lane, 32);
                    if (fq == 0) ssp[r * 16 + (u.pn & 3) * 4 + wc] = ss; }
                asm volatile("" ::: "memory");
            }
    }
};

__device__ __forceinline__ unsigned pk4_fp8(float a, float b, float c, float d) { int w = 0; w = __builtin_amdgcn_cvt_pk_fp8_f32(a, b, w, false); w = __builtin_amdgcn_cvt_pk_fp8_f32(c, d, w, true); return (unsigned)w; }
__device__ __forceinline__ u32x4 xpose4(unsigned d0, unsigned d1, unsigned d2, unsigned d3) {
    const auto s01 = __builtin_amdgcn_permlane16_swap(d0, d1, false, false), s23 = __builtin_amdgcn_permlane16_swap(d2, d3, false, false);
    const auto t02 = __builtin_amdgcn_permlane32_swap(s01[0], s23[0], false, false), t13 = __builtin_amdgcn_permlane32_swap(s01[1], s23[1], false, false);
    u32x4 q; q.x = t02[0]; q.y = t13[0]; q.z = t02[1]; q.w = t13[1]; return q;
}
struct EpiSwiglu8 {
    static constexpr bool PERM = false, AFTER_DRAIN = false;
    unsigned char* O; int ldc; int nmod; float sc;
    __device__ __forceinline__ void operator()(const f32x4 (&acc)[2][2][4][2], const Unit& u, int wr, int wc, int fr, int fq) const {
        const int row0 = u.pm * BM + wr * 64 + fr, hc0 = (u.pn % nmod) * 128 + wc * 16;
        const float k1 = sc * -1.44269504f, k3 = 1.f / (4.f * sc * sc);
#pragma unroll
        for (int ai = 0; ai < 2; ++ai)
#pragma unroll
            for (int bj = 0; bj < 2; ++bj) { unsigned d[4];
#pragma unroll
                for (int m = 0; m < 4; ++m) { const f32x4 y = swiglu4(acc[ai][bj][m][0], acc[ai][bj][m][1], k1, k3);
                    d[m] = pk4_fp8(y[0], y[1], y[2], y[3]); }
                const u32x4 q = xpose4(d[0], d[1], d[2], d[3]);
                *(u32x4*)(O + (size_t)(row0 + ai * HALF + 16 * fq) * ldc + hc0 + bj * 64) = q; }
    }
};

struct EpiPleFused {
    static constexpr bool PERM = false, AFTER_DRAIN = false;
    const float* base; float* out; const bf16_t* PP; bf16_t* hb; float* ssp; int ldc; const PG8_LAS float* tbl;
    __device__ __forceinline__ void operator()(const f32x4 (&acc)[2][2][4][2], const Unit& u, int wr, int wc, int fr, int fq) const {
        { int z_ = 0; asm volatile("" : "+v"(z_)); const int l_ = (int)__builtin_amdgcn_mbcnt_hi(~0u, __builtin_amdgcn_mbcnt_lo(~0u, (unsigned)z_)); fr = l_ & 15; fq = l_ >> 4; }
        const int row0 = u.pm * BM + wr * 64 + fr, col0 = u.pn * BM + wc * 32 + 4 * fq, lane = fq * 16 + fr;
#pragma unroll
        for (int ai = 0; ai < 2; ++ai)
#pragma unroll
            for (int mp = 0; mp < 2; ++mp) {
                f32x4 bsv[2][2][2]; u32x2 tv[2][2][2];
#pragma unroll
                for (int mm = 0; mm < 2; ++mm)
#pragma unroll
                    for (int bj = 0; bj < 2; ++bj)
#pragma unroll
                        for (int n = 0; n < 2; ++n) { const size_t o = (size_t)(row0 + ai * HALF + (2 * mp + mm) * 16) * ldc + col0 + bj * HALF + n * 16; bsv[mm][bj][n] = *(const f32x4*)(base + o); tv[mm][bj][n] = *(const u32x2*)(PP + o); }
#pragma unroll
                for (int mm = 0; mm < 2; ++mm) { const int m = 2 * mp + mm; const size_t r = (size_t)(row0 + ai * HALF + m * 16), off = r * ldc + col0; float ss = 0.f;
                    const float rs = tbl[wr * 64 + fr + ai * HALF + m * 16];
#pragma unroll
                    for (int bj = 0; bj < 2; ++bj)
#pragma unroll
                        for (int n = 0; n < 2; ++n) { const size_t o = off + bj * HALF + n * 16; const u32x2 t = tv[mm][bj][n]; const f32x4 b = bsv[mm][bj][n]; const f32x4 a = acc[ai][bj][m][n] * rs;
                            f32x4 v; v[0] = b[0] + bf_lo(t.x) * sigm(a[0]); v[1] = b[1] + bf_hi(t.x) * sigm(a[1]); v[2] = b[2] + bf_lo(t.y) * sigm(a[2]); v[3] = b[3] + bf_hi(t.y) * sigm(a[3]);
                            *(f32x4*)(out + o) = v; u32x2 w; w.x = cvtpk(v[0], v[1]); w.y = cvtpk(v[2], v[3]); *(u32x2*)(hb + o) = w; ss += (v[0] * v[0] + v[1] * v[1]) + (v[2] * v[2] + v[3] * v[3]); }
                    ss = xor_add(ss, lane, 16); ss = xor_add(ss, lane, 32);
                    if (fq == 0) ssp[r * 16 + (u.pn & 3) * 4 + wc] = ss; }
                asm volatile("" ::: "memory");
            }
    }
};
struct SubOrder {
    int j, nsub, n;
    __device__ __forceinline__ bool next(int i, Unit& u) const { if (j < 0) return false; const int L = i * nsub + j; if (L >= n) return false; u.pm = L >> 2; u.pn = L & 3; return true; }
    __device__ __forceinline__ void a_ready(const Unit&) const {}
    __device__ __forceinline__ void done(const Unit&) const {}
};

typedef _Float16 h16x2 __attribute__((ext_vector_type(2)));
__device__ __forceinline__ unsigned pk_f16(float a, float b) { const h16x2 v = {(_Float16)a, (_Float16)b}; return __builtin_bit_cast(unsigned, v); }
__device__ __forceinline__ float f16_lo(unsigned u) { return (float)__builtin_bit_cast(h16x2, u)[0]; }
__device__ __forceinline__ float f16_hi(unsigned u) { return (float)__builtin_bit_cast(h16x2, u)[1]; }
struct EpiResH {
    static constexpr bool PERM = true, AFTER_DRAIN = false;
    const unsigned short* base; unsigned short* out; float* ssp; int ldc; float sc;
    __device__ __forceinline__ void operator()(const f32x4 (&acc)[2][2][4][2], const Unit& u, int wr, int wc, int fr, int fq) const {
        { int z_ = 0; asm volatile("" : "+v"(z_)); const int l_ = (int)__builtin_amdgcn_mbcnt_hi(~0u, __builtin_amdgcn_mbcnt_lo(~0u, (unsigned)z_)); fr = l_ & 15; fq = l_ >> 4; }
        const int row0 = u.pm * BM + wr * 64 + fr, col0 = u.pn * BM + wc * 32 + 8 * fq, lane = fq * 16 + fr;
#pragma unroll
        for (int ai = 0; ai < 2; ++ai)
#pragma unroll
            for (int mp = 0; mp < 2; ++mp) {
                u32x4 bsv[2][2];
#pragma unroll
                for (int mm = 0; mm < 2; ++mm)
#pragma unroll
                    for (int bj = 0; bj < 2; ++bj) bsv[mm][bj] = *(const u32x4*)(base + (size_t)(row0 + ai * HALF + (2 * mp + mm) * 16) * ldc + col0 + bj * HALF);
#pragma unroll
                for (int mm = 0; mm < 2; ++mm) { const int m = 2 * mp + mm; const size_t r = (size_t)(row0 + ai * HALF + m * 16), off = r * ldc + col0; float ss = 0.f;
#pragma unroll
                    for (int bj = 0; bj < 2; ++bj) { const u32x4 b = bsv[mm][bj]; const f32x4 a0 = acc[ai][bj][m][0] * sc, a1 = acc[ai][bj][m][1] * sc;
                        f32x4 v0, v1; v0[0] = f16_lo(b.x) + a0[0]; v0[1] = f16_hi(b.x) + a0[1]; v0[2] = f16_lo(b.y) + a0[2]; v0[3] = f16_hi(b.y) + a0[3];
                        v1[0] = f16_lo(b.z) + a1[0]; v1[1] = f16_hi(b.z) + a1[1]; v1[2] = f16_lo(b.w) + a1[2]; v1[3] = f16_hi(b.w) + a1[3];
                        u32x4 w; w.x = pk_f16(v0[0], v0[1]); w.y = pk_f16(v0[2], v0[3]); w.z = pk_f16(v1[0], v1[1]); w.w = pk_f16(v1[2], v1[3]); *(u32x4*)(out + off + bj * HALF) = w;
                        ss += ((v0[0] * v0[0] + v0[1] * v0[1]) + (v0[2] * v0[2] + v0[3] * v0[3])) + ((v1[0] * v1[0] + v1[1] * v1[1]) + (v1[2] * v1[2] + v1[3] * v1[3])); }
                    ss = xor_add(ss, lane, 16); ss = xor_add(ss, lane, 32);
                    if (fq == 0) ssp[r * 16 + (u.pn & 3) * 4 + wc] = ss; }
                asm volatile("" ::: "memory");
            }
    }
};
struct EpiPleH {
    static constexpr bool PERM = true, AFTER_DRAIN = false;
    const unsigned short* base; unsigned short* out; const bf16_t* PP; float* ssp; int ldc; const PG8_LAS float* tbl;
    __device__ __forceinline__ void operator()(const f32x4 (&acc)[2][2][4][2], const Unit& u, int wr, int wc, int fr, int fq) const {
        { int z_ = 0; asm volatile("" : "+v"(z_)); const int l_ = (int)__builtin_amdgcn_mbcnt_hi(~0u, __builtin_amdgcn_mbcnt_lo(~0u, (unsigned)z_)); fr = l_ & 15; fq = l_ >> 4; }
        const int row0 = u.pm * BM + wr * 64 + fr, col0 = u.pn * BM + wc * 32 + 8 * fq, lane = fq * 16 + fr;
#pragma unroll
        for (int ai = 0; ai < 2; ++ai)
#pragma unroll
            for (int mp = 0; mp < 2; ++mp) {
                u32x4 bsv[2][2], tv[2][2];
#pragma unroll
                for (int mm = 0; mm < 2; ++mm)
#pragma unroll
                    for (int bj = 0; bj < 2; ++bj) { const size_t o = (size_t)(row0 + ai * HALF + (2 * mp + mm) * 16) * ldc + col0 + bj * HALF; bsv[mm][bj] = *(const u32x4*)(base + o); tv[mm][bj] = *(const u32x4*)(PP + o); }
#pragma unroll
                for (int mm = 0; mm < 2; ++mm) { const int m = 2 * mp + mm; const size_t r = (size_t)(row0 + ai * HALF + m * 16), off = r * ldc + col0; float ss = 0.f;
                    const float rs = tbl[wr * 64 + fr + ai * HALF + m * 16];
#pragma unroll
                    for (int bj = 0; bj < 2; ++bj) { const u32x4 t = tv[mm][bj], b = bsv[mm][bj]; const f32x4 a0 = acc[ai][bj][m][0] * rs, a1 = acc[ai][bj][m][1] * rs;
                        f32x4 v0, v1; v0[0] = f16_lo(b.x) + bf_lo(t.x) * sigm(a0[0]); v0[1] = f16_hi(b.x) + bf_hi(t.x) * sigm(a0[1]); v0[2] = f16_lo(b.y) + bf_lo(t.y) * sigm(a0[2]); v0[3] = f16_hi(b.y) + bf_hi(t.y) * sigm(a0[3]);
                        v1[0] = f16_lo(b.z) + bf_lo(t.z) * sigm(a1[0]); v1[1] = f16_hi(b.z) + bf_hi(t.z) * sigm(a1[1]); v1[2] = f16_lo(b.w) + bf_lo(t.w) * sigm(a1[2]); v1[3] = f16_hi(b.w) + bf_hi(t.w) * sigm(a1[3]);
                        u32x4 w; w.x = pk_f16(v0[0], v0[1]); w.y = pk_f16(v0[2], v0[3]); w.z = pk_f16(v1[0], v1[1]); w.w = pk_f16(v1[2], v1[3]); *(u32x4*)(out + off + bj * HALF) = w;
                        ss += ((v0[0] * v0[0] + v0[1] * v0[1]) + (v0[2] * v0[2] + v0[3] * v0[3])) + ((v1[0] * v1[0] + v1[1] * v1[1]) + (v1[2] * v1[2] + v1[3] * v1[3])); }
                    ss = xor_add(ss, lane, 16); ss = xor_add(ss, lane, 32);
                    if (fq == 0) ssp[r * 16 + (u.pn & 3) * 4 + wc] = ss; }
                asm volatile("" ::: "memory");
            }
    }
};

struct EpiBfPlain {
    static constexpr bool PERM = true, AFTER_DRAIN = false;
    bf16_t* O; int ldc;
    __device__ __forceinline__ void operator()(const f32x4 (&acc)[2][2][4][2], const Unit& u, int wr, int wc, int fr, int fq) const {
        { int z_ = 0; asm volatile("" : "+v"(z_)); const int l_ = (int)__builtin_amdgcn_mbcnt_hi(~0u, __builtin_amdgcn_mbcnt_lo(~0u, (unsigned)z_)); fr = l_ & 15; fq = l_ >> 4; }
        const int row0 = u.pm * BM + wr * 64 + fr, col0 = u.pn * BM + wc * 32 + 8 * fq;
#pragma unroll
        for (int ai = 0; ai < 2; ++ai)
#pragma unroll
            for (int m = 0; m < 4; ++m) { bf16_t* rowp = O + (size_t)(row0 + ai * HALF + m * 16) * ldc + col0;
#pragma unroll
                for (int bj = 0; bj < 2; ++bj) { const f32x4 v0 = acc[ai][bj][m][0], v1 = acc[ai][bj][m][1];
                    u32x4 w; w.x = cvtpk(v0[0], v0[1]); w.y = cvtpk(v0[2], v0[3]); w.z = cvtpk(v1[0], v1[1]); w.w = cvtpk(v1[2], v1[3]);
                    *(u32x4*)(rowp + bj * HALF) = w; } }
    }
};

struct EpiZG {
    static constexpr bool PERM = true, AFTER_DRAIN = false;
    bf16_t* O; int ldc; unsigned char* GZ; const PG8_LAS float* tbl;
    __device__ __forceinline__ void operator()(const f32x4 (&acc)[2][2][4][2], const Unit& u, int wr, int wc, int fr, int fq) const {
        const int row0 = u.pm * BM + wr * 64 + fr;
        if (u.pn < 11) { const int col0 = u.pn * BM + wc * 32 + 8 * fq;
#pragma unroll
            for (int ai = 0; ai < 2; ++ai)
#pragma unroll
                for (int m = 0; m < 4; ++m) { const size_t r = (size_t)(row0 + ai * HALF + m * 16); const float s = tbl[wr * 64 + fr + ai * HALF + m * 16]; bf16_t* rowp = O + r * ldc + col0;
#pragma unroll
                    for (int bj = 0; bj < 2; ++bj) { const f32x4 v0 = acc[ai][bj][m][0] * s, v1 = acc[ai][bj][m][1] * s;
                        u32x4 w; w.x = cvtpk(v0[0], v0[1]); w.y = cvtpk(v0[2], v0[3]); w.z = cvtpk(v1[0], v1[1]); w.w = cvtpk(v1[2], v1[3]);
                        *(u32x4*)(rowp + bj * HALF) = w; } }
        } else { const int col0 = (u.pn - 11) * BM + wc * 32 + 16 * (fq >> 1);
#pragma unroll
            for (int ai = 0; ai < 2; ++ai)
#pragma unroll
                for (int mp = 0; mp < 2; ++mp) { unsigned char* rowp = GZ + (size_t)(row0 + ai * HALF + (2 * mp + (fq & 1)) * 16) * 2048 + col0;
#pragma unroll
                    for (int bj = 0; bj < 2; ++bj) { u32x2 wv[2];
#pragma unroll
                        for (int mm = 0; mm < 2; ++mm) { const int m = 2 * mp + mm; const float s = tbl[wr * 64 + fr + ai * HALF + m * 16]; const f32x4 v0 = acc[ai][bj][m][0] * s, v1 = acc[ai][bj][m][1] * s;
                            unsigned q[8];
#pragma unroll
                            for (int i = 0; i < 4; ++i) { q[i] = (unsigned)(sigm(v0[i]) * 255.f + 0.5f); q[4 + i] = (unsigned)(sigm(v1[i]) * 255.f + 0.5f); if (u.pn >= 15) { q[i] = q[i] < 1u ? 1u : q[i]; q[4 + i] = q[4 + i] < 1u ? 1u : q[4 + i]; } }
                            wv[mm].x = q[0] | (q[1] << 8) | (q[2] << 16) | (q[3] << 24); wv[mm].y = q[4] | (q[5] << 8) | (q[6] << 16) | (q[7] << 24); }
                        const auto x = __builtin_amdgcn_permlane16_swap(wv[0].x, wv[1].x, false, false), y = __builtin_amdgcn_permlane16_swap(wv[0].y, wv[1].y, false, false);
                        u32x4 w; w.x = x[0]; w.y = y[0]; w.z = x[1]; w.w = y[1];
                        *(u32x4*)(rowp + bj * HALF) = w; } }
        }
    }
};
template <int ADD> struct EpiGate8 {
    static constexpr bool PERM = true, AFTER_DRAIN = false;
    bf16_t* O; int ldc; const unsigned char* G; int ldg;
    __device__ __forceinline__ void operator()(const f32x4 (&acc)[2][2][4][2], const Unit& u, int wr, int wc, int fr, int fq) const {
        { int z_ = 0; asm volatile("" : "+v"(z_)); const int l_ = (int)__builtin_amdgcn_mbcnt_hi(~0u, __builtin_amdgcn_mbcnt_lo(~0u, (unsigned)z_)); fr = l_ & 15; fq = l_ >> 4; }
        const int row0 = u.pm * BM + wr * 64 + fr, col0 = u.pn * BM + wc * 32 + 8 * fq;
#pragma unroll
        for (int ai = 0; ai < 2; ++ai) {
            u32x2 g[4][2]; u32x4 p[4][2];
#pragma unroll
            for (int m = 0; m < 4; ++m)
#pragma unroll
                for (int bj = 0; bj < 2; ++bj) { const size_t r = (size_t)(row0 + ai * HALF + m * 16); const int c = col0 + bj * HALF;
                    g[m][bj] = *(const u32x2*)(G + r * ldg + c); if (ADD) p[m][bj] = *(const u32x4*)(O + r * ldc + c); }
#pragma unroll
            for (int m = 0; m < 4; ++m)
#pragma unroll
                for (int bj = 0; bj < 2; ++bj) { const size_t r = (size_t)(row0 + ai * HALF + m * 16); const int c = col0 + bj * HALF;
                    const u32x2 gg = g[m][bj]; f32x4 v0 = acc[ai][bj][m][0], v1 = acc[ai][bj][m][1]; const float k = 1.f / 255.f;
                    v0[0] *= (float)(gg.x & 255u) * k; v0[1] *= (float)((gg.x >> 8) & 255u) * k; v0[2] *= (float)((gg.x >> 16) & 255u) * k; v0[3] *= (float)(gg.x >> 24) * k;
                    v1[0] *= (float)(gg.y & 255u) * k; v1[1] *= (float)((gg.y >> 8) & 255u) * k; v1[2] *= (float)((gg.y >> 16) & 255u) * k; v1[3] *= (float)(gg.y >> 24) * k;
                    if (ADD) { const u32x4 pp = p[m][bj]; v0[0] += bf_lo(pp.x); v0[1] += bf_hi(pp.x); v0[2] += bf_lo(pp.y); v0[3] += bf_hi(pp.y);
                                                      v1[0] += bf_lo(pp.z); v1[1] += bf_hi(pp.z); v1[2] += bf_lo(pp.w); v1[3] += bf_hi(pp.w); }
                    u32x4 w; w.x = cvtpk(v0[0], v0[1]); w.y = cvtpk(v0[2], v0[3]); w.z = cvtpk(v1[0], v1[1]); w.w = cvtpk(v1[2], v1[3]);
                    *(u32x4*)(O + r * ldc + c) = w; }
            asm volatile("" ::: "memory");
        }
    }
};

struct EpiGateM {
    static constexpr bool PERM = true, AFTER_DRAIN = false;
    bf16_t* O; int ldc; const unsigned char* G; int ldg;
    __device__ __forceinline__ void mid(f32x4 (&acc)[2][2][4][2], const Unit& u, int wr, int wc) const {
        int fr, fq; { int z_ = 0; asm volatile("" : "+v"(z_)); const int l_ = (int)__builtin_amdgcn_mbcnt_hi(~0u, __builtin_amdgcn_mbcnt_lo(~0u, (unsigned)z_)); fr = l_ & 15; fq = l_ >> 4; }
        const int row0 = u.pm * BM + wr * 64 + fr, col0 = u.pn * BM + wc * 32 + 8 * fq;
#pragma unroll
        for (int ai = 0; ai < 2; ++ai) {
            u32x2 ga[4][2], gb[4][2];
#pragma unroll
            for (int m = 0; m < 4; ++m)
#pragma unroll
                for (int bj = 0; bj < 2; ++bj) { const unsigned char* gp = G + (size_t)(row0 + ai * HALF + m * 16) * ldg + col0 + bj * HALF; ga[m][bj] = *(const u32x2*)gp; gb[m][bj] = *(const u32x2*)(gp + 1024); }
#pragma unroll
            for (int m = 0; m < 4; ++m)
#pragma unroll
                for (int bj = 0; bj < 2; ++bj) { const u32x2 a = ga[m][bj], b = gb[m][bj];
#define GM_R(w, sh) ((float)(((a.w) >> (sh)) & 255u) * __builtin_amdgcn_rcpf((float)(((b.w) >> (sh)) & 255u)))
                    acc[ai][bj][m][0][0] *= GM_R(x, 0); acc[ai][bj][m][0][1] *= GM_R(x, 8); acc[ai][bj][m][0][2] *= GM_R(x, 16); acc[ai][bj][m][0][3] *= GM_R(x, 24);
                    acc[ai][bj][m][1][0] *= GM_R(y, 0); acc[ai][bj][m][1][1] *= GM_R(y, 8); acc[ai][bj][m][1][2] *= GM_R(y, 16); acc[ai][bj][m][1][3] *= GM_R(y, 24);
#undef GM_R
                }
        }
    }
    __device__ __forceinline__ void operator()(const f32x4 (&acc)[2][2][4][2], const Unit& u, int wr, int wc, int fr, int fq) const {
        { int z_ = 0; asm volatile("" : "+v"(z_)); const int l_ = (int)__builtin_amdgcn_mbcnt_hi(~0u, __builtin_amdgcn_mbcnt_lo(~0u, (unsigned)z_)); fr = l_ & 15; fq = l_ >> 4; }
        const int row0 = u.pm * BM + wr * 64 + fr, col0 = u.pn * BM + wc * 32 + 8 * fq;
#pragma unroll
        for (int ai = 0; ai < 2; ++ai) {
            u32x2 gb[4][2];
#pragma unroll
            for (int m = 0; m < 4; ++m)
#pragma unroll
                for (int bj = 0; bj < 2; ++bj) gb[m][bj] = *(const u32x2*)(G + (size_t)(row0 + ai * HALF + m * 16) * ldg + 1024 + col0 + bj * HALF);
#pragma unroll
            for (int m = 0; m < 4; ++m)
#pragma unroll
                for (int bj = 0; bj < 2; ++bj) { const size_t r = (size_t)(row0 + ai * HALF + m * 16); const int c = col0 + bj * HALF; const u32x2 b = gb[m][bj]; const float k = 1.f / 255.f;
                    f32x4 v0 = acc[ai][bj][m][0], v1 = acc[ai][bj][m][1];
                    v0[0] *= (float)(b.x & 255u) * k; v0[1] *= (float)((b.x >> 8) & 255u) * k; v0[2] *= (float)((b.x >> 16) & 255u) * k; v0[3] *= (float)(b.x >> 24) * k;
                    v1[0] *= (float)(b.y & 255u) * k; v1[1] *= (float)((b.y >> 8) & 255u) * k; v1[2] *= (float)((b.y >> 16) & 255u) * k; v1[3] *= (float)(b.y >> 24) * k;
                    u32x4 w; w.x = cvtpk(v0[0], v0[1]); w.y = cvtpk(v0[2], v0[3]); w.z = cvtpk(v1[0], v1[1]); w.w = cvtpk(v1[2], v1[3]);
                    *(u32x4*)(O + r * ldc + c) = w; }
        }
    }
};
}
constexpr int NWAVES = 8;
constexpr int D = 1024, NB = 4, S = 4096, DEPTH = 4, M = NB * S;
constexpr int HQ = 8, HKV = 2, DH = 64, WIN = 128;
constexpr int HGH = 4, DK = 128, DV = 128;
constexpr int INW = 4864;
constexpr int OFF_AQ = 0, OFF_AK = 512, OFF_AV = 640, OFF_HQ = 768, OFF_HF = 1280, OFF_HI = 1792, OFF_HG = 2304, OFF_GA = 2816, OFF_GB = 3840;
constexpr int ZW = 2816;
constexpr int FD = 2816, NE = 8, FE = 3584, PLE = 256;
constexpr float EPS = 1e-6f;
constexpr int MOE_ROWS = 2 * M + NE * 256;

constexpr size_t MiB = 1u << 20;
constexpr size_t WS_CTL = 0, CTL_ZERO_BYTES = 2 * MiB;
constexpr size_t WS_TBL = 2 * MiB;
constexpr size_t WS_H = 6 * MiB, WS_U = 70 * MiB, WS_Z = 102 * MiB, WS_ZT = 254 * MiB;
constexpr size_t WS_OA = 342 * MiB, WS_OB = 358 * MiB, WS_MG = 374 * MiB, WS_AG = 342 * MiB, WS_Y = 410 * MiB, WS_PB = 478 * MiB, WS_W = 510 * MiB;
constexpr size_t WS_GZ = WS_Z + 96 * MiB;
constexpr size_t WS_U2 = WS_H;
constexpr size_t W_IN = WS_W, W_A = WS_W + 38 * MiB, W_B = WS_W + 42 * MiB, W_OUT = WS_W + 46 * MiB, W_PG = WS_W + 54 * MiB, W_PP = WS_W + 62 * MiB,
                 W_13D = WS_W + 64 * MiB, W_2D = WS_W + 86 * MiB, W_13M = WS_W + 97 * MiB, W_2M = WS_W + 321 * MiB, WS_END = WS_W + 433 * MiB;
static_assert((size_t)DEPTH * INW * D * 2 == 38 * MiB && (size_t)2 * NE * 2 * FE * D * 2 == 224 * MiB && (size_t)2 * NE * FE * D * 2 == 112 * MiB && (size_t)2 * 2 * FD * D * 2 == 22 * MiB, "weight map");
static_assert((size_t)MOE_ROWS * FE * 2 <= 240 * MiB && (size_t)MOE_ROWS * D * 2 <= 68 * MiB && (size_t)M * INW * 2 == 152 * MiB, "activation map");
constexpr int CW_TMO = 0, CW_CODE = 1;
constexpr int CW_BAR = 8192, BAR_STRIDE = 4096, MAX_LAUNCH = 120;
static_assert((CW_BAR + MAX_LAUNCH * BAR_STRIDE) * 4 <= (int)CTL_ZERO_BYTES, "CTL words inside the memset region");

constexpr int RING_OFF = 0, RING_BYTES = 131072;
constexpr int LDSCTL_OFF = RING_BYTES, MISC_OFF = LDSCTL_OFF + 320;
constexpr int LDS_BYTES = 147456;
constexpr int RSTD_OFF = LDSCTL_OFF + 1024;

#define GAS __attribute__((address_space(1)))
#define LAS __attribute__((address_space(3)))
typedef unsigned short bf16;
typedef unsigned v4u __attribute__((ext_vector_type(4)));
typedef unsigned v2u __attribute__((ext_vector_type(2)));
typedef float f32x4 __attribute__((ext_vector_type(4)));
typedef short bf16x8 __attribute__((ext_vector_type(8)));
typedef GAS unsigned gu32;
#define RLX_AGENT __ATOMIC_RELAXED, __HIP_MEMORY_SCOPE_AGENT
#define LDS_WAIT() asm volatile("s_waitcnt lgkmcnt(0)" ::: "memory")
#define VM_WAIT() asm volatile("s_waitcnt vmcnt(0)" ::: "memory")
__device__ __forceinline__ unsigned f2bf(float f) { unsigned u = __builtin_bit_cast(unsigned, f); return (u + 0x7fffu + ((u >> 16) & 1u)) >> 16; }
__device__ __forceinline__ unsigned pk2(float lo, float hi) { return f2bf(lo) | (f2bf(hi) << 16); }
__device__ __forceinline__ float bf2f(bf16 b) { return __uint_as_float((unsigned)b << 16); }
#define XB_TMO      128
#define XB_XCNT(j)  (256  + 64 * (j))
#define XB_XSUB(j)  (1280 + 64 * (j))
#define XB_XGEN(j)  (2304 + 64 * (j))
#define XB_TOP      3328
#define XB_TOPGEN   3392
#define XCD_BAR_WORDS 3456
#define XB_SPIN_CAP (1u << 18)

__device__ __forceinline__ unsigned xb_ld(unsigned* p)              { return __hip_atomic_load(p, __ATOMIC_RELAXED, __HIP_MEMORY_SCOPE_AGENT); }
__device__ __forceinline__ unsigned xb_add(unsigned* p, unsigned v) { return __hip_atomic_fetch_add(p, v, __ATOMIC_RELAXED, __HIP_MEMORY_SCOPE_AGENT); }
__device__ __forceinline__ unsigned xb_xcc_id() { return (unsigned)__builtin_amdgcn_s_getreg((3 << 11) | 20) & 0xFu; }
#define XB_SPIN(cond, bar) do { unsigned _sp = 0; while (cond) { __builtin_amdgcn_s_sleep(1); \
    if ((++_sp & 255u) == 0u) { if (xb_ld(&(bar)[XB_TMO])) break; if (_sp > XB_SPIN_CAP) { atomicAdd(&(bar)[XB_TMO], 1u); break; } } } } while (0)

struct XcdBarrier {
    unsigned* bar; unsigned x;
    volatile LAS unsigned* st;
};

__device__ __forceinline__ XcdBarrier xcd_barrier_post(unsigned* bar, volatile LAS unsigned* st) {
    XcdBarrier b; b.bar = bar; b.x = xb_xcc_id(); b.st = st;
    if (threadIdx.x == 0) (void)xb_add(&bar[XB_XCNT(b.x)], 1u);
    return b;
}
__device__ __forceinline__ void xcd_barrier_complete(unsigned* bar, unsigned x, unsigned& nloc, unsigned& nx) {
    const unsigned G = gridDim.x * gridDim.y * gridDim.z;
    unsigned sum, cnt, mine, sp = 0u;
    for (;;) {
        sum = 0u; cnt = 0u; mine = 0u;
#pragma unroll
        for (unsigned j = 0; j < 16; ++j) { const unsigned c = xb_ld(&bar[XB_XCNT(j)]); sum += c; cnt += (c > 0u) ? 1u : 0u; mine = (j == x) ? c : mine; }
        if (sum == G) break;
        __builtin_amdgcn_s_sleep(1);
        if ((++sp & 255u) == 0u) { if (xb_ld(&bar[XB_TMO])) break; if (sp > XB_SPIN_CAP) { atomicAdd(&bar[XB_TMO], 1u); break; } }
    }
    nloc = mine > 0u ? mine : 1u; nx = cnt > 0u ? cnt : 1u;
}

__device__ __forceinline__ void xcd_barrier(const XcdBarrier& b, int tid  ) {
    asm volatile("s_waitcnt vmcnt(0)" ::: "memory");
    __syncthreads();
    if (tid == 0) {
        unsigned* bar = b.bar; unsigned xq = b.x; asm volatile("" : "+s"(xq));
        __builtin_amdgcn_s_waitcnt(0);
        unsigned nloc = b.st[0], nx = b.st[1];
        if (nloc == 0u) { xcd_barrier_complete(bar, xq, nloc, nx); b.st[0] = nloc; b.st[1] = nx; }
        const unsigned old = xb_add(&bar[XB_XSUB(xq)], 1u);
        const unsigned gen = old / nloc;
        if (old + 1u == (gen + 1u) * nloc) {
            __builtin_amdgcn_fence(__ATOMIC_RELEASE, "agent");
            asm volatile("s_waitcnt vmcnt(0)" ::: "memory");
            const unsigned og = xb_add(&bar[XB_TOP], 1u);
            const unsigned tg = og / nx;
            if (og + 1u == (tg + 1u) * nx) xb_add(&bar[XB_TOPGEN], 1u);
            else XB_SPIN(xb_ld(&bar[XB_TOPGEN]) == tg, bar);
            __builtin_amdgcn_fence(__ATOMIC_ACQUIRE, "agent");
            xb_add(&bar[XB_XGEN(xq)], 1u);
            asm volatile("s_waitcnt vmcnt(0)" ::: "memory");
        } else {
            XB_SPIN(xb_ld(&bar[XB_XGEN(xq)]) == gen, bar);
            __builtin_amdgcn_fence(__ATOMIC_ACQUIRE, "agent");
            asm volatile("s_waitcnt vmcnt(0)" ::: "memory");
        }
    }
    __syncthreads();
}
constexpr size_t T_SSP = 1 << 20, T_SSP2 = 2 << 20;
struct Args { const float* in[23]; float* out; unsigned char* ws; int ph_lo, ph_hi, li, pad; };
struct Frame {
    LAS unsigned char* lds;
    volatile LAS unsigned* MISC;
    gu32* ctl;
    int tid, lane, wave;
    int vcu, G;
};
__device__ __forceinline__ float wave_sum_n(float v) {
#pragma unroll
    for (int o = 1; o < 64; o <<= 1) v += __shfl_xor(v, o);
    return v;
}
__device__ __forceinline__ float wave_sum(float v, int lane) {
#pragma unroll
    for (int o = 1; o < 64; o <<= 1) v += __builtin_bit_cast(float, __builtin_amdgcn_ds_bpermute((lane ^ o) << 2, __builtin_bit_cast(int, v)));
    return v;
}
template <int MODE, int KL>
__device__ __forceinline__ void p0_cvt_item(const float* W, int K, int N, unsigned char* WT, int il, int which, int item, int lane, const float* gk, float scale, int ldk, int koff) {
    const int nblk = N >> 6, kb = item / nblk, nb = item - kb * nblk, nq = lane & 15, kr = lane >> 4, k0 = 4 * KL * kb + KL * kr, n0 = 64 * nb + 4 * nq;
    const GAS f32x4* src = (const GAS f32x4*)(W + (size_t)k0 * N + n0);
    f32x4 v[KL];
#pragma unroll
    for (int i = 0; i < KL; ++i) v[i] = src[(size_t)i * (N >> 2)];
    if (MODE == 1) {
#pragma unroll
        for (int q = 0; q < KL / 4; ++q) { const f32x4 g = *(const GAS f32x4*)(gk + k0 + 4 * q); v[4 * q] *= g.x; v[4 * q + 1] *= g.y; v[4 * q + 2] *= g.z; v[4 * q + 3] *= g.w; } }
    if (MODE == 2) {
#pragma unroll
        for (int i = 0; i < KL; ++i) v[i] *= scale; }
#pragma unroll
    for (int c = 0; c < 4; ++c) { const int n = n0 + c, row = il ? ((n >> 4) * 32 + which * 16 + (n & 15)) : n;
        if (MODE == 2) { GAS v4u* dst = (GAS v4u*)(WT + (size_t)row * ldk + koff + k0);
#pragma unroll
            for (int q = 0; q < KL / 16; ++q) { v4u o;
                o.x = pg8::pk4_fp8(v[16 * q][c], v[16 * q + 1][c], v[16 * q + 2][c], v[16 * q + 3][c]);     o.y = pg8::pk4_fp8(v[16 * q + 4][c], v[16 * q + 5][c], v[16 * q + 6][c], v[16 * q + 7][c]);
                o.z = pg8::pk4_fp8(v[16 * q + 8][c], v[16 * q + 9][c], v[16 * q + 10][c], v[16 * q + 11][c]); o.w = pg8::pk4_fp8(v[16 * q + 12][c], v[16 * q + 13][c], v[16 * q + 14][c], v[16 * q + 15][c]);
                dst[q] = o; } }
        else { GAS v4u* dst = (GAS v4u*)(WT + ((size_t)row * ldk + koff + k0) * 2);
#pragma unroll
            for (int q = 0; q < KL / 8; ++q) { v4u o;
                if (MODE == 1) { o.x = pg8::pk_f16(v[8 * q][c], v[8 * q + 1][c]); o.y = pg8::pk_f16(v[8 * q + 2][c], v[8 * q + 3][c]); o.z = pg8::pk_f16(v[8 * q + 4][c], v[8 * q + 5][c]); o.w = pg8::pk_f16(v[8 * q + 6][c], v[8 * q + 7][c]); }
                else { o.x = pk2(v[8 * q][c], v[8 * q + 1][c]); o.y = pk2(v[8 * q + 2][c], v[8 * q + 3][c]); o.z = pk2(v[8 * q + 4][c], v[8 * q + 5][c]); o.w = pk2(v[8 * q + 6][c], v[8 * q + 7][c]); }
                dst[q] = o; } } }
}
constexpr int MT_PER = (D / 128) * (FE / 64), MT_SET = 24 * MT_PER;
constexpr int MT_N1 = 3, MT_N4 = 3, MT_G1 = MT_N1 * 64 * NWAVES, MT_G4 = MT_N4 * 128 * NWAVES, MT_TAIL = 2 * MT_G1 + MT_G4;
static_assert(MT_TAIL <= MT_SET, "tile split");
__device__ __forceinline__ void moe_cvt_tile(const Args& a, int set, int id, int lane) {
    const int j = id / MT_PER, item = id - j * MT_PER;
    if (j < 16) { const int e = set * 8 + (j & 7), wh = j >> 3;
        p0_cvt_item<2, 32>(a.in[17 + wh] + (size_t)e * D * FE, D, FE, a.ws + W_13M + (size_t)e * 2 * FE * D, 1, wh, item, lane, nullptr, 32.f, D, 0); }
    else { const int e = set * 8 + (j - 16); p0_cvt_item<2, 32>(a.in[19] + (size_t)e * FE * D, FE, D, a.ws + W_2M + (size_t)e * D * FE, 0, 0, item, lane, nullptr, 64.f, FE, 0); }
}
__device__ __forceinline__ void rms_row_to_bf16(const float* xrow, const float* g, bf16* orow, int lane) {
    const GAS f32x4* xr = (const GAS f32x4*)xrow + lane; const GAS f32x4* gr = (const GAS f32x4*)g + lane;
    f32x4 v[4]; float s = 0.f;
#pragma unroll
    for (int j = 0; j < 4; ++j) { v[j] = xr[64 * j]; s += (v[j].x * v[j].x + v[j].y * v[j].y) + (v[j].z * v[j].z + v[j].w * v[j].w); }
    const float rstd = rsqrtf(wave_sum(s, lane) * (1.f / D) + EPS);
    GAS v2u* o8 = (GAS v2u*)orow + lane;
#pragma unroll
    for (int j = 0; j < 4; ++j) { const f32x4 gg = gr[64 * j]; v2u w; w.x = pk2(v[j].x * rstd * gg.x, v[j].y * rstd * gg.y); w.y = pk2(v[j].z * rstd * gg.z, v[j].w * rstd * gg.w); o8[64 * j] = w; }
}
__device__ __forceinline__ void rms_row_to_f32(const float* xrow, const float* g, float* orow, int lane) {
    const GAS f32x4* xr = (const GAS f32x4*)xrow + lane; const GAS f32x4* gr = (const GAS f32x4*)g + lane;
    f32x4 v[4]; float s = 0.f;
#pragma unroll
    for (int j = 0; j < 4; ++j) { v[j] = xr[64 * j]; s += (v[j].x * v[j].x + v[j].y * v[j].y) + (v[j].z * v[j].z + v[j].w * v[j].w); }
    const float rstd = rsqrtf(wave_sum(s, lane) * (1.f / D) + EPS);
    GAS f32x4* o = (GAS f32x4*)orow + lane;
#pragma unroll
    for (int j = 0; j < 4; ++j) { const f32x4 gg = gr[64 * j]; o[64 * j] = v[j] * rstd * gg; }
}

__device__ __forceinline__ void p0_prologue(Frame& F, const Args& a) {
    const int gw = F.vcu * NWAVES + F.wave, NGW = F.G * NWAVES;
    unsigned char* ws = a.ws;
    constexpr int I_MP = MT_SET - MT_TAIL;
    constexpr int I_IN = (D / 64) * (INW / 64), I_AB = (512 / 64) * (D / 64), I_SQ = (D / 64) * (D / 64), I_PP = (PLE / 64) * (D / 64), I_D1 = (D / 64) * (FD / 64), I_D2 = (FD / 64) * (D / 64);
    constexpr int NITEMS = 2 * I_MP + 4 * I_IN + 8 * I_AB + 8 * I_SQ + 4 * I_PP + 4 * I_D1 + 2 * I_D2;
    for (int it = gw; it < NITEMS; it += NGW) {
        int r = it;
        if (r < 2 * I_MP) { const int set = r / I_MP; moe_cvt_tile(a, set, MT_TAIL + (r - set * I_MP), F.lane); continue; } r -= 2 * I_MP;
        const float* W; const float* gk = nullptr; unsigned char* WT; int K, N, il = 0, wh = 0, ldk, koff = 0, item;
        if (r < 4 * I_IN) { const int l = r / I_IN; item = r - l * I_IN; W = a.in[2] + (size_t)l * D * INW; K = D; N = INW; WT = ws + W_IN + (size_t)l * INW * D * 2; gk = a.in[10] + l * D; ldk = D; }
        else if ((r -= 4 * I_IN) < 4 * I_SQ) { const int l = r / I_SQ; item = r - l * I_SQ; W = a.in[21] + (size_t)l * D * D; K = D; N = D; WT = ws + W_PG + (size_t)l * D * D * 2; gk = a.in[12] + l * D; ldk = D; }
        else if ((r -= 4 * I_SQ) < 4 * I_D1) { const int j = r / I_D1, i = j & 1; wh = j >> 1; item = r - j * I_D1; W = a.in[13 + wh] + (size_t)i * D * FD; K = D; N = FD; WT = ws + W_13D + (size_t)i * 2 * FD * D * 2; gk = a.in[11] + 2 * i * D; ldk = D; il = 1; }
        else if ((r -= 4 * I_D1) < 8 * I_AB) { const int j = r / I_AB, l = j & 3, hb2 = j >> 2; item = r - j * I_AB; W = a.in[7 + hb2] + (size_t)l * 512 * D; K = 512; N = D; WT = ws + W_A + (size_t)l * D * D * 2; ldk = D; koff = 512 * hb2; }
        else if ((r -= 8 * I_AB) < 4 * I_SQ) { const int l = r / I_SQ; item = r - l * I_SQ; W = a.in[9] + (size_t)l * D * D; K = D; N = D; WT = ws + W_OUT + (size_t)l * D * D * 2; ldk = D; }
        else if ((r -= 4 * I_SQ) < 4 * I_PP) { const int l = r / I_PP; item = r - l * I_PP; W = a.in[20] + (size_t)l * PLE * D; K = PLE; N = D; WT = ws + W_PP + (size_t)l * D * PLE * 2; ldk = PLE; }
        else { r -= 4 * I_PP; const int i = r / I_D2; item = r - i * I_D2; W = a.in[15] + (size_t)i * FD * D; K = FD; N = D; WT = ws + W_2D + (size_t)i * D * FD * 2; ldk = FD; }
        if (gk) p0_cvt_item<1, 16>(W, K, N, WT, il, wh, item, F.lane, gk, 1.f, ldk, koff);
        else p0_cvt_item<0, 16>(W, K, N, WT, il, wh, item, F.lane, nullptr, 1.f, ldk, koff);
    }
    if (F.vcu == 0) { const int c = F.tid; const float* lbl = a.in[5]; float* lb = (float*)(ws + WS_TBL);
        float v[DEPTH], mx = -INFINITY, sum = 0.f;
#pragma unroll
        for (int l = 0; l < DEPTH; ++l) { v[l] = lbl[l * 512 + c]; mx = fmaxf(mx, v[l]); }
#pragma unroll
        for (int l = 0; l < DEPTH; ++l) { v[l] = expf(v[l] - mx); sum += v[l]; }
        float cum = 0.f; const float s0 = v[0] / sum;
#pragma unroll
        for (int l = 0; l < DEPTH; ++l) { cum += v[l] / sum; lb[l * 512 + c] = cum - s0; } }
    { float* ssp = (float*)(ws + WS_TBL + T_SSP2); bf16* hb = (bf16*)(ws + WS_U2);
      for (int m = gw; m < M; m += 4 * NGW) { f32x4 v[4][4];
#pragma unroll
          for (int r = 0; r < 4; ++r) { const GAS f32x4* xr = (const GAS f32x4*)(a.in[0] + (size_t)(m + r * NGW) * D) + F.lane;
#pragma unroll
              for (int j = 0; j < 4; ++j) v[r][j] = xr[64 * j]; }
#pragma unroll
          for (int r = 0; r < 4; ++r) { GAS v2u* o8 = (GAS v2u*)(hb + (size_t)(m + r * NGW) * D) + F.lane; float s = 0.f;
#pragma unroll
              for (int j = 0; j < 4; ++j) { const f32x4 x = v[r][j]; s += (x.x * x.x + x.y * x.y) + (x.z * x.z + x.w * x.w); v2u w; w.x = pg8::pk_f16(x.x, x.y); w.y = pg8::pk_f16(x.z, x.w); o8[64 * j] = w; }
              s = wave_sum(s, F.lane); if (F.lane < 16) ssp[(size_t)(m + r * NGW) * 16 + F.lane] = (F.lane == 0) ? s : 0.f; } } }
    { const GAS f32x4* src = (const GAS f32x4*)a.in[1]; GAS v2u* dst = (GAS v2u*)(ws + WS_PB); const size_t n4 = (size_t)DEPTH * M * PLE / 4;
      const size_t st = (size_t)NGW * 64;
      for (size_t i = (size_t)gw * 64 + F.lane; i < n4; i += 16 * st) { f32x4 v[16];
#pragma unroll
          for (int k = 0; k < 16; ++k) v[k] = src[i + k * st];
#pragma unroll
          for (int k = 0; k < 16; ++k) { v2u w; w.x = pk2(v[k].x, v[k].y); w.y = pk2(v[k].z, v[k].w); dst[i + k * st] = w; } } }
}

constexpr size_t T_LB = 0, T_CNT = 16 << 10, T_TOKE = 32 << 10, T_TOKW = 96 << 10, T_POS = 224 << 10, T_ROWW = 352 << 10, T_LISTU = 512 << 10, T_LISTD = 544 << 10, T_NUN = 552 << 10;
constexpr int NT_UP = 2 * FE / 256, NT_DN = D / 256;
typedef int i32x2 __attribute__((ext_vector_type(2)));
typedef int i32x4 __attribute__((ext_vector_type(4)));
typedef float f32x2 __attribute__((ext_vector_type(2)));
__device__ __forceinline__ int ld_agent_i(const int* p) { return (int)__hip_atomic_load((const unsigned*)p, RLX_AGENT); }
__device__ __forceinline__ void moe_tables(LAS int* T, const int* cnt, int G, int wgi, int tid) {
    const int lane = tid & 63, e = tid >> 6;
    int tot = 0, pre = 0;
    for (int t = lane; t < G; t += 64) { const int c = cnt[t * 8 + e]; tot += c; pre += (t < wgi) ? c : 0; }
    const float totf = wave_sum((float)tot, lane), pref = wave_sum((float)pre, lane);
    if (tid < 64) T[tid] = 0;
    __syncthreads();
    if (lane == 0) { T[e] = (int)totf; T[8 + e] = (int)pref; }
    __syncthreads();
    if (tid == 0) { int st = 0, ts = 0;
        for (int e = 0; e < 8; ++e) { const int tl = (T[e] + 255) >> 8; T[16 + e] = st; T[24 + e] = tl; T[32 + e] = ts; st += tl * 256; ts += tl; }
        T[40] = ts; }
    __syncthreads();
}
__device__ __forceinline__ i32x2 moe_unit(const LAS int* T, int L, int NT) {
    i32x2 r = {0, 0};
    for (int e = 0; e < 8; ++e) { const int tl = T[24 + e], ue = tl * NT;
        if (L < ue) { const int nig = 8 * NT, gid = L / nig, fm = gid * 8, gsz = (tl - fm) < 8 ? (tl - fm) : 8; r.x = T[32 + e] + fm + (L % nig) % gsz; r.y = e * NT + (L % nig) / gsz; return r; }
        L -= ue; }
    return r;
}
namespace pg8 {
struct ListOrder {
    const int* list; int n, G, c;
    __device__ __forceinline__ bool next(int i, Unit& u) const {
        const long L = (long)i * G + c; if (L >= n) return false;
        int wgid = (int)L; { const int q = n / NXCD, r = n % NXCD, xcd = wgid % NXCD, off = wgid / NXCD; wgid = (xcd < r ? xcd * (q + 1) : r * (q + 1) + (xcd - r) * q) + off; }
        u.pm = __builtin_amdgcn_readfirstlane(ld_agent_i(list + 2 * wgid)); u.pn = __builtin_amdgcn_readfirstlane(ld_agent_i(list + 2 * wgid + 1)); return true;
    }
    __device__ __forceinline__ void a_ready(const Unit&) const {}
    __device__ __forceinline__ void done(const Unit&) const {}
};
struct ListOrderL {
    const PG8_LAS int* ul; int n, G, c;
    __device__ __forceinline__ bool next(int i, Unit& u) const {
        const long L = (long)i * G + c; if (L >= n) return false;
        u.pm = __builtin_amdgcn_readfirstlane(ul[2 * i]); u.pn = __builtin_amdgcn_readfirstlane(ul[2 * i + 1]); return true;
    }
    __device__ __forceinline__ void a_ready(const Unit&) const {}
    __device__ __forceinline__ void done(const Unit&) const {}
};
}

constexpr int AT_KSTR = 72, AT_VSTR = 260;
constexpr int AT_K_OFF = 0, AT_V_OFF = 256 * AT_KSTR * 2, AT_TB_OFF = AT_V_OFF + 64 * AT_VSTR * 2, AT_LDS_END = AT_TB_OFF + 4 * 384 * 4;
static_assert(AT_LDS_END <= RING_BYTES && AT_V_OFF % 16 == 0 && AT_TB_OFF % 16 == 0, "attention LDS map");
typedef float f32x16 __attribute__((ext_vector_type(16)));
typedef short s16x4 __attribute__((ext_vector_type(4)));
__device__ __forceinline__ int t5_bucket_d(int d) {
    if (d < 16) return d;
    int large = 16 + (int)(logf((float)d / 16.f) / logf(8.f) * 16.f);
    return large < 31 ? large : 31;
}
__device__ __forceinline__ void attn_phase(LAS unsigned char* lds, const bf16* z, const float* sinks_l, const float* rel_bias, bf16* oa, int tid, int vcu, int G) {
    const int lane = tid & 63, wave = __builtin_amdgcn_readfirstlane(tid >> 6), l31 = lane & 31, h2 = lane >> 5;
    LAS bf16* Kt = (LAS bf16*)(lds + AT_K_OFF); LAS bf16* Vt = (LAS bf16*)(lds + AT_V_OFF); LAS float* tb = (LAS float*)(lds + AT_TB_OFF);
    for (int unit = vcu; unit < NB * (S / 128) * HKV; unit += G) {
        const int b = unit >> 6, n = (unit >> 1) & 31, kvh = unit & 1;
        __syncthreads();
        for (int i = tid; i < 4 * 384; i += NWAVES * 64) { const int g = i / 384, dist = i % 384 - 128;
            tb[i] = (dist >= 0 && dist < WIN) ? rel_bias[t5_bucket_d(dist) * HQ + kvh * 4 + g] : -1e30f; }
        v4u kq[4], vq[2][2];
#pragma unroll
        for (int j = 0; j < 4; ++j) { const int idx = tid + 512 * j, row = idx >> 3, ch = idx & 7; const bool valid = (n > 0) || (row >= 128);
            const size_t tok = (size_t)b * S + n * 128 - 128 + row;
            kq[j] = (v4u){0u, 0u, 0u, 0u};
            if (valid) kq[j] = *(const GAS v4u*)(z + tok * ZW + OFF_AK + kvh * 64 + ch * 8); }
#pragma unroll
        for (int j = 0; j < 2; ++j) { const int gq = wave + 8 * j, p = 16 * (gq & 7) + (lane & 15), ch = 4 * (gq >> 3) + (lane >> 4); const bool valid = (n > 0) || (p >= 64);
            const size_t tok = (size_t)b * S + n * 128 - 128 + 2 * p;
            vq[j][0] = (v4u){0u, 0u, 0u, 0u}; vq[j][1] = vq[j][0];
            if (valid) { vq[j][0] = *(const GAS v4u*)(z + tok * ZW + OFF_AV + kvh * 64 + ch * 8); vq[j][1] = *(const GAS v4u*)(z + (tok + 1) * ZW + OFF_AV + kvh * 64 + ch * 8); } }
#pragma unroll
        for (int j = 0; j < 4; ++j) { const int idx = tid + 512 * j, row = idx >> 3, ch = idx & 7; *(LAS v4u*)(Kt + row * AT_KSTR + ch * 8) = kq[j]; }
#pragma unroll
        for (int j = 0; j < 2; ++j) { const int gq = wave + 8 * j, p = 16 * (gq & 7) + (lane & 15), ch = 4 * (gq >> 3) + (lane >> 4);
            LAS unsigned* vp = (LAS unsigned*)(Vt + (ch * 8) * AT_VSTR + 2 * p); const v4u va = vq[j][0], vb = vq[j][1];
            vp[0 * (AT_VSTR / 2)] = __builtin_amdgcn_perm(vb.x, va.x, 0x05040100u); vp[1 * (AT_VSTR / 2)] = __builtin_amdgcn_perm(vb.x, va.x, 0x07060302u);
            vp[2 * (AT_VSTR / 2)] = __builtin_amdgcn_perm(vb.y, va.y, 0x05040100u); vp[3 * (AT_VSTR / 2)] = __builtin_amdgcn_perm(vb.y, va.y, 0x07060302u);
            vp[4 * (AT_VSTR / 2)] = __builtin_amdgcn_perm(vb.z, va.z, 0x05040100u); vp[5 * (AT_VSTR / 2)] = __builtin_amdgcn_perm(vb.z, va.z, 0x07060302u);
            vp[6 * (AT_VSTR / 2)] = __builtin_amdgcn_perm(vb.w, va.w, 0x05040100u); vp[7 * (AT_VSTR / 2)] = __builtin_amdgcn_perm(vb.w, va.w, 0x07060302u); }
        __syncthreads();
        const int g = wave >> 1, hq = kvh * 4 + g; const float sink = sinks_l[hq];
        for (int s2 = 0; s2 < 2; ++s2) {
            const int sb = (wave & 1) * 2 + s2, q0 = 32 * sb; const size_t qtok = (size_t)b * S + n * 128 + q0 + l31;
            bf16x8 Qf[4];
#pragma unroll
            for (int d0 = 0; d0 < 4; ++d0) Qf[d0] = *(const GAS bf16x8*)(z + qtok * ZW + OFF_AQ + hq * 64 + 16 * d0 + 8 * h2);
            f32x16 Sc[5];
#pragma unroll
            for (int i = 0; i < 5; ++i) { f32x16 acc = {0.f, 0.f, 0.f, 0.f, 0.f, 0.f, 0.f, 0.f, 0.f, 0.f, 0.f, 0.f, 0.f, 0.f, 0.f, 0.f};
#pragma unroll
                for (int d0 = 0; d0 < 4; ++d0) { const bf16x8 kf = *(const LAS bf16x8*)(Kt + (32 * (sb + i) + l31) * AT_KSTR + 16 * d0 + 8 * h2); acc = __builtin_amdgcn_mfma_f32_32x32x16_bf16(kf, Qf[d0], acc, 0, 0, 0); }
                Sc[i] = acc; }
            float mx = sink;
#pragma unroll
            for (int i = 0; i < 5; ++i)
#pragma unroll
                for (int r = 0; r < 16; ++r) { const int kj = 32 * (sb + i) + (r & 3) + 8 * (r >> 2) + 4 * h2; float sv = Sc[i][r] * 0.125f + tb[g * 384 + (q0 + l31) + 256 - kj];
                    if (n == 0 && kj < 128) sv = -1e30f; Sc[i][r] = sv; mx = fmaxf(mx, sv); }
            mx = fmaxf(mx, __builtin_bit_cast(float, __builtin_amdgcn_ds_bpermute((lane ^ 32) << 2, __builtin_bit_cast(int, mx))));
            float sum = 0.f;
#pragma unroll
            for (int i = 0; i < 5; ++i)
#pragma unroll
                for (int r = 0; r < 16; ++r) { const float p = __expf(Sc[i][r] - mx); Sc[i][r] = p; sum += p; }
            sum += __builtin_bit_cast(float, __builtin_amdgcn_ds_bpermute((lane ^ 32) << 2, __builtin_bit_cast(int, sum)));
            sum += __expf(sink - mx);
            f32x16 O0 = {0.f, 0.f, 0.f, 0.f, 0.f, 0.f, 0.f, 0.f, 0.f, 0.f, 0.f, 0.f, 0.f, 0.f, 0.f, 0.f}, O1 = O0;
#pragma unroll
            for (int i = 0; i < 5; ++i)
#pragma unroll
                for (int ks = 0; ks < 2; ++ks) {
                    v4u pw; pw.x = pg8::cvtpk(Sc[i][8 * ks + 0], Sc[i][8 * ks + 1]); pw.y = pg8::cvtpk(Sc[i][8 * ks + 2], Sc[i][8 * ks + 3]); pw.z = pg8::cvtpk(Sc[i][8 * ks + 4], Sc[i][8 * ks + 5]); pw.w = pg8::cvtpk(Sc[i][8 * ks + 6], Sc[i][8 * ks + 7]);
                    const bf16x8 pf = __builtin_bit_cast(bf16x8, pw);
                    const int kb = 32 * (sb + i) + 16 * ks + 4 * h2;
                    { const LAS bf16* vp = Vt + l31 * AT_VSTR + kb; const s16x4 a = *(const LAS s16x4*)vp, c = *(const LAS s16x4*)(vp + 8);
                      const bf16x8 vf = {a[0], a[1], a[2], a[3], c[0], c[1], c[2], c[3]}; O0 = __builtin_amdgcn_mfma_f32_32x32x16_bf16(vf, pf, O0, 0, 0, 0); }
                    { const LAS bf16* vp = Vt + (32 + l31) * AT_VSTR + kb; const s16x4 a = *(const LAS s16x4*)vp, c = *(const LAS s16x4*)(vp + 8);
                      const bf16x8 vf = {a[0], a[1], a[2], a[3], c[0], c[1], c[2], c[3]}; O1 = __builtin_amdgcn_mfma_f32_32x32x16_bf16(vf, pf, O1, 0, 0, 0); }
                }
            const float inv = 1.f / sum;
            bf16* orow = oa + qtok * 1024 + hq * 64 + 4 * h2;
#pragma unroll
            for (int rg = 0; rg < 4; ++rg) {
                v2u w0; w0.x = pg8::cvtpk(O0[4 * rg] * inv, O0[4 * rg + 1] * inv); w0.y = pg8::cvtpk(O0[4 * rg + 2] * inv, O0[4 * rg + 3] * inv); *(GAS v2u*)(orow + 8 * rg) = w0;
                v2u w1; w1.x = pg8::cvtpk(O1[4 * rg] * inv, O1[4 * rg + 1] * inv); w1.y = pg8::cvtpk(O1[4 * rg + 2] * inv, O1[4 * rg + 3] * inv); *(GAS v2u*)(orow + 32 + 8 * rg) = w1; }
        }
    }
    __syncthreads();
}

constexpr size_t WS_QC = WS_ZT, WS_OLOC = WS_ZT + 16 * MiB, WS_SEND = WS_ZT + 48 * MiB, WS_DTOT = WS_ZT + 80 * MiB, WS_SINIT = WS_Y;
constexpr int HG_SCL = 256, HG_NSC = S / HG_SCL;
constexpr int H1_QSTR = 136, H1_TSTR = 72;
constexpr int H1_QD = 0, H1_KI = 64 * H1_QSTR * 2, H1_KT = 2 * 64 * H1_QSTR * 2, H1_VT = H1_KT + 128 * H1_TSTR * 2, H1_DC = H1_VT + 128 * H1_TSTR * 2, H1_AL = H1_DC + 2048, H1_RT = H1_AL + 2048, H1_PB = H1_RT + 512, H1_END = H1_PB + 2048;
static_assert(H1_END <= RING_BYTES, "HGRN LDS map");
typedef short s16x4v __attribute__((ext_vector_type(4)));
__device__ __forceinline__ bf16x8 cat8(s16x4v a, s16x4v b) { return (bf16x8){a[0], a[1], a[2], a[3], b[0], b[1], b[2], b[3]}; }
__device__ __forceinline__ s16x4v pack4(f32x4 v) { v2u w; w.x = pg8::cvtpk(v[0], v[1]); w.y = pg8::cvtpk(v[2], v[3]); return __builtin_bit_cast(s16x4v, w); }
__device__ __forceinline__ void hgrn_pass1(LAS unsigned char* lds, unsigned char* ws, const bf16* z, const float* lbl, int tid, int vcu, int G) {
    const int lane = tid & 63, wave = __builtin_amdgcn_readfirstlane(tid >> 6), l15 = lane & 15, q4 = lane >> 4;
    LAS bf16* QD = (LAS bf16*)(lds + H1_QD); LAS bf16* KI = (LAS bf16*)(lds + H1_KI); LAS bf16* KT = (LAS bf16*)(lds + H1_KT); LAS bf16* VT = (LAS bf16*)(lds + H1_VT);
    LAS float* DC = (LAS float*)(lds + H1_DC); LAS float* AL = (LAS float*)(lds + H1_AL); LAS float* RT = (LAS float*)(lds + H1_RT); LAS s16x4v* PB = (LAS s16x4v*)(lds + H1_PB);
    GAS bf16* qc = (GAS bf16*)(ws + WS_QC); GAS bf16* oloc = (GAS bf16*)(ws + WS_OLOC); GAS float* send = (GAS float*)(ws + WS_SEND); GAS float* dtot = (GAS float*)(ws + WS_DTOT);
    const GAS bf16* zg = (const GAS bf16*)z; const GAS float* lblg = (const GAS float*)lbl;
    for (int item = vcu; item < NB * HGH * HG_NSC; item += G) {
        const int sc = item % HG_NSC, hh = (item / HG_NSC) & 3, b = item / (HG_NSC * 4);
        const size_t tok0 = (size_t)b * S + sc * HG_SCL;
        f32x4 St[8];
#pragma unroll
        for (int i = 0; i < 8; ++i) St[i] = (f32x4){0.f, 0.f, 0.f, 0.f};
        __syncthreads();
        if (tid < 128) RT[tid] = 0.f;
        v4u vraw[2]; bf16 qraw[16], fraw[16];
        const float lbv = lblg[hh * 128 + (tid & 127)];
        const int vt2 = 16 * (wave & 1) + (lane & 15), vch = 4 * (wave >> 1) + (lane >> 4);
#define H1_LOAD(hf) do { const size_t tk_ = tok0 + 64 * (hf); \
            _Pragma("unroll") for (int j = 0; j < 2; ++j) vraw[j] = *(const GAS v4u*)(zg + (tk_ + 2 * vt2 + j) * ZW + OFF_HI + hh * 128 + 8 * vch); \
            _Pragma("unroll") for (int t = 0; t < 16; ++t) { const GAS bf16* zp_ = zg + (tk_ + 16 * (tid >> 7) + t) * ZW + hh * 128 + (tid & 127); fraw[t] = zp_[OFF_HF]; qraw[t] = zp_[OFF_HQ]; } } while (0)
        H1_LOAD(0);
        for (int half = 0; half < HG_SCL / 64; ++half) {
            const size_t tokh = tok0 + 64 * half;
            { const int c = tid >> 7, d = tid & 127;
              float fA[16], EA[16]; float eA = 1.f;
#pragma unroll
              for (int t = 0; t < 16; ++t) { const float f = lbv + (1.f - lbv) * pg8::sigm(bf2f(fraw[t])); eA = fmaxf(eA * f, 1e-30f); fA[t] = f; EA[t] = eA; }
              AL[c * 128 + d] = __logf(eA);
              __syncthreads();
              float base = RT[d];
              for (int cc = 0; cc < c; ++cc) base += AL[cc * 128 + d];
              const float ebase = __expf(base);
              unsigned kw[8], kprev = 0u;
#pragma unroll
              for (int t = 0; t < 16; ++t) { const size_t tok = tokh + 16 * c + t; const float q = bf2f(qraw[t]);
                  const float qd = q * EA[t], ki = (1.f - fA[t]) * __builtin_amdgcn_rcpf(EA[t]);
                  const unsigned qk = pg8::cvtpk(qd, ki); const bf16 kib = (bf16)(qk >> 16);
                  QD[(16 * c + t) * H1_QSTR + d] = (bf16)(qk & 0xffffu); KI[(16 * c + t) * H1_QSTR + d] = kib;
                  if (t & 1) kw[t >> 1] = kprev | (qk & 0xffff0000u); else kprev = qk >> 16;
                  qc[tok * 512 + hh * 128 + d] = (bf16)(pg8::cvtpk(qd * ebase, 0.f) & 0xffffu); }
              { LAS v4u* kt = (LAS v4u*)(KT + d * H1_TSTR + 16 * c); kt[0] = (v4u){kw[0], kw[1], kw[2], kw[3]}; kt[1] = (v4u){kw[4], kw[5], kw[6], kw[7]}; }
              DC[c * 128 + d] = eA;
            }
            { LAS unsigned* vp = (LAS unsigned*)(VT + (8 * vch) * H1_TSTR + 2 * vt2); const v4u va = vraw[0], vb = vraw[1];
              vp[0 * (H1_TSTR / 2)] = __builtin_amdgcn_perm(vb.x, va.x, 0x05040100u); vp[1 * (H1_TSTR / 2)] = __builtin_amdgcn_perm(vb.x, va.x, 0x07060302u);
              vp[2 * (H1_TSTR / 2)] = __builtin_amdgcn_perm(vb.y, va.y, 0x05040100u); vp[3 * (H1_TSTR / 2)] = __builtin_amdgcn_perm(vb.y, va.y, 0x07060302u);
              vp[4 * (H1_TSTR / 2)] = __builtin_amdgcn_perm(vb.z, va.z, 0x05040100u); vp[5 * (H1_TSTR / 2)] = __builtin_amdgcn_perm(vb.z, va.z, 0x07060302u);
              vp[6 * (H1_TSTR / 2)] = __builtin_amdgcn_perm(vb.w, va.w, 0x05040100u); vp[7 * (H1_TSTR / 2)] = __builtin_amdgcn_perm(vb.w, va.w, 0x07060302u); }
            __syncthreads();
            if (half + 1 < HG_SCL / 64) H1_LOAD(half + 1);
            if (tid < 128) { float r = RT[tid]; for (int cc = 0; cc < 4; ++cc) r += AL[cc * 128 + tid]; RT[tid] = r; if (half == HG_SCL / 64 - 1) dtot[(size_t)item * 128 + tid] = __expf(r); }
            if (wave < 4) { const int c = wave; f32x4 PT = {0.f, 0.f, 0.f, 0.f};
                const LAS bf16* qrow = QD + (16 * c + l15) * H1_QSTR; const LAS bf16* krow = KI + (16 * c + l15) * H1_QSTR;
#pragma unroll
                for (int kk = 0; kk < 4; ++kk) { const bf16x8 ka = *(const LAS bf16x8*)(krow + 32 * kk + 8 * q4), qb = *(const LAS bf16x8*)(qrow + 32 * kk + 8 * q4);
                    PT = __builtin_amdgcn_mfma_f32_16x16x32_bf16(ka, qb, PT, 0, 0, 0); }
#pragma unroll
                for (int i = 0; i < 4; ++i) if (4 * q4 + i > l15) PT[i] = 0.f;
                PB[c * 64 + lane] = pack4(PT); }
            __syncthreads();
            const int e0 = 16 * wave;
            for (int c = 0; c < 4; ++c) {
                f32x4 O = {0.f, 0.f, 0.f, 0.f};
                const LAS bf16* qrow = QD + (16 * c + l15) * H1_QSTR;
#pragma unroll
                for (int kk = 0; kk < 4; ++kk) {
                    const bf16x8 sb = cat8(pack4(St[2 * kk]), pack4(St[2 * kk + 1]));
                    const bf16x8 qa = cat8(*(const LAS s16x4v*)(qrow + 32 * kk + 4 * q4), *(const LAS s16x4v*)(qrow + 32 * kk + 16 + 4 * q4));
                    O = __builtin_amdgcn_mfma_f32_16x16x32_bf16(qa, sb, O, 0, 0, 0);
                }
                const s16x4v vf = *(const LAS s16x4v*)(VT + (e0 + l15) * H1_TSTR + 16 * c + 4 * q4);
                O = __builtin_amdgcn_mfma_f32_16x16x16bf16_1k(PB[c * 64 + lane], vf, O, 0, 0, 0);
#pragma unroll
                for (int db = 0; db < 8; ++db) {
                    const s16x4v kf = *(const LAS s16x4v*)(KT + (16 * db + l15) * H1_TSTR + 16 * c + 4 * q4);
                    St[db] = __builtin_amdgcn_mfma_f32_16x16x16bf16_1k(kf, vf, St[db], 0, 0, 0);
                    const f32x4 dc = *(const LAS f32x4*)(DC + c * 128 + 16 * db + 4 * q4);
                    St[db] = St[db] * dc;
                }
#pragma unroll
                for (int i = 0; i < 4; ++i) oloc[(tokh + 16 * c + 4 * q4 + i) * 512 + hh * 128 + e0 + l15] = (bf16)(pg8::cvtpk(O[i], 0.f) & 0xffffu);
            }
            __syncthreads();
        }
#pragma unroll
        for (int db = 0; db < 8; ++db) *(GAS f32x4*)(send + ((size_t)item * 128 + 16 * wave + l15) * 128 + 16 * db + 4 * q4) = St[db];
    }
    __syncthreads();
}
#undef H1_LOAD
__device__ __forceinline__ void hgrn_scan(unsigned char* ws, int tid, int vcu, int G) {
    const float* send = (const float*)(ws + WS_SEND); const float* dtot = (const float*)(ws + WS_DTOT); unsigned* sinit = (unsigned*)(ws + WS_SINIT);
    for (int gid = vcu * (NWAVES * 64) + tid; gid < NB * HGH * 64 * 128; gid += G * NWAVES * 64) {
        const int dp = gid & 63, e = (gid >> 6) & 127, bh = gid >> 13;
        float s0 = 0.f, s1 = 0.f;
#pragma unroll
        for (int sc = 0; sc < HG_NSC - 1; ++sc) { const size_t item = (size_t)bh * HG_NSC + sc;
            const f32x2 av = *(const GAS f32x2*)(send + (item * 128 + e) * 128 + 2 * dp), dv = *(const GAS f32x2*)(dtot + item * 128 + 2 * dp);
            s0 = fmaf(dv.x, s0, av.x); s1 = fmaf(dv.y, s1, av.y);
            sinit[((item + 1) * 128 + e) * 64 + dp] = pk2(s0, s1); }
    }
}
__device__ __forceinline__ void hgrn_pass3(LAS unsigned char* lds, unsigned char* ws, const bf16* z, const float* ng, bf16* ob, int tid, int vcu, int G) {
    const int lane = tid & 63, wave = __builtin_amdgcn_readfirstlane(tid >> 6), l15 = lane & 15, q4 = lane >> 4;
    const bf16* qc = (const bf16*)(ws + WS_QC); const bf16* oloc = (const bf16*)(ws + WS_OLOC); const bf16* sinit = (const bf16*)(ws + WS_SINIT);
    for (int item = vcu; item < NB * HGH * HG_NSC; item += G) {
        const int sc = item % HG_NSC, hh = (item / HG_NSC) & 3, b = item / (HG_NSC * 4);
        constexpr int TB = HG_SCL / 128;
        const size_t tokw = (size_t)b * S + sc * HG_SCL + 16 * TB * wave + l15;
        f32x4 acc[TB][8]; v2u gzv[TB][8]; f32x4 gnv[8];
#pragma unroll
        for (int tb = 0; tb < TB; ++tb)
#pragma unroll
            for (int eb = 0; eb < 8; ++eb) { { const v2u ol = *(const GAS v2u*)(oloc + (tokw + 16 * tb) * 512 + hh * 128 + 16 * eb + 4 * q4); acc[tb][eb] = (f32x4){pg8::bf_lo(ol.x), pg8::bf_hi(ol.x), pg8::bf_lo(ol.y), pg8::bf_hi(ol.y)}; }
                gzv[tb][eb] = *(const GAS v2u*)(z + (tokw + 16 * tb) * ZW + OFF_HG + hh * 128 + 16 * eb + 4 * q4); }
#pragma unroll
        for (int eb = 0; eb < 8; ++eb) gnv[eb] = *(const GAS f32x4*)(ng + 16 * eb + 4 * q4);
        if (sc > 0) {
            __syncthreads();
            { LAS v4u* SL = (LAS v4u*)lds; const GAS v4u* sg = (const GAS v4u*)(sinit + (size_t)item * 128 * 128);
              v4u t4[4];
#pragma unroll
              for (int i = 0; i < 4; ++i) t4[i] = sg[tid + 512 * i];
#pragma unroll
              for (int i = 0; i < 4; ++i) { const int idx = tid + 512 * i, row = idx >> 4, ch = idx & 15; SL[row * 17 + ch] = t4[i]; } }
            __syncthreads();
            bf16x8 bq[TB][4];
#pragma unroll
            for (int tb = 0; tb < TB; ++tb)
#pragma unroll
                for (int kk = 0; kk < 4; ++kk) bq[tb][kk] = *(const GAS bf16x8*)(qc + (tokw + 16 * tb) * 512 + hh * 128 + 32 * kk + 8 * q4);
#pragma unroll
            for (int eb = 0; eb < 8; ++eb)
#pragma unroll
                for (int kk = 0; kk < 4; ++kk) { const bf16x8 sa = *(const LAS bf16x8*)(lds + ((16 * eb + l15) * 17 + 4 * kk + q4) * 16);
#pragma unroll
                    for (int tb = 0; tb < TB; ++tb) acc[tb][eb] = __builtin_amdgcn_mfma_f32_16x16x32_bf16(sa, bq[tb][kk], acc[tb][eb], 0, 0, 0); }
        }
#pragma unroll
        for (int tb = 0; tb < TB; ++tb) { const size_t tok = tokw + 16 * tb;
            float ss = 0.f;
#pragma unroll
            for (int eb = 0; eb < 8; ++eb) {
                ss += (acc[tb][eb][0] * acc[tb][eb][0] + acc[tb][eb][1] * acc[tb][eb][1]) + (acc[tb][eb][2] * acc[tb][eb][2] + acc[tb][eb][3] * acc[tb][eb][3]); }
            ss += __builtin_bit_cast(float, __builtin_amdgcn_ds_bpermute((lane ^ 16) << 2, __builtin_bit_cast(int, ss)));
            ss += __builtin_bit_cast(float, __builtin_amdgcn_ds_bpermute((lane ^ 32) << 2, __builtin_bit_cast(int, ss)));
            const float r = rsqrtf(ss * (1.f / DV) + EPS);
#pragma unroll
            for (int eb = 0; eb < 8; ++eb) { const int e = 16 * eb + 4 * q4;
                const f32x4 gn = gnv[eb]; const v2u gz = gzv[tb][eb];
                const float g0 = pg8::bf_lo(gz.x), g1 = pg8::bf_hi(gz.x), g2 = pg8::bf_lo(gz.y), g3 = pg8::bf_hi(gz.y);
                v2u w; w.x = pg8::cvtpk(acc[tb][eb][0] * r * gn[0] * pg8::silu(g0), acc[tb][eb][1] * r * gn[1] * pg8::silu(g1)); w.y = pg8::cvtpk(acc[tb][eb][2] * r * gn[2] * pg8::silu(g2), acc[tb][eb][3] * r * gn[3] * pg8::silu(g3));
                *(GAS v2u*)(ob + tok * 1024 + hh * 128 + e) = w; } }
    }
}
constexpr int PH_PRO = 0, PH_L0 = 1, PH_PER_LAYER = 16, PH_FINAL = PH_L0 + DEPTH * PH_PER_LAYER, PH_END = PH_FINAL + 1;
constexpr int P_N1 = 0, P_G1 = 1, P_ATT = 2, P_SCAN = 3, P_HG3 = 4, P_G2 = 5, P_G3 = 6, P_N2 = 7, P_R2 = 8, P_G4 = 9, P_G5 = 10, P_CMB = 11, P_N3 = 12, P_G6 = 13, P_G6B = 14;

__global__ void __launch_bounds__(NWAVES * 64, 2) mk_fwd(Args args) {
    extern __shared__ __attribute__((aligned(16))) unsigned char lds[];
    Frame F;
    F.lds = (LAS unsigned char*)lds;
    F.MISC = (volatile LAS unsigned*)(F.lds + MISC_OFF);
    F.tid = threadIdx.x; F.lane = F.tid & 63; F.wave = __builtin_amdgcn_readfirstlane(F.tid >> 6);
    F.G = gridDim.x; { const int bx = blockIdx.x; F.vcu = (F.G % 8 == 0) ? (bx % 8) * (F.G / 8) + bx / 8 : bx; }
    const Args* ap = (const Args*)__builtin_amdgcn_kernarg_segment_ptr();
    unsigned char* ws = ap->ws;
    F.ctl = (gu32*)(ws + WS_CTL);
    for (int u = F.tid; u < (LDS_BYTES - LDSCTL_OFF) / 4; u += NWAVES * 64) ((LAS unsigned*)(F.lds + LDSCTL_OFF))[u] = 0u;
    __syncthreads();
    XcdBarrier bar = xcd_barrier_post((unsigned*)(F.ctl + CW_BAR) + ap->li * BAR_STRIDE, F.MISC + 8);
    int lo = ap->ph_lo, hi = ap->ph_hi;
#define OPQ_RANGE() asm volatile("" : "+s"(lo), "+s"(hi), "+s"(ws), "+s"(ap))
#define IN(k) (lo <= (k) && (k) < hi)
#define SEAM(k) do { if (hi > (k) + 1) { OPQ_LANE(); xcd_barrier(bar, tidv); } } while (0)
#define ROWLOOP(m) int m = gw; asm volatile("" : "+s"(m)); for (; m < M; m += NGW)
#define OPQ_LANE() int z_ = 0; asm volatile("" : "+v"(z_)); const int ln = (int)__builtin_amdgcn_mbcnt_hi(~0u, __builtin_amdgcn_mbcnt_lo(~0u, (unsigned)z_)); const int tidv = F.wave * 64 + ln; (void)tidv; int bix = blockIdx.x; asm volatile("" : "+s"(bix)); (void)bix

    const int gw = F.vcu * NWAVES + F.wave, NGW = F.G * NWAVES;
#define RSTD_TBL(So, sspp) LAS float* rtb = (LAS float*)(F.lds + RSTD_OFF); int tpm; { pg8::Unit u0{0, 0}; (void)So.next(0, u0); tpm = u0.pm; if (ln + 64 * F.wave < 256) rtb[tidv] = pg8::row_rstd((sspp), (size_t)tpm * 256 + tidv); __syncthreads(); }
#define ULIST_FILL(listp, nn) LAS int* ulp = (LAS int*)(F.lds + LDSCTL_OFF + 4096); { const int i_ = ln + 64 * F.wave; if (i_ < 32) { const long L_ = (long)i_ * F.G + bix; if (L_ < (nn)) { int w_ = (int)L_; \
        { const int q_ = (nn) / 8, r_ = (nn) % 8, x_ = w_ % 8, o_ = w_ / 8; w_ = (x_ < r_ ? x_ * (q_ + 1) : r_ * (q_ + 1) + (x_ - r_) * q_) + o_; } ulp[2 * i_] = ld_agent_i((listp) + 2 * w_); ulp[2 * i_ + 1] = ld_agent_i((listp) + 2 * w_ + 1); } } __syncthreads(); }
#define WSPTRS() bf16* const un = (bf16*)(ws + WS_OA + 34 * MiB); (void)un;     \
    unsigned short* const hx = (unsigned short*)(ws + WS_U2); unsigned short* const hy = (unsigned short*)(ws + WS_U); (void)hx; (void)hy; bf16* const ub = (bf16*)(ws + WS_U); bf16* const zb = (bf16*)(ws + WS_Z); bf16* const oa = (bf16*)(ws + WS_OA); bf16* const ob = (bf16*)(ws + WS_OA) + 512; bf16* const mg = (bf16*)(ws + WS_MG); \
    (void)ub; (void)zb; (void)oa; (void)ob; (void)mg

    if (IN(PH_PRO)) { p0_prologue(F, *ap); SEAM(PH_PRO); }

    for (int l = 0; l < DEPTH; ++l) {
        OPQ_RANGE();
        WSPTRS();
        const int pb = PH_L0 + l * PH_PER_LAYER;
        if (IN(pb + P_G1)) {
            OPQ_LANE();
            if (bix >= 192) {
                const int rk = (bix - 192) * NWAVES + F.wave, id0 = (l & 1) ? MT_G1 + MT_G4 : 0;
                for (int k = 0; k < MT_N1; ++k) moe_cvt_tile(*ap, l >> 1, id0 + rk + k * (64 * NWAVES), ln); }
            pg8::Gemm g{(const bf16*)(ws + WS_U2), (const bf16*)(ws + W_IN) + (size_t)l * INW * D, M, INW, D}; pg8::StaticOrder So; So.init(M, INW, F.G, bix);
            RSTD_TBL(So, (const float*)(ws + WS_TBL + T_SSP2));
            pg8::EpiZG E{zb, ZW, (unsigned char*)(ws + WS_GZ), rtb}; (void)tpm;
            pg8::gemm_phase<pg8::EpiZG, pg8::StaticOrder, true, true, 2>(F.lds + RING_OFF, g, So, E, tidv);
            SEAM(pb + P_G1);
        }
        if (IN(pb + P_ATT)) {
            OPQ_LANE();
            attn_phase(F.lds + RING_OFF, zb, ap->in[3] + l * HQ, ap->in[4], oa, tidv, F.vcu, F.G);
            hgrn_pass1(F.lds + RING_OFF, ws, zb, (const float*)(ws + WS_TBL + T_LB) + l * 512, tidv, F.vcu, F.G);
            SEAM(pb + P_ATT);
        }
        if (IN(pb + P_SCAN)) {
            OPQ_LANE();
            hgrn_scan(ws, tidv, F.vcu, F.G);
            SEAM(pb + P_SCAN);
        }
        if (IN(pb + P_HG3)) {
            OPQ_LANE();
            hgrn_pass3(F.lds + RING_OFF, ws, zb, ap->in[6] + l * DV, ob, tidv, F.vcu, F.G);
            SEAM(pb + P_HG3);
        }
        if (IN(pb + P_G2)) {
            OPQ_LANE();
            pg8::StaticOrder So; So.init(M, D, F.G, bix);
            { pg8::Gemm g{oa, (const bf16*)(ws + W_A) + (size_t)l * D * D, M, D, D};
              pg8::EpiGateM E{mg, D, (const unsigned char*)(ws + WS_GZ), 2 * D};
              pg8::gemm_phase<pg8::EpiGateM, pg8::StaticOrder, true, true, 0, true>(F.lds + RING_OFF, g, So, E, tidv); }
            SEAM(pb + P_G2);
        }
        if (IN(pb + P_G3)) {
            OPQ_LANE();
            pg8::Gemm g{mg, (const bf16*)(ws + W_OUT) + (size_t)l * D * D, M, D, D}; pg8::StaticOrder So; So.init(M, D, F.G, bix);
            pg8::EpiResH E{hx, hy, (float*)(ws + WS_TBL + T_SSP), D, 1.f};
            pg8::gemm_phase<pg8::EpiResH, pg8::StaticOrder, true, true>(F.lds + RING_OFF, g, So, E, tidv);
            SEAM(pb + P_G3);
        }
        if (IN(pb + P_N2)) {
            if (l & 1) {
                OPQ_LANE();
                LAS int* T = (LAS int*)(F.lds + RING_OFF);
                if (tidv < 8) T[tidv] = 0;
                __syncthreads();
                const float* rw = ap->in[16] + (size_t)(l >> 1) * D * NE; const float* gn = ap->in[11] + l * D;
                LAS f32x4* RW = (LAS f32x4*)(F.lds + RING_OFF + 1024);
#pragma unroll
                for (int i = 0; i < 4; ++i) { const int j = tidv + 512 * i, k = j >> 1;
                    RW[((((k >> 8) * 4 + (k & 3)) * 2 + (j & 1)) << 6) + ((k >> 2) & 63)] = ((const GAS f32x4*)rw)[j]; }
                f32x4 gv[4];
#pragma unroll
                for (int q = 0; q < 4; ++q) gv[q] = ((const GAS f32x4*)gn)[ln + 64 * q];
                __syncthreads();
                const int tpw = M / F.G / NWAVES;
                int* toke = (int*)(ws + WS_TBL + T_TOKE); f32x2* tokw = (f32x2*)(ws + WS_TBL + T_TOKW);
                const int tw0 = (F.vcu * NWAVES + F.wave) * tpw;
                v2u hn[2][4];
#pragma unroll
                for (int r = 0; r < 2; ++r) { const GAS v2u* xr = (const GAS v2u*)(hy + (size_t)(tw0 + r) * D) + ln;
#pragma unroll
                    for (int q = 0; q < 4; ++q) hn[r][q] = xr[64 * q]; }
                for (int j = 0; j < tpw; j += 2) {
                    const int t0 = tw0 + j;
                    f32x4 v[2][4]; float ss[2] = {0.f, 0.f};
#pragma unroll
                    for (int r = 0; r < 2; ++r)
#pragma unroll
                        for (int q = 0; q < 4; ++q) { const v2u hv = hn[r][q]; v[r][q] = (f32x4){pg8::f16_lo(hv.x), pg8::f16_hi(hv.x), pg8::f16_lo(hv.y), pg8::f16_hi(hv.y)}; }
                    if (j + 2 < tpw) {
#pragma unroll
                        for (int r = 0; r < 2; ++r) { const GAS v2u* xr = (const GAS v2u*)(hy + (size_t)(t0 + 2 + r) * D) + ln;
#pragma unroll
                            for (int q = 0; q < 4; ++q) hn[r][q] = xr[64 * q]; } }
#pragma unroll
                    for (int r = 0; r < 2; ++r) {
#pragma unroll
                        for (int q = 0; q < 4; ++q) ss[r] += (v[r][q].x * v[r][q].x + v[r][q].y * v[r][q].y) + (v[r][q].z * v[r][q].z + v[r][q].w * v[r][q].w); }
                    float rstd[2]; rstd[0] = rsqrtf(wave_sum(ss[0], ln) * (1.f / D) + EPS); rstd[1] = rsqrtf(wave_sum(ss[1], ln) * (1.f / D) + EPS);
                    float lg[2][8];
#pragma unroll
                    for (int r = 0; r < 2; ++r)
#pragma unroll
                        for (int e = 0; e < 8; ++e) lg[r][e] = 0.f;
#pragma unroll
                    for (int q = 0; q < 4; ++q) { f32x4 uu[2];
#pragma unroll
                        for (int r = 0; r < 2; ++r) { uu[r] = v[r][q] * rstd[r] * gv[q]; ((GAS unsigned*)((unsigned char*)un + (size_t)(t0 + r) * D) + ln)[64 * q] = pg8::pk4_fp8(uu[r].x, uu[r].y, uu[r].z, uu[r].w); }
                        const LAS f32x4* wr4 = RW + q * 512 + ln;
#pragma unroll
                        for (int c = 0; c < 4; ++c) { const f32x4 w0 = wr4[128 * c], w1 = wr4[128 * c + 64];
#pragma unroll
                            for (int r = 0; r < 2; ++r) { const float xv = uu[r][c];
                                lg[r][0] = fmaf(xv, w0.x, lg[r][0]); lg[r][1] = fmaf(xv, w0.y, lg[r][1]); lg[r][2] = fmaf(xv, w0.z, lg[r][2]); lg[r][3] = fmaf(xv, w0.w, lg[r][3]);
                                lg[r][4] = fmaf(xv, w1.x, lg[r][4]); lg[r][5] = fmaf(xv, w1.y, lg[r][5]); lg[r][6] = fmaf(xv, w1.z, lg[r][6]); lg[r][7] = fmaf(xv, w1.w, lg[r][7]); } } }
#pragma unroll
                    for (int r = 0; r < 2; ++r)
#pragma unroll
                        for (int e = 0; e < 8; ++e) lg[r][e] = wave_sum(lg[r][e], ln);
#pragma unroll
                    for (int r = 0; r < 2; ++r) {
                        int i1 = 0; float v1 = lg[r][0];
#pragma unroll
                        for (int e = 1; e < 8; ++e) if (lg[r][e] > v1) { v1 = lg[r][e]; i1 = e; }
                        int i2 = -1; float v2 = -INFINITY;
#pragma unroll
                        for (int e = 0; e < 8; ++e) if (e != i1 && lg[r][e] > v2) { v2 = lg[r][e]; i2 = e; }
                        const float e2 = __expf(v2 - v1), w1g = 1.f / (1.f + e2), w2g = e2 / (1.f + e2);
                        if (ln == 0) { toke[t0 + r] = i1 | (i2 << 8); tokw[t0 + r] = (f32x2){w1g, w2g}; atomicAdd((int*)&T[i1], 1); atomicAdd((int*)&T[i2], 1); } }
                }
                __syncthreads();
                if (tidv < 8) ((int*)(ws + WS_TBL + T_CNT))[F.vcu * 8 + tidv] = T[tidv];
            }
            if (l & 1) SEAM(pb + P_N2);
        }
        if (IN(pb + P_R2)) {
            if (l & 1) {
                OPQ_LANE();
                LAS int* T = (LAS int*)(F.lds + RING_OFF);
                moe_tables(T, (const int*)(ws + WS_TBL + T_CNT), F.G, F.vcu, tidv);
                const int tpg = M / F.G;
                const int* toke = (const int*)(ws + WS_TBL + T_TOKE); const f32x2* tokw = (const f32x2*)(ws + WS_TBL + T_TOKW);
                i32x2* posg = (i32x2*)(ws + WS_TBL + T_POS); float* roww = (float*)(ws + WS_TBL + T_ROWW);
                bf16* ag = (bf16*)(ws + WS_AG);
                LAS int* P = T + 64;
                if (F.wave == 0) {
                    for (int t0 = 0; t0 < tpg; t0 += 64) {
                        const int tl = t0 + ln, t = F.vcu * tpg + tl; const bool ok = tl < tpg;
                        const int ee = ok ? toke[t] : 0x0808; const int e1 = ee & 255, e2 = ee >> 8;
                        int p1 = 0, p2 = 0;
#pragma unroll
                        for (int e = 0; e < 8; ++e) { const unsigned long long mk = __ballot(ok && (e1 == e || e2 == e)); const int rk = __popcll(mk & ((1ull << ln) - 1ull));
                            const int base = T[16 + e] + T[8 + e] + T[48 + e];
                            if (e1 == e) p1 = base + rk; if (e2 == e) p2 = base + rk;
                            if (ln == 0) T[48 + e] += __popcll(mk); }
                        if (ok) { P[2 * tl] = p1; P[2 * tl + 1] = p2; posg[t] = (i32x2){p1, p2}; const f32x2 w = tokw[t]; roww[p1] = w.x; roww[p2] = w.y; }
                    }
                }
                __syncthreads();
                for (int r0 = F.wave; r0 < 2 * tpg; r0 += 16 * NWAVES) {
                    v4u a4[16]; int pp[16];
#pragma unroll
                    for (int k = 0; k < 16; ++k) { const int r = r0 + k * NWAVES, t = F.vcu * tpg + (r >> 1); pp[k] = P[r]; a4[k] = ((const GAS v4u*)((const unsigned char*)un + (size_t)t * D))[ln]; }
#pragma unroll
                    for (int k = 0; k < 16; ++k) ((GAS v4u*)((unsigned char*)ag + (size_t)pp[k] * D))[ln] = a4[k];
                }
                if (F.vcu < 8) {
                    const int e = F.vcu, r0 = T[16 + e] + T[e], r1 = T[16 + e] + T[24 + e] * 256;
                    for (int r = r0 + F.wave; r < r1; r += NWAVES) { GAS v2u* dst = (GAS v2u*)((unsigned char*)ag + (size_t)r * D) + ln; dst[0] = (v2u){0u, 0u}; dst[64] = (v2u){0u, 0u}; if (ln == 0) roww[r] = 0.f; }
                }
                if (F.vcu == 8 % F.G) {
                    const int nu = T[40] * NT_UP, nd = T[40] * NT_DN;
                    i32x2* lu = (i32x2*)(ws + WS_TBL + T_LISTU); i32x2* ld = (i32x2*)(ws + WS_TBL + T_LISTD);
                    for (int L = tidv; L < nu; L += NWAVES * 64) lu[L] = moe_unit(T, L, NT_UP);
                    for (int L = tidv; L < nd; L += NWAVES * 64) ld[L] = moe_unit(T, L, NT_DN);
                    if (tidv == 0) { ((int*)(ws + WS_TBL + T_NUN))[0] = nu; ((int*)(ws + WS_TBL + T_NUN))[1] = nd; }
                }
                __syncthreads();
            }
            if (l & 1) SEAM(pb + P_R2);
        }
        if (IN(pb + P_G4)) {
            OPQ_LANE();
            if (l & 1) {
                OPQ_LANE();
                const int nu = __builtin_amdgcn_readfirstlane(ld_agent_i((const int*)(ws + WS_TBL + T_NUN)));
                pg8::Gemm g{(const bf16*)(ws + WS_AG), (const bf16*)(ws + W_13M + (size_t)(l >> 1) * NE * 2 * FE * D), MOE_ROWS, NE * 2 * FE, D / 2};
                ULIST_FILL((const int*)(ws + WS_TBL + T_LISTU), nu);
                pg8::ListOrderL So{ulp, nu, F.G, bix};
                pg8::EpiSwiglu8 E{(unsigned char*)zb, FE, NT_UP, 1.f / 32.f};
                pg8::gemm_phase<pg8::EpiSwiglu8, pg8::ListOrderL, true, true, true>(F.lds + RING_OFF, g, So, E, tidv);
            }
            if ((l & 1) == 0) {
                if (bix >= 128) { const int rk = (bix - 128) * NWAVES + F.wave;
                    for (int k = 0; k < MT_N4; ++k) moe_cvt_tile(*ap, l >> 1, MT_G1 + rk + k * (128 * NWAVES), ln); }
                { OPQ_LANE();
                  const int nun = (M / 256) * (2 * FD / 256), nfull = nun / F.G, nbusy = nun - nfull * F.G, nsub = F.G - nbusy;
                  pg8::SubOrder Sp{nsub > 0 ? (bix >= nbusy ? bix - nbusy : -1) : bix, nsub > 0 ? nsub : F.G, (M / 256) * (D / 256)};
                  int kple = PLE; asm volatile("" : "+s"(kple));
                  pg8::Gemm gp{(const bf16*)(ws + WS_PB) + (size_t)l * M * PLE, (const bf16*)(ws + W_PP) + (size_t)l * D * PLE, M, D, kple};
                  pg8::EpiBfPlain Ep{mg, D};
                  pg8::gemm_phase<pg8::EpiBfPlain, pg8::SubOrder, true, true>(F.lds + RING_OFF, gp, Sp, Ep, tidv); }
                OPQ_LANE();
                pg8::Gemm g{ub, (const bf16*)(ws + W_13D) + (size_t)(l >> 1) * 2 * FD * D, M, 2 * FD, D}; pg8::StaticOrder So; So.init(M, 2 * FD, F.G, bix);
                RSTD_TBL(So, (const float*)(ws + WS_TBL + T_SSP));
                pg8::EpiSwigluN E{zb, FD, (const float*)(ws + WS_TBL + T_SSP), rtb, tpm};
                pg8::gemm_phase<pg8::EpiSwigluN, pg8::StaticOrder, true, true, 2>(F.lds + RING_OFF, g, So, E, tidv);

            }
            SEAM(pb + P_G4);
        }
        if (IN(pb + P_G5)) {
            OPQ_LANE();
            if (l & 1) {
                { OPQ_LANE(); const int nd = __builtin_amdgcn_readfirstlane(ld_agent_i((const int*)(ws + WS_TBL + T_NUN) + 1));
                  const int nfull = nd / F.G, nbusy = nd - nfull * F.G, nsub = F.G - nbusy;
                  pg8::SubOrder Sp{nsub > 0 ? (bix >= nbusy ? bix - nbusy : -1) : bix, nsub > 0 ? nsub : F.G, (M / 256) * (D / 256)};
                  int kple = PLE; asm volatile("" : "+s"(kple));
                  pg8::Gemm gp{(const bf16*)(ws + WS_PB) + (size_t)l * M * PLE, (const bf16*)(ws + W_PP) + (size_t)l * D * PLE, M, D, kple};
                  pg8::EpiBfPlain Ep{mg, D};
                  pg8::gemm_phase<pg8::EpiBfPlain, pg8::SubOrder, true, true>(F.lds + RING_OFF, gp, Sp, Ep, tidv); }
                { OPQ_LANE(); const int nd = __builtin_amdgcn_readfirstlane(ld_agent_i((const int*)(ws + WS_TBL + T_NUN) + 1));
                  pg8::Gemm g{zb, (const bf16*)(ws + W_2M + (size_t)(l >> 1) * NE * D * FE), MOE_ROWS, NE * D, FE / 2};
                  ULIST_FILL((const int*)(ws + WS_TBL + T_LISTD), nd);
                  pg8::ListOrderL So{ulp, nd, F.G, bix};
                  pg8::EpiMoeDown E{(bf16*)(ws + WS_Y), D, (const float*)(ws + WS_TBL + T_ROWW), NT_DN, 1.f / 256.f};
                  pg8::gemm_phase<pg8::EpiMoeDown, pg8::ListOrderL, true, true, true>(F.lds + RING_OFF, g, So, E, tidv); }

            }
            if ((l & 1) == 0) {
                OPQ_LANE();
                pg8::Gemm g{zb, (const bf16*)(ws + W_2D) + (size_t)(l >> 1) * D * FD, M, D, FD}; pg8::StaticOrder So; So.init(M, D, F.G, bix);
                pg8::EpiResH E{hy, hy, (float*)(ws + WS_TBL + T_SSP), D, 1.f};
                pg8::gemm_phase<pg8::EpiResH, pg8::StaticOrder, true, true>(F.lds + RING_OFF, g, So, E, tidv);
            }
            SEAM(pb + P_G5);
        }
        if (IN(pb + P_CMB)) {
            if (l & 1) {
                OPQ_LANE();
                const bf16* Y = (const bf16*)(ws + WS_Y); const int* posg = (const int*)(ws + WS_TBL + T_POS);
                int gwo = gw; asm volatile("" : "+s"(gwo));
                const int pr = gwo + (ln & 7) * NGW; const int p1v = ld_agent_i(posg + 2 * pr), p2v = ld_agent_i(posg + 2 * pr + 1);
                for (int k0 = 0; k0 < M / NGW; k0 += 4) {
                    v2u hv[4][4], ya[4][4], yb[4][4];
#pragma unroll
                    for (int r = 0; r < 4; ++r) { const int p1 = __builtin_amdgcn_readlane(p1v, k0 + r), p2 = __builtin_amdgcn_readlane(p2v, k0 + r);
                        const GAS v2u* xr = (const GAS v2u*)(hy + (size_t)(gwo + (k0 + r) * NGW) * D) + ln;
                        const GAS v2u* y1 = (const GAS v2u*)(Y + (size_t)p1 * D) + ln; const GAS v2u* y2 = (const GAS v2u*)(Y + (size_t)p2 * D) + ln;
#pragma unroll
                        for (int q = 0; q < 4; ++q) { hv[r][q] = xr[64 * q]; ya[r][q] = y1[64 * q]; yb[r][q] = y2[64 * q]; } }
#pragma unroll
                    for (int r = 0; r < 4; ++r) { const int mr = gwo + (k0 + r) * NGW; float ss = 0.f; f32x4 v[4];
#pragma unroll
                        for (int q = 0; q < 4; ++q) { const v2u h = hv[r][q], a = ya[r][q], b = yb[r][q];
                            v[q].x = pg8::f16_lo(h.x) + (pg8::bf_lo(a.x) + pg8::bf_lo(b.x)); v[q].y = pg8::f16_hi(h.x) + (pg8::bf_hi(a.x) + pg8::bf_hi(b.x));
                            v[q].z = pg8::f16_lo(h.y) + (pg8::bf_lo(a.y) + pg8::bf_lo(b.y)); v[q].w = pg8::f16_hi(h.y) + (pg8::bf_hi(a.y) + pg8::bf_hi(b.y));
                            ss += (v[q].x * v[q].x + v[q].y * v[q].y) + (v[q].z * v[q].z + v[q].w * v[q].w); }
                        ss = wave_sum(ss, ln);
                        GAS v2u* o8 = (GAS v2u*)(ub + (size_t)mr * D) + ln;
#pragma unroll
                        for (int q = 0; q < 4; ++q) { v2u w; w.x = pg8::pk_f16(v[q].x, v[q].y); w.y = pg8::pk_f16(v[q].z, v[q].w); o8[64 * q] = w; }
                        if (ln < 16) ((float*)(ws + WS_TBL + T_SSP))[(size_t)mr * 16 + ln] = (ln == 0) ? ss : 0.f; }
                }
            }
            if (l & 1) SEAM(pb + P_CMB);
        }
        if (IN(pb + P_G6)) {
            OPQ_LANE();
            pg8::StaticOrder So; So.init(M, D, F.G, bix);
            { pg8::Gemm g{ub, (const bf16*)(ws + W_PG) + (size_t)l * D * D, M, D, D};
              RSTD_TBL(So, (const float*)(ws + WS_TBL + T_SSP)); (void)tpm;
              pg8::EpiPleH E{hy, hx, mg, (float*)(ws + WS_TBL + T_SSP2), D, rtb};
              pg8::gemm_phase<pg8::EpiPleH, pg8::StaticOrder, true, true, 2>(F.lds + RING_OFF, g, So, E, tidv); }
            SEAM(pb + P_G6B);
        }
    }
    OPQ_RANGE();
    if (IN(PH_FINAL)) {
        WSPTRS();
        OPQ_LANE();
        { int m = gw; asm volatile("" : "+s"(m)); const GAS f32x4* gr = (const GAS f32x4*)ap->in[22] + ln;
          for (; m < M; m += 2 * NGW) { f32x4 v[2][4]; float ss[2] = {0.f, 0.f};
#pragma unroll
              for (int r = 0; r < 2; ++r) { const GAS v2u* xr = (const GAS v2u*)(hx + (size_t)(m + r * NGW) * D) + ln;
#pragma unroll
                  for (int q = 0; q < 4; ++q) { const v2u hv = xr[64 * q]; v[r][q] = (f32x4){pg8::f16_lo(hv.x), pg8::f16_hi(hv.x), pg8::f16_lo(hv.y), pg8::f16_hi(hv.y)}; } }
#pragma unroll
              for (int r = 0; r < 2; ++r) {
#pragma unroll
                  for (int q = 0; q < 4; ++q) ss[r] += (v[r][q].x * v[r][q].x + v[r][q].y * v[r][q].y) + (v[r][q].z * v[r][q].z + v[r][q].w * v[r][q].w);
                  const float rstd = rsqrtf(wave_sum(ss[r], ln) * (1.f / D) + EPS); GAS f32x4* o = (GAS f32x4*)(ap->out + (size_t)(m + r * NGW) * D) + ln;
#pragma unroll
                  for (int q = 0; q < 4; ++q) o[64 * q] = v[r][q] * rstd * gr[64 * q]; } } }
    }
#undef IN
#undef SEAM
#undef OPQ_LANE
#undef ROWLOOP
#undef OPQ_RANGE
#undef WSPTRS
#undef ULIST_FILL
#undef RSTD_TBL
}

extern "C" void kernel_launch(void* const* d_in, const int* in_sizes, int n_in, void* d_out, int out_size, void* d_ws, size_t ws_size, hipStream_t stream) {
    static int grid = 0;
    if (grid == 0) {
        if (n_in != 23 || out_size != M * D || ws_size < WS_END) { fprintf(stderr, "kernel_launch: unexpected sizes (n_in %d out %d ws %zu need %zu)\n", n_in, out_size, ws_size, (size_t)WS_END); grid = -1; return; }
        int dev = 0, cus = 0, per_cu = 0;
        if (hipGetDevice(&dev) != hipSuccess || hipDeviceGetAttribute(&cus, hipDeviceAttributeMultiprocessorCount, dev) != hipSuccess) { grid = -1; return; }
        if (hipFuncSetAttribute((const void*)mk_fwd, hipFuncAttributeMaxDynamicSharedMemorySize, LDS_BYTES) != hipSuccess) { fprintf(stderr, "hipFuncSetAttribute failed\n"); grid = -1; return; }
        if (hipOccupancyMaxActiveBlocksPerMultiprocessor(&per_cu, (const void*)mk_fwd, NWAVES * 64, LDS_BYTES) != hipSuccess || per_cu < 1) { fprintf(stderr, "occupancy query: %d\n", per_cu); }
        (void)hipGetLastError();
        if (cus != 256) { fprintf(stderr, "kernel_launch: built for a 256-CU device (one workgroup per CU; the unit deal and the row-rstd tables assume it), found %d CUs; nothing launched\n", cus); grid = -1; return; }
        grid = cus;
    }
    if (grid < 0) return;
    if (hipMemsetAsync((char*)d_ws + WS_CTL, 0, CTL_ZERO_BYTES, stream) != hipSuccess) return;
    Args a{};
    for (int i = 0; i < 23; ++i) a.in[i] = (const float*)d_in[i];
    a.out = (float*)d_out; a.ws = (unsigned char*)d_ws;
    int li = 0;
    auto run = [&](int lo, int hi) { a.ph_lo = lo; a.ph_hi = hi; a.li = li++; hipLaunchKernelGGL(mk_fwd, dim3(grid), dim3(NWAVES * 64), LDS_BYTES, stream, a); };

    run(PH_PRO, PH_END);
}
```

```cpp
#include <hip/hip_runtime.h>
#include <cstdio>
#include <cstdint>
#include <cmath>
#define DBG_STOP 0
namespace pg8 {
#define PG8_LAS __attribute__((address_space(3)))
typedef unsigned short bf16_t;
typedef short bf16x8 __attribute__((ext_vector_type(8)));
typedef float f32x4 __attribute__((ext_vector_type(4)));
typedef unsigned u32x4 __attribute__((ext_vector_type(4)));
constexpr int BM = 256, BK = 64, HALF = 128, HTB = HALF * BK * 2  , STAGE_BYTES = 8 * HTB, NXCD = 8, WGM = 8;

__host__ __device__ __forceinline__ int lds_byte(int r, int c) { const int st = (r >> 4) * 2 + (c >> 5), rr = r & 15, cc = c & 31, ob = rr * 64 + cc * 2; return st * 1024 + (ob ^ (((ob >> 9) & 1) << 5)); }
__host__ __device__ __forceinline__ void stage_rc(int b, int& R, int& C) { const int st = b / 1024, sb = b % 1024, swz = sb ^ (((sb >> 9) & 1) << 5); R = (st >> 1) * 16 + swz / 64; C = (st & 1) * 32 + (swz % 64) / 2; }
__host__ __device__ __forceinline__ int perm32(int rho) { const int n = rho >> 4, i = rho & 15; return 8 * (i >> 2) + 4 * n + (i & 3); }

struct Unit { int pm, pn; };
struct Gemm { const bf16_t* A; const bf16_t* Bt; int M, N, K; };

struct StaticOrder {
    int nM, nN, nwg, G, c;
    __host__ __device__ void init(int M, int N, int G_, int c_) { nM = M / BM; nN = N / BM; nwg = nM * nN; G = G_; c = c_; }
    __host__ __device__ bool next(int i, Unit& u) const {
        const long L = (long)i * G + c; if (L >= nwg) return false;
        int wgid = (int)L; { const int q = nwg / NXCD, r = nwg % NXCD, xcd = wgid % NXCD, off = wgid / NXCD; wgid = (xcd < r ? xcd * (q + 1) : r * (q + 1) + (xcd - r) * q) + off; }
        const int nig = WGM * nN, gid = wgid / nig, fm = gid * WGM, gsz = (nM - fm) < WGM ? (nM - fm) : WGM;
        u.pm = fm + ((wgid % nig) % gsz); u.pn = (wgid % nig) / gsz; return true;
    }
    __device__ __forceinline__ void a_ready(const Unit&) const {}
    __device__ __forceinline__ void done(const Unit&) const {}
};

__device__ __forceinline__ unsigned cvt_pk_bf16(float lo, float hi) { unsigned r; asm volatile("v_cvt_pk_bf16_f32 %0, %1, %2" : "=v"(r) : "v"(lo), "v"(hi)); return r; }
typedef float f32x2 __attribute__((ext_vector_type(2)));
__device__ __forceinline__ f32x2 gelu_pk(f32x2 v) {
    const f32x2 av = __builtin_elementwise_abs(v), d = av * 0.2316418882f + 1.0f;
    f32x2 t; t.x = __builtin_amdgcn_rcpf(d.x); t.y = __builtin_amdgcn_rcpf(d.y);
    f32x2 q = t * 0.5307027145f + (-0.7265760135f); q = q * t + 0.7107068705f; q = q * t + (-0.142248368f); q = q * t + 0.127414796f; q = q * t;
    const f32x2 s = (v * v) * (-0.72134752044f);
    f32x2 e; e.x = __builtin_amdgcn_exp2f(s.x); e.y = __builtin_amdgcn_exp2f(s.y);
    const f32x2 m = v * (q * e), r = v - m;
    f32x2 o; o.x = v.x < 0.f ? m.x : r.x; o.y = v.y < 0.f ? m.y : r.y; return o;
}

template <int ACT  > struct EpiBf16 {
    static constexpr bool PERM = true, AFTER_DRAIN = false; static_assert(ACT == 0 || ACT == 1, "EpiBf16: ACT is 0 (none) or 1 (gelu_pk)");
    bf16_t* O; int ldc; const float* bias; int split_cols; size_t split_stride; float scale0;
    __device__ __forceinline__ void operator()(const f32x4 (&acc)[2][2][4][2], const Unit& u, int wr, int wc, int fr, int fq) const {
        const int row0 = u.pm * BM + wr * 64 + fr; int colt = u.pn * BM; bf16_t* base = O;
        float sc = 1.f; if (split_cols) { const int t = colt / split_cols; base += (size_t)t * split_stride; colt -= t * split_cols; if (t == 0) sc = scale0; }
        const int col0 = colt + wc * 32 + 8 * fq, bcol0 = u.pn * BM + wc * 32 + 8 * fq;
        f32x4 bv[2][2];
#pragma unroll
        for (int bj = 0; bj < 2; ++bj)
#pragma unroll
            for (int n = 0; n < 2; ++n) bv[bj][n] = bias ? *(const f32x4*)(bias + bcol0 + bj * HALF + 4 * n) : (f32x4){0.f, 0.f, 0.f, 0.f};
#pragma unroll
        for (int ai = 0; ai < 2; ++ai)
#pragma unroll
            for (int m = 0; m < 4; ++m) { bf16_t* rowp = base + (size_t)(row0 + ai * HALF + m * 16) * ldc + col0;
#pragma unroll
                for (int bj = 0; bj < 2; ++bj) { f32x4 v0 = acc[ai][bj][m][0] + bv[bj][0], v1 = acc[ai][bj][m][1] + bv[bj][1];
                    if (ACT == 1) { f32x2 a = gelu_pk((f32x2){v0[0], v0[1]}), b = gelu_pk((f32x2){v0[2], v0[3]}), c = gelu_pk((f32x2){v1[0], v1[1]}), d = gelu_pk((f32x2){v1[2], v1[3]});
                        v0 = (f32x4){a.x, a.y, b.x, b.y}; v1 = (f32x4){c.x, c.y, d.x, d.y}; }
                    v0 = v0 * sc; v1 = v1 * sc; u32x4 w; w.x = cvt_pk_bf16(v0[0], v0[1]); w.y = cvt_pk_bf16(v0[2], v0[3]); w.z = cvt_pk_bf16(v1[0], v1[1]); w.w = cvt_pk_bf16(v1[2], v1[3]);
                    *(u32x4*)(rowp + bj * HALF) = w; } }
    }
};
typedef _Float16 pg8_h8 __attribute__((ext_vector_type(8)));
typedef int pg8_v8i __attribute__((ext_vector_type(8))); typedef int pg8_v4i __attribute__((ext_vector_type(4)));
__device__ __forceinline__ pg8_v8i pg8_ld8(const PG8_LAS unsigned char* p) { const pg8_v4i a = *(const PG8_LAS pg8_v4i*)p, c = *(const PG8_LAS pg8_v4i*)(p + 1024); return __builtin_shufflevector(a, c, 0, 1, 2, 3, 4, 5, 6, 7); }
template <class Epi, class Sched, bool ALIGN_EPI = false, bool SP2 = false, int DT = 0, bool MID = false>
__device__ __forceinline__ void gemm_phase(PG8_LAS unsigned char* lds, const Gemm g, const Sched& S, const Epi& E, int tid_in) {
    constexpr bool FP8 = (DT == 1);
    int tid_o = tid_in; asm volatile("" : "+v"(tid_o));
    const int tid = tid_o, wid = __builtin_amdgcn_readfirstlane(tid >> 6), lane = tid & 63, wr = wid >> 2, wc = wid & 3, fr = lane & 15, fq = lane >> 4;
    const int K = g.K, nt = K / BK;
    unsigned voffA[2], voffB[2];
#pragma unroll
    for (int i = 0; i < 2; ++i) { int R, C; stage_rc(tid * 16 + i * 8192, R, C); const int Rb = Epi::PERM ? ((R & ~31) + perm32(R & 31)) : R;
        voffA[i] = (unsigned)(R * K + C) * 2u; voffB[i] = (unsigned)(Rb * K + C) * 2u; }
    const size_t kstep = (size_t)(BK * 2);
    const size_t hstep = (size_t)HALF * K * 2;
    const size_t tstep = 2 * hstep;
    const unsigned ldsw = (unsigned)wid * 1024u;
    const int aoff = lds_byte(wr * 64 + fr, fq * 8), boff = lds_byte(wc * 32 + fr, fq * 8);
#define PG8_SA(b, h) (((b) * 2 + (h)) * HTB)
#define PG8_SB(b, h) ((4 + (b) * 2 + (h)) * HTB)
#define PG8_STAGE(bufoff, gbase, voff) do { _Pragma("unroll") for (int _i = 0; _i < 2; ++_i) \
        __builtin_amdgcn_global_load_lds((const unsigned*)((const char*)(gbase) + (voff)[_i]), (PG8_LAS unsigned*)(lds + (bufoff) + ldsw + _i * 8192), 16, 0, 0); } while (0)
#define PG8_LDA(dst, b, h) do { if constexpr (FP8) { _Pragma("unroll") for (int m = 0; m < 4; ++m) dst##8[m] = pg8_ld8(lds + PG8_SA(b, h) + aoff + m * 2048); } \
        else { _Pragma("unroll") for (int m = 0; m < 4; ++m) _Pragma("unroll") for (int k = 0; k < 2; ++k) dst[m][k] = *(const PG8_LAS bf16x8*)(lds + PG8_SA(b, h) + aoff + m * 2048 + k * 1024); } } while (0)
#define PG8_LDB(dst, b, h) do { if constexpr (FP8) { _Pragma("unroll") for (int n = 0; n < 2; ++n) dst##8[n] = pg8_ld8(lds + PG8_SB(b, h) + boff + n * 2048); } \
        else { _Pragma("unroll") for (int n = 0; n < 2; ++n) _Pragma("unroll") for (int k = 0; k < 2; ++k) dst[n][k] = *(const PG8_LAS bf16x8*)(lds + PG8_SB(b, h) + boff + n * 2048 + k * 1024); } } while (0)
#define PG8_MMA(ai, bj, At, Bt) do { __builtin_amdgcn_s_setprio(1); _Pragma("unroll") for (int m = 0; m < 4; ++m) _Pragma("unroll") for (int n = 0; n < 2; ++n) { \
        if constexpr (FP8) asm volatile("v_mfma_scale_f32_16x16x128_f8f6f4 %0, %1, %2, %0, %3, %3 op_sel_hi:[0,0,0]" : "+v"(acc[ai][bj][m][n]) : "v"(Bt##8[n]), "v"(At##8[m]), "v"(sc7f));     \
        else { _Pragma("unroll") for (int k = 0; k < 2; ++k) { if constexpr (DT == 2) acc[ai][bj][m][n] = __builtin_amdgcn_mfma_f32_16x16x32_f16(__builtin_bit_cast(pg8_h8, Bt[n][k]), __builtin_bit_cast(pg8_h8, At[m][k]), acc[ai][bj][m][n], 0, 0, 0); \
            else acc[ai][bj][m][n] = __builtin_amdgcn_mfma_f32_16x16x32_bf16(Bt[n][k], At[m][k], acc[ai][bj][m][n], 0, 0, 0); } } } __builtin_amdgcn_s_setprio(0); } while (0)
#define PG8_WAIT_V(n) asm volatile("s_waitcnt vmcnt(" #n ")" ::: "memory")
#define PG8_WAIT_L(n) asm volatile("s_waitcnt lgkmcnt(" #n ")" ::: "memory")
#define PG8_BAR __builtin_amdgcn_s_barrier()
#define PG8_SCHED __builtin_amdgcn_sched_barrier(0)
    Unit cur, nxt; int ui = 0;
    if (!S.next(0, cur)) return;
    f32x4 acc[2][2][4][2];
#pragma unroll
    for (int a = 0; a < 2; ++a)
#pragma unroll
        for (int b = 0; b < 2; ++b)
#pragma unroll
            for (int m = 0; m < 4; ++m)
#pragma unroll
                for (int n = 0; n < 2; ++n) acc[a][b][m][n] = (f32x4){0.f, 0.f, 0.f, 0.f};
    bf16x8 At[4][2], B0[2][2], B1[2][2];
    int sc7f = 0x7F7F7F7F; asm volatile("" : "+v"(sc7f));
    pg8_v8i At8[4], B08[2], B18[2];
    const char* cA = (const char*)g.A + (size_t)cur.pm * tstep; const char* cB = (const char*)g.Bt + (size_t)cur.pn * tstep;
    S.a_ready(cur);
    if constexpr (SP2) {
        PG8_STAGE(PG8_SB(0, 0), cB, voffB); PG8_STAGE(PG8_SB(0, 1), cB + hstep, voffB); PG8_STAGE(PG8_SA(0, 0), cA, voffA); PG8_STAGE(PG8_SA(0, 1), cA + hstep, voffA);
        if (wr == 1) PG8_BAR;
        PG8_WAIT_V(2); PG8_BAR;
        PG8_STAGE(PG8_SB(1, 0), cB + kstep, voffB); PG8_STAGE(PG8_SA(1, 0), cA + kstep, voffA); PG8_STAGE(PG8_SB(1, 1), cB + hstep + kstep, voffB);
        PG8_WAIT_V(6); PG8_BAR;
    } else {
        PG8_STAGE(PG8_SB(0, 0), cB, voffB); PG8_STAGE(PG8_SA(0, 0), cA, voffA); PG8_STAGE(PG8_SB(0, 1), cB + hstep, voffB); PG8_STAGE(PG8_SA(0, 1), cA + hstep, voffA);
        if (wr == 1) PG8_BAR;
        PG8_WAIT_V(4); PG8_BAR;
        PG8_STAGE(PG8_SB(1, 0), cB + kstep, voffB); PG8_STAGE(PG8_SA(1, 0), cA + kstep, voffA); PG8_STAGE(PG8_SB(1, 1), cB + hstep + kstep, voffB);
        PG8_WAIT_V(6); PG8_BAR;
    }
    for (;;) {
        const bool has_next = S.next(ui + 1, nxt);
        const char* nA = has_next ? (const char*)g.A + (size_t)nxt.pm * tstep : cA; const char* nB = has_next ? (const char*)g.Bt + (size_t)nxt.pn * tstep : cB;
        for (int t = 0; t < nt; t += 2) {
            if constexpr (MID) { if (t == (nt >> 1)) E.mid(acc, cur, wr, wc); }
            const bool last = (t == nt - 2);
            const char* a1 = cA + (size_t)(t + 1) * kstep;
            const char* a2 = last ? nA : cA + (size_t)(t + 2) * kstep; const char* b2 = last ? nB : cB + (size_t)(t + 2) * kstep;
            const char* a3 = a2 + kstep; const char* b3 = b2 + kstep;
            if (last && has_next) S.a_ready(nxt);
            if constexpr (SP2) {
            PG8_LDB(B0, 0, 0); PG8_LDB(B1, 0, 1); PG8_SCHED; PG8_LDA(At, 0, 0); PG8_STAGE(PG8_SA(1, 1), a1 + hstep, voffA);
            PG8_WAIT_V(8); PG8_WAIT_L(0); PG8_BAR; PG8_MMA(0, 0, At, B0); PG8_MMA(0, 1, At, B1); PG8_BAR; PG8_SCHED;
            PG8_LDA(At, 0, 1); PG8_STAGE(PG8_SB(0, 0), b2, voffB); PG8_STAGE(PG8_SB(0, 1), b2 + hstep, voffB); PG8_STAGE(PG8_SA(0, 0), a2, voffA);
            PG8_WAIT_V(8); PG8_WAIT_L(0); PG8_BAR; PG8_MMA(1, 0, At, B0); PG8_MMA(1, 1, At, B1); PG8_BAR; PG8_SCHED;
            PG8_LDB(B0, 1, 0); PG8_LDB(B1, 1, 1); PG8_SCHED; PG8_LDA(At, 1, 0); PG8_STAGE(PG8_SA(0, 1), a2 + hstep, voffA);
            PG8_WAIT_V(8); PG8_WAIT_L(0); PG8_BAR; PG8_MMA(0, 0, At, B0); PG8_MMA(0, 1, At, B1); PG8_BAR; PG8_SCHED;
            PG8_LDA(At, 1, 1); PG8_STAGE(PG8_SB(1, 0), b3, voffB); PG8_STAGE(PG8_SB(1, 1), b3 + hstep, voffB); PG8_STAGE(PG8_SA(1, 0), a3, voffA);
            PG8_WAIT_V(8); PG8_WAIT_L(0); PG8_BAR; PG8_MMA(1, 0, At, B0); PG8_MMA(1, 1, At, B1); PG8_BAR; PG8_SCHED;
            } else {
            PG8_LDB(B0, 0, 0); PG8_SCHED; PG8_LDA(At, 0, 0); PG8_STAGE(PG8_SA(1, 1), a1 + hstep, voffA);
            PG8_WAIT_L(8); PG8_BAR; PG8_WAIT_L(0); PG8_MMA(0, 0, At, B0); PG8_BAR; PG8_SCHED;
            PG8_LDB(B1, 0, 1); PG8_STAGE(PG8_SB(0, 0), b2, voffB);
            PG8_BAR; PG8_WAIT_L(0); PG8_MMA(0, 1, At, B1); PG8_BAR;
            PG8_LDA(At, 0, 1); PG8_STAGE(PG8_SA(0, 0), a2, voffA);
            PG8_BAR; PG8_WAIT_L(0); PG8_MMA(1, 0, At, B0); PG8_BAR; PG8_SCHED;
            PG8_STAGE(PG8_SB(0, 1), b2 + hstep, voffB);
            PG8_WAIT_V(6); PG8_BAR; PG8_MMA(1, 1, At, B1); PG8_BAR;
            PG8_LDB(B0, 1, 0); PG8_SCHED; PG8_LDA(At, 1, 0); PG8_STAGE(PG8_SA(0, 1), a2 + hstep, voffA);
            PG8_WAIT_L(8); PG8_BAR; PG8_WAIT_L(0); PG8_MMA(0, 0, At, B0); PG8_BAR; PG8_SCHED;
            PG8_LDB(B1, 1, 1); PG8_STAGE(PG8_SB(1, 0), b3, voffB);
            PG8_BAR; PG8_WAIT_L(0); PG8_MMA(0, 1, At, B1); PG8_BAR;
            PG8_LDA(At, 1, 1); PG8_STAGE(PG8_SA(1, 0), a3, voffA);
            PG8_BAR; PG8_WAIT_L(0); PG8_MMA(1, 0, At, B0); PG8_BAR; PG8_SCHED;
            PG8_STAGE(PG8_SB(1, 1), b3 + hstep, voffB);
            PG8_WAIT_V(6); PG8_BAR; PG8_MMA(1, 1, At, B1); PG8_BAR;
            }
        }
        if constexpr (FP8) asm volatile("s_nop 15\n\ts_nop 15" ::: "memory");
        if constexpr (ALIGN_EPI) { if (wr == 0) PG8_BAR; }
        if constexpr (!Epi::AFTER_DRAIN) { E(acc, cur, wr, wc, fr, fq); S.done(cur); }
        if (!has_next) break;
#pragma unroll
        for (int a = 0; a < 2; ++a)
#pragma unroll
            for (int b = 0; b < 2; ++b)
#pragma unroll
                for (int m = 0; m < 4; ++m)
#pragma unroll
                    for (int n = 0; n < 2; ++n) acc[a][b][m][n] = (f32x4){0.f, 0.f, 0.f, 0.f};
        cur = nxt; cA = nA; cB = nB; ++ui;
        if constexpr (ALIGN_EPI) { if (wr == 1) PG8_BAR; }
    }
    PG8_WAIT_V(0);
    if constexpr (!ALIGN_EPI) { if (wr == 0) PG8_BAR; }
    PG8_BAR;
    if constexpr (Epi::AFTER_DRAIN) { E.fused(acc, cur, wr, wc, fr, fq, lds, wid, lane); S.done(cur); }
#undef PG8_SA
#undef PG8_SB
#undef PG8_STAGE
#undef PG8_LDA
#undef PG8_LDB
#undef PG8_MMA
#undef PG8_WAIT_V
#undef PG8_WAIT_L
#undef PG8_BAR
#undef PG8_SCHED
}
}
namespace pg8 {
typedef unsigned u32x2 __attribute__((ext_vector_type(2)));
typedef float f32x2_t __attribute__((ext_vector_type(2))); typedef __bf16 bf16x2_t __attribute__((ext_vector_type(2)));
__device__ __forceinline__ unsigned cvtpk(float lo, float hi) { f32x2_t v = {lo, hi}; bf16x2_t b = __builtin_convertvector(v, bf16x2_t); return __builtin_bit_cast(unsigned, b); }
__device__ __forceinline__ float bf_lo(unsigned u) { return __uint_as_float(u << 16); }
__device__ __forceinline__ float bf_hi(unsigned u) { return __uint_as_float(u & 0xffff0000u); }
__device__ __forceinline__ float sigm(float x) { return __builtin_amdgcn_rcpf(1.f + __expf(-x)); }
__device__ __forceinline__ float silu(float x) { return x * sigm(x); }
typedef float f32x2v __attribute__((ext_vector_type(2)));
__device__ __forceinline__ f32x4 swiglu4(f32x4 a, f32x4 b, float k1, float k3) {
    const f32x2v a0 = {a[0], a[1]}, a1 = {a[2], a[3]}, b0 = {b[0], b[1]}, b1 = {b[2], b[3]};
    const f32x2v t0 = a0 * k1, t1 = a1 * k1;
    const f32x2v e0 = {__builtin_amdgcn_exp2f(t0[0]), __builtin_amdgcn_exp2f(t0[1])}, e1 = {__builtin_amdgcn_exp2f(t1[0]), __builtin_amdgcn_exp2f(t1[1])};
    const f32x2v d0 = e0 * k3 + k3, d1 = e1 * k3 + k3;
    const f32x2v r0 = {__builtin_amdgcn_rcpf(d0[0]), __builtin_amdgcn_rcpf(d0[1])}, r1 = {__builtin_amdgcn_rcpf(d1[0]), __builtin_amdgcn_rcpf(d1[1])};
    const f32x2v y0 = (a0 * b0) * r0, y1 = (a1 * b1) * r1;
    return (f32x4){y0[0], y0[1], y1[0], y1[1]};
}

template <int ADD> struct EpiGate {
    static constexpr bool PERM = true, AFTER_DRAIN = false;
    bf16_t* O; int ldc; const bf16_t* G; int ldg;
    __device__ __forceinline__ void operator()(const f32x4 (&acc)[2][2][4][2], const Unit& u, int wr, int wc, int fr, int fq) const {
        { int z_ = 0; asm volatile("" : "+v"(z_)); const int l_ = (int)__builtin_amdgcn_mbcnt_hi(~0u, __builtin_amdgcn_mbcnt_lo(~0u, (unsigned)z_)); fr = l_ & 15; fq = l_ >> 4; }
        const int row0 = u.pm * BM + wr * 64 + fr, col0 = u.pn * BM + wc * 32 + 8 * fq;
        u32x4 g[2][2][2], p[2][2][2];
#define EG_LOAD(bt, buf) _Pragma("unroll") for (int mm = 0; mm < 2; ++mm) _Pragma("unroll") for (int bj = 0; bj < 2; ++bj) { const size_t r = (size_t)(row0 + ((bt) >> 1) * HALF + (2 * ((bt) & 1) + mm) * 16); const int c = col0 + bj * HALF; \
            g[buf][mm][bj] = *(const u32x4*)(G + r * ldg + c); if (ADD) p[buf][mm][bj] = *(const u32x4*)(O + r * ldc + c); }
        EG_LOAD(0, 0);
#pragma unroll
        for (int bt = 0; bt < 4; ++bt) { const int buf = bt & 1, ai = bt >> 1, mp = bt & 1;
            if (bt == 0) { EG_LOAD(1, 1); } else if (bt == 1) { EG_LOAD(2, 0); } else if (bt == 2) { EG_LOAD(3, 1); }
#pragma unroll
            for (int mm = 0; mm < 2; ++mm)
#pragma unroll
                for (int bj = 0; bj < 2; ++bj) { const int m = 2 * mp + mm; const size_t r = (size_t)(row0 + ai * HALF + m * 16); const int c = col0 + bj * HALF;
                    const u32x4 gg = g[buf][mm][bj]; f32x4 v0 = acc[ai][bj][m][0], v1 = acc[ai][bj][m][1];
                    v0[0] *= sigm(bf_lo(gg.x)); v0[1] *= sigm(bf_hi(gg.x)); v0[2] *= sigm(bf_lo(gg.y)); v0[3] *= sigm(bf_hi(gg.y));
                    v1[0] *= sigm(bf_lo(gg.z)); v1[1] *= sigm(bf_hi(gg.z)); v1[2] *= sigm(bf_lo(gg.w)); v1[3] *= sigm(bf_hi(gg.w));
                    if (ADD) { const u32x4 pp = p[buf][mm][bj]; v0[0] += bf_lo(pp.x); v0[1] += bf_hi(pp.x); v0[2] += bf_lo(pp.y); v0[3] += bf_hi(pp.y);
                                                      v1[0] += bf_lo(pp.z); v1[1] += bf_hi(pp.z); v1[2] += bf_lo(pp.w); v1[3] += bf_hi(pp.w); }
                    u32x4 w; w.x = cvtpk(v0[0], v0[1]); w.y = cvtpk(v0[2], v0[3]); w.z = cvtpk(v1[0], v1[1]); w.w = cvtpk(v1[2], v1[3]);
                    *(u32x4*)(O + r * ldc + c) = w; }
        }
#undef EG_LOAD
    }
};
struct EpiRes {
    static constexpr bool PERM = false, AFTER_DRAIN = false;
    const float* base; float* out; int ldc;
    __device__ __forceinline__ void operator()(const f32x4 (&acc)[2][2][4][2], const Unit& u, int wr, int wc, int fr, int fq) const {
        const int row0 = u.pm * BM + wr * 64 + fr, col0 = u.pn * BM + wc * 32 + 4 * fq;
#pragma unroll
        for (int ai = 0; ai < 2; ++ai)
#pragma unroll
            for (int m = 0; m < 4; ++m) { const size_t off = (size_t)(row0 + ai * HALF + m * 16) * ldc + col0;
#pragma unroll
                for (int bj = 0; bj < 2; ++bj)
#pragma unroll
                    for (int n = 0; n < 2; ++n) { const f32x4 b = *(const f32x4*)(base + off + bj * HALF + n * 16); *(f32x4*)(out + off + bj * HALF + n * 16) = b + acc[ai][bj][m][n]; } }
    }
};
struct EpiSwiglu {
    static constexpr bool PERM = false, AFTER_DRAIN = false;
    bf16_t* O; int ldc; int nmod;
    __device__ __forceinline__ void operator()(const f32x4 (&acc)[2][2][4][2], const Unit& u, int wr, int wc, int fr, int fq) const {
        const int row0 = u.pm * BM + wr * 64 + fr, hc0 = (u.pn % nmod) * 128 + wc * 16 + 4 * fq;
#pragma unroll
        for (int ai = 0; ai < 2; ++ai)
#pragma unroll
            for (int m = 0; m < 4; ++m) { bf16_t* rowp = O + (size_t)(row0 + ai * HALF + m * 16) * ldc + hc0;
#pragma unroll
                for (int bj = 0; bj < 2; ++bj) { const f32x4 a = acc[ai][bj][m][0], b = acc[ai][bj][m][1];
                    u32x2 w; w.x = cvtpk(silu(a[0]) * b[0], silu(a[1]) * b[1]); w.y = cvtpk(silu(a[2]) * b[2], silu(a[3]) * b[3]);
                    *(u32x2*)(rowp + bj * 64) = w; } }
    }
};
struct EpiSigT {
    static constexpr bool PERM = false, AFTER_DRAIN = false;
    bf16_t* T; int ldc;
    __device__ __forceinline__ void operator()(const f32x4 (&acc)[2][2][4][2], const Unit& u, int wr, int wc, int fr, int fq) const {
        const int row0 = u.pm * BM + wr * 64 + fr, col0 = u.pn * BM + wc * 32 + 4 * fq;
#pragma unroll
        for (int ai = 0; ai < 2; ++ai)
#pragma unroll
            for (int m = 0; m < 4; ++m) { bf16_t* rowp = T + (size_t)(row0 + ai * HALF + m * 16) * ldc + col0;
#pragma unroll
                for (int bj = 0; bj < 2; ++bj)
#pragma unroll
                    for (int n = 0; n < 2; ++n) { const f32x4 a = acc[ai][bj][m][n]; u32x2 w; w.x = cvtpk(sigm(a[0]), sigm(a[1])); w.y = cvtpk(sigm(a[2]), sigm(a[3]));
                        *(u32x2*)(rowp + bj * HALF + n * 16) = w; } }
    }
};
struct EpiPle {
    static constexpr bool PERM = false, AFTER_DRAIN = false;
    const float* base; float* out; const bf16_t* T; int ldc;
    __device__ __forceinline__ void operator()(const f32x4 (&acc)[2][2][4][2], const Unit& u, int wr, int wc, int fr, int fq) const {
        const int row0 = u.pm * BM + wr * 64 + fr, col0 = u.pn * BM + wc * 32 + 4 * fq;
#pragma unroll
        for (int ai = 0; ai < 2; ++ai)
#pragma unroll
            for (int m = 0; m < 4; ++m) { const size_t off = (size_t)(row0 + ai * HALF + m * 16) * ldc + col0;
#pragma unroll
                for (int bj = 0; bj < 2; ++bj)
#pragma unroll
                    for (int n = 0; n < 2; ++n) { const size_t o = off + bj * HALF + n * 16; const u32x2 t = *(const u32x2*)(T + o); const f32x4 b = *(const f32x4*)(base + o); const f32x4 a = acc[ai][bj][m][n];
                        f32x4 r; r[0] = b[0] + bf_lo(t.x) * a[0]; r[1] = b[1] + bf_hi(t.x) * a[1]; r[2] = b[2] + bf_lo(t.y) * a[2]; r[3] = b[3] + bf_hi(t.y) * a[3];
                        *(f32x4*)(out + o) = r; } }
    }
};
struct EpiMoeDown {
    static constexpr bool PERM = true, AFTER_DRAIN = false;
    bf16_t* Y; int ldc; const float* gw; int nmod; float sc;
    __device__ __forceinline__ void operator()(const f32x4 (&acc)[2][2][4][2], const Unit& u, int wr, int wc, int fr, int fq) const {
        const int row0 = u.pm * BM + wr * 64 + fr, col0 = (u.pn % nmod) * BM + wc * 32 + 8 * fq;
#pragma unroll
        for (int ai = 0; ai < 2; ++ai)
#pragma unroll
            for (int m = 0; m < 4; ++m) { const size_t r = (size_t)(row0 + ai * HALF + m * 16); const float s = gw[r] * sc; bf16_t* rowp = Y + r * ldc + col0;
#pragma unroll
                for (int bj = 0; bj < 2; ++bj) { const f32x4 v0 = acc[ai][bj][m][0] * s, v1 = acc[ai][bj][m][1] * s;
                    u32x4 w; w.x = cvtpk(v0[0], v0[1]); w.y = cvtpk(v0[2], v0[3]); w.z = cvtpk(v1[0], v1[1]); w.w = cvtpk(v1[2], v1[3]);
                    *(u32x4*)(rowp + bj * HALF) = w; } }
    }
};

__device__ __forceinline__ float row_rstd(const float* ssp, size_t row) {
    const f32x4* p = (const f32x4*)(ssp + row * 16); const f32x4 a = p[0], b = p[1], c = p[2], d = p[3];
    const float s = (((a[0] + a[1]) + (a[2] + a[3])) + ((b[0] + b[1]) + (b[2] + b[3]))) + (((c[0] + c[1]) + (c[2] + c[3])) + ((d[0] + d[1]) + (d[2] + d[3])));
    return rsqrtf(s * (1.f / 1024.f) + 1e-6f);
}
__device__ __forceinline__ float xor_add(float v, int lane, int o) { return v + __builtin_bit_cast(float, __builtin_amdgcn_ds_bpermute((lane ^ o) << 2, __builtin_bit_cast(int, v))); }
struct EpiZn {
    static constexpr bool PERM = true, AFTER_DRAIN = false;
    bf16_t* O; int ldc; const float* ssp; const PG8_LAS float* tbl; int tpm;
    __device__ __forceinline__ void operator()(const f32x4 (&acc)[2][2][4][2], const Unit& u, int wr, int wc, int fr, int fq) const {
        const int row0 = u.pm * BM + wr * 64 + fr, col0 = u.pn * BM + wc * 32 + 8 * fq;
#pragma unroll
        for (int ai = 0; ai < 2; ++ai)
#pragma unroll
            for (int m = 0; m < 4; ++m) { const size_t r = (size_t)(row0 + ai * HALF + m * 16); const float s = tbl[wr * 64 + fr + ai * HALF + m * 16];     bf16_t* rowp = O + r * ldc + col0;
#pragma unroll
                for (int bj = 0; bj < 2; ++bj) { const f32x4 v0 = acc[ai][bj][m][0] * s, v1 = acc[ai][bj][m][1] * s;
                    u32x4 w; w.x = cvtpk(v0[0], v0[1]); w.y = cvtpk(v0[2], v0[3]); w.z = cvtpk(v1[0], v1[1]); w.w = cvtpk(v1[2], v1[3]);
                    *(u32x4*)(rowp + bj * HALF) = w; } }
    }
};
struct EpiSwigluN {
    static constexpr bool PERM = false, AFTER_DRAIN = false;
    bf16_t* O; int ldc; const float* ssp; const PG8_LAS float* tbl; int tpm;
    __device__ __forceinline__ void operator()(const f32x4 (&acc)[2][2][4][2], const Unit& u, int wr, int wc, int fr, int fq) const {
        const int row0 = u.pm * BM + wr * 64 + fr, hc0 = u.pn * 128 + wc * 16 + 4 * fq;
#pragma unroll
        for (int ai = 0; ai < 2; ++ai)
#pragma unroll
            for (int m = 0; m < 4; ++m) { const size_t r = (size_t)(row0 + ai * HALF + m * 16); const float s = tbl[wr * 64 + fr + ai * HALF + m * 16];     bf16_t* rowp = O + r * ldc + hc0; const float k1 = s * -1.44269504f, k3 = __builtin_amdgcn_rcpf(s * s);
#pragma unroll
                for (int bj = 0; bj < 2; ++bj) { const f32x4 y = swiglu4(acc[ai][bj][m][0], acc[ai][bj][m][1], k1, k3);
                    u32x2 w; w.x = cvtpk(y[0], y[1]); w.y = cvtpk(y[2], y[3]);
                    *(u32x2*)(rowp + bj * 64) = w; } }
    }
};
struct EpiSigTN {
    static constexpr bool PERM = false, AFTER_DRAIN = false;
    bf16_t* T; int ldc; const float* ssp; const PG8_LAS float* tbl; int tpm;
    __device__ __forceinline__ void operator()(const f32x4 (&acc)[2][2][4][2], const Unit& u, int wr, int wc, int fr, int fq) const {
        const int row0 = u.pm * BM + wr * 64 + fr, col0 = u.pn * BM + wc * 32 + 4 * fq;
#pragma unroll
        for (int ai = 0; ai < 2; ++ai)
#pragma unroll
            for (int m = 0; m < 4; ++m) { const size_t r = (size_t)(row0 + ai * HALF + m * 16); const float s = tbl[wr * 64 + fr + ai * HALF + m * 16];     bf16_t* rowp = T + r * ldc + col0;
#pragma unroll
                for (int bj = 0; bj < 2; ++bj)
#pragma unroll
                    for (int n = 0; n < 2; ++n) { const f32x4 a = acc[ai][bj][m][n] * s; u32x2 w; w.x = cvtpk(sigm(a[0]), sigm(a[1])); w.y = cvtpk(sigm(a[2]), sigm(a[3]));
                        *(u32x2*)(rowp + bj * HALF + n * 16) = w; } }
    }
};
struct EpiResSS {
    static constexpr bool PERM = false, AFTER_DRAIN = false;
    const float* base; float* out; bf16_t* hb; float* ssp; int ldc;
    __device__ __forceinline__ void operator()(const f32x4 (&acc)[2][2][4][2], const Unit& u, int wr, int wc, int fr, int fq) const {
        { int z_ = 0; asm volatile("" : "+v"(z_)); const int l_ = (int)__builtin_amdgcn_mbcnt_hi(~0u, __builtin_amdgcn_mbcnt_lo(~0u, (unsigned)z_)); fr = l_ & 15; fq = l_ >> 4; }
        const int row0 = u.pm * BM + wr * 64 + fr, col0 = u.pn * BM + wc * 32 + 4 * fq, lane = fq * 16 + fr;
#pragma unroll
        for (int ai = 0; ai < 2; ++ai)
#pragma unroll
            for (int mp = 0; mp < 2; ++mp) {
                f32x4 bsv[2][2][2];
#pragma unroll
                for (int mm = 0; mm < 2; ++mm)
#pragma unroll
                    for (int bj = 0; bj < 2; ++bj)
#pragma unroll
                        for (int n = 0; n < 2; ++n) bsv[mm][bj][n] = *(const f32x4*)(base + (size_t)(row0 + ai * HALF + (2 * mp + mm) * 16) * ldc + col0 + bj * HALF + n * 16);
#pragma unroll
                for (int mm = 0; mm < 2; ++mm) { const int m = 2 * mp + mm; const size_t r = (size_t)(row0 + ai * HALF + m * 16), off = r * ldc + col0; float ss = 0.f;
#pragma unroll
                    for (int bj = 0; bj < 2; ++bj)
#pragma unroll
                        for (int n = 0; n < 2; ++n) { const size_t o = off + bj * HALF + n * 16; const f32x4 v = bsv[mm][bj][n] + acc[ai][bj][m][n]; *(f32x4*)(out + o) = v;
                            u32x2 w; w.x = cvtpk(v[0], v[1]); w.y = cvtpk(v[2], v[3]); *(u32x2*)(hb + o) = w; ss += (v[0] * v[0] + v[1] * v[1]) + (v[2] * v[2] + v[3] * v[3]); }
                    ss = xor_add(ss, lane, 16); ss = xor_add(ss, lane, 32);
                    if (fq == 0) ssp[r * 16 + (u.pn & 3) * 4 + wc] = ss; }
                asm volatile("" ::: "memory");
            }
    }
};
struct EpiPleSS {
    static constexpr bool PERM = false, AFTER_DRAIN = false;
    const float* base; float* out; const bf16_t* T; bf16_t* hb; float* ssp; int ldc;
    __device__ __forceinline__ void operator()(const f32x4 (&acc)[2][2][4][2], const Unit& u, int wr, int wc, int fr, int fq) const {
        { int z_ = 0; asm volatile("" : "+v"(z_)); const int l_ = (int)__builtin_amdgcn_mbcnt_hi(~0u, __builtin_amdgcn_mbcnt_lo(~0u, (unsigned)z_)); fr = l_ & 15; fq = l_ >> 4; }
        const int row0 = u.pm * BM + wr * 64 + fr, col0 = u.pn * BM + wc * 32 + 4 * fq, lane = fq * 16 + fr;
#pragma unroll
        for (int ai = 0; ai < 2; ++ai)
#pragma unroll
            for (int mp = 0; mp < 2; ++mp) {
                f32x4 bsv[2][2][2]; u32x2 tv[2][2][2];
#pragma unroll
                for (int mm = 0; mm < 2; ++mm)
#pragma unroll
                    for (int bj = 0; bj < 2; ++bj)
#pragma unroll
                        for (int n = 0; n < 2; ++n) { const size_t o = (size_t)(row0 + ai * HALF + (2 * mp + mm) * 16) * ldc + col0 + bj * HALF + n * 16; bsv[mm][bj][n] = *(const f32x4*)(base + o); tv[mm][bj][n] = *(const u32x2*)(T + o); }
#pragma unroll
                for (int mm = 0; mm < 2; ++mm) { const int m = 2 * mp + mm; const size_t r = (size_t)(row0 + ai * HALF + m * 16), off = r * ldc + col0; float ss = 0.f;
#pragma unroll
                    for (int bj = 0; bj < 2; ++bj)
#pragma unroll
                        for (int n = 0; n < 2; ++n) { const size_t o = off + bj * HALF + n * 16; const u32x2 t = tv[mm][bj][n]; const f32x4 b = bsv[mm][bj][n]; const f32x4 a = acc[ai][bj][m][n];
                            f32x4 v; v[0] = b[0] + bf_lo(t.x) * a[0]; v[1] = b[1] + bf_hi(t.x) * a[1]; v[2] = b[2] + bf_lo(t.y) * a[2]; v[3] = b[3] + bf_hi(t.y) * a[3];
                            *(f32x4*)(out + o) = v; u32x2 w; w.x = cvtpk(v[0], v[1]); w.y = cvtpk(v[2], v[3]); *(u32x2*)(hb + o) = w; ss += (v[0] * v[0] + v[1] * v[1]) + (v[2] * v[2] + v[3] * v[3]); }
                    ss = xor_add(ss, lane, 16); ss = xor_add(ss, lane, 32);
                    if (fq == 0) ssp[r * 16 + (u.pn & 3) * 4 + wc] = ss; }
                asm volatile("" ::: "memory");
            }
    }
};

__device__ __forceinline__ unsigned pk4_fp8(float a, float b, float c, float d) { int w = 0; w = __builtin_amdgcn_cvt_pk_fp8_f32(a, b, w, false); w = __builtin_amdgcn_cvt_pk_fp8_f32(c, d, w, true); return (unsigned)w; }
__device__ __forceinline__ u32x4 xpose4(unsigned d0, unsigned d1, unsigned d2, unsigned d3) {
    const auto s01 = __builtin_amdgcn_permlane16_swap(d0, d1, false, false), s23 = __builtin_amdgcn_permlane16_swap(d2, d3, false, false);
    const auto t02 = __builtin_amdgcn_permlane32_swap(s01[0], s23[0], false, false), t13 = __builtin_amdgcn_permlane32_swap(s01[1], s23[1], false, false);
    u32x4 q; q.x = t02[0]; q.y = t13[0]; q.z = t02[1]; q.w = t13[1]; return q;
}
struct EpiSwiglu8 {
    static constexpr bool PERM = false, AFTER_DRAIN = false;
    unsigned char* O; int ldc; int nmod; float sc;
    __device__ __forceinline__ void operator()(const f32x4 (&acc)[2][2][4][2], const Unit& u, int wr, int wc, int fr, int fq) const {
        const int row0 = u.pm * BM + wr * 64 + fr, hc0 = (u.pn % nmod) * 128 + wc * 16;
        const float k1 = sc * -1.44269504f, k3 = 1.f / (4.f * sc * sc);
#pragma unroll
        for (int ai = 0; ai < 2; ++ai)
#pragma unroll
            for (int bj = 0; bj < 2; ++bj) { unsigned d[4];
#pragma unroll
                for (int m = 0; m < 4; ++m) { const f32x4 y = swiglu4(acc[ai][bj][m][0], acc[ai][bj][m][1], k1, k3);
                    d[m] = pk4_fp8(y[0], y[1], y[2], y[3]); }
                const u32x4 q = xpose4(d[0], d[1], d[2], d[3]);
                *(u32x4*)(O + (size_t)(row0 + ai * HALF + 16 * fq) * ldc + hc0 + bj * 64) = q; }
    }
};

struct EpiPleFused {
    static constexpr bool PERM = false, AFTER_DRAIN = false;
    const float* base; float* out; const bf16_t* PP; bf16_t* hb; float* ssp; int ldc; const PG8_LAS float* tbl;
    __device__ __forceinline__ void operator()(const f32x4 (&acc)[2][2][4][2], const Unit& u, int wr, int wc, int fr, int fq) const {
        { int z_ = 0; asm volatile("" : "+v"(z_)); const int l_ = (int)__builtin_amdgcn_mbcnt_hi(~0u, __builtin_amdgcn_mbcnt_lo(~0u, (unsigned)z_)); fr = l_ & 15; fq = l_ >> 4; }
        const int row0 = u.pm * BM + wr * 64 + fr, col0 = u.pn * BM + wc * 32 + 4 * fq, lane = fq * 16 + fr;
#pragma unroll
        for (int ai = 0; ai < 2; ++ai)
#pragma unroll
            for (int mp = 0; mp < 2; ++mp) {
                f32x4 bsv[2][2][2]; u32x2 tv[2][2][2];
#pragma unroll
                for (int mm = 0; mm < 2; ++mm)
#pragma unroll
                    for (int bj = 0; bj < 2; ++bj)
#pragma unroll
                        for (int n = 0; n < 2; ++n) { const size_t o = (size_t)(row0 + ai * HALF + (2 * mp + mm) * 16) * ldc + col0 + bj * HALF + n * 16; bsv[mm][bj][n] = *(const f32x4*)(base + o); tv[mm][bj][n] = *(const u32x2*)(PP + o); }
#pragma unroll
                for (int mm = 0; mm < 2; ++mm) { const int m = 2 * mp + mm; const size_t r = (size_t)(row0 + ai * HALF + m * 16), off = r * ldc + col0; float ss = 0.f;
                    const float rs = tbl[wr * 64 + fr + ai * HALF + m * 16];
#pragma unroll
                    for (int bj = 0; bj < 2; ++bj)
#pragma unroll
                        for (int n = 0; n < 2; ++n) { const size_t o = off + bj * HALF + n * 16; const u32x2 t = tv[mm][bj][n]; const f32x4 b = bsv[mm][bj][n]; const f32x4 a = acc[ai][bj][m][n] * rs;
                            f32x4 v; v[0] = b[0] + bf_lo(t.x) * sigm(a[0]); v[1] = b[1] + bf_hi(t.x) * sigm(a[1]); v[2] = b[2] + bf_lo(t.y) * sigm(a[2]); v[3] = b[3] + bf_hi(t.y) * sigm(a[3]);
                            *(f32x4*)(out + o) = v; u32x2 w; w.x = cvtpk(v[0], v[1]); w.y = cvtpk(v[2], v[3]); *(u32x2*)(hb + o) = w; ss += (v[0] * v[0] + v[1] * v[1]) + (v[2] * v[2] + v[3] * v[3]); }
                    ss = xor_add(ss, lane, 16); ss = xor_add(ss, lane, 32);
                    if (fq == 0) ssp[r * 16 + (u.pn & 3) * 4 + wc] = ss; }
                asm volatile("" ::: "memory");
            }
    }
};
struct SubOrder {
    int j, nsub, n;
    __device__ __forceinline__ bool next(int i, Unit& u) const { if (j < 0) return false; const int L = i * nsub + j; if (L >= n) return false; u.pm = L >> 2; u.pn = L & 3; return true; }
    __device__ __forceinline__ void a_ready(const Unit&) const {}
    __device__ __forceinline__ void done(const Unit&) const {}
};

typedef _Float16 h16x2 __attribute__((ext_vector_type(2)));
__device__ __forceinline__ unsigned pk_f16(float a, float b) { const h16x2 v = {(_Float16)a, (_Float16)b}; return __builtin_bit_cast(unsigned, v); }
__device__ __forceinline__ float f16_lo(unsigned u) { return (float)__builtin_bit_cast(h16x2, u)[0]; }
__device__ __forceinline__ float f16_hi(unsigned u) { return (float)__builtin_bit_cast(h16x2, u)[1]; }
struct EpiResH {
    static constexpr bool PERM = true, AFTER_DRAIN = false;
    const unsigned short* base; unsigned short* out; float* ssp; int ldc; float sc;
    __device__ __forceinline__ void operator()(const f32x4 (&acc)[2][2][4][2], const Unit& u, int wr, int wc, int fr, int fq) const {
        { int z_ = 0; asm volatile("" : "+v"(z_)); const int l_ = (int)__builtin_amdgcn_mbcnt_hi(~0u, __builtin_amdgcn_mbcnt_lo(~0u, (unsigned)z_)); fr = l_ & 15; fq = l_ >> 4; }
        const int row0 = u.pm * BM + wr * 64 + fr, col0 = u.pn * BM + wc * 32 + 8 * fq, lane = fq * 16 + fr;
#pragma unroll
        for (int ai = 0; ai < 2; ++ai)
#pragma unroll
            for (int mp = 0; mp < 2; ++mp) {
                u32x4 bsv[2][2];
#pragma unroll
                for (int mm = 0; mm < 2; ++mm)
#pragma unroll
                    for (int bj = 0; bj < 2; ++bj) bsv[mm][bj] = *(const u32x4*)(base + (size_t)(row0 + ai * HALF + (2 * mp + mm) * 16) * ldc + col0 + bj * HALF);
#pragma unroll
                for (int mm = 0; mm < 2; ++mm) { const int m = 2 * mp + mm; const size_t r = (size_t)(row0 + ai * HALF + m * 16), off = r * ldc + col0; float ss = 0.f;
#pragma unroll
                    for (int bj = 0; bj < 2; ++bj) { const u32x4 b = bsv[mm][bj]; const f32x4 a0 = acc[ai][bj][m][0] * sc, a1 = acc[ai][bj][m][1] * sc;
                        f32x4 v0, v1; v0[0] = f16_lo(b.x) + a0[0]; v0[1] = f16_hi(b.x) + a0[1]; v0[2] = f16_lo(b.y) + a0[2]; v0[3] = f16_hi(b.y) + a0[3];
                        v1[0] = f16_lo(b.z) + a1[0]; v1[1] = f16_hi(b.z) + a1[1]; v1[2] = f16_lo(b.w) + a1[2]; v1[3] = f16_hi(b.w) + a1[3];
                        u32x4 w; w.x = pk_f16(v0[0], v0[1]); w.y = pk_f16(v0[2], v0[3]); w.z = pk_f16(v1[0], v1[1]); w.w = pk_f16(v1[2], v1[3]); *(u32x4*)(out + off + bj * HALF) = w;
                        ss += ((v0[0] * v0[0] + v0[1] * v0[1]) + (v0[2] * v0[2] + v0[3] * v0[3])) + ((v1[0] * v1[0] + v1[1] * v1[1]) + (v1[2] * v1[2] + v1[3] * v1[3])); }
                    ss = xor_add(ss, lane, 16); ss = xor_add(ss, lane, 32);
                    if (fq == 0) ssp[r * 16 + (u.pn & 3) * 4 + wc] = ss; }
                asm volatile("" ::: "memory");
            }
    }
};
struct EpiPleH {
    static constexpr bool PERM = true, AFTER_DRAIN = false;
    const unsigned short* base; unsigned short* out; const bf16_t* PP; float* ssp; int ldc; const PG8_LAS float* tbl;
    __device__ __forceinline__ void operator()(const f32x4 (&acc)[2][2][4][2], const Unit& u, int wr, int wc, int fr, int fq) const {
        { int z_ = 0; asm volatile("" : "+v"(z_)); const int l_ = (int)__builtin_amdgcn_mbcnt_hi(~0u, __builtin_amdgcn_mbcnt_lo(~0u, (unsigned)z_)); fr = l_ & 15; fq = l_ >> 4; }
        const int row0 = u.pm * BM + wr * 64 + fr, col0 = u.pn * BM + wc * 32 + 8 * fq, lane = fq * 16 + fr;
#pragma unroll
        for (int ai = 0; ai < 2; ++ai)
#pragma unroll
            for (int mp = 0; mp < 2; ++mp) {
                u32x4 bsv[2][2], tv[2][2];
#pragma unroll
                for (int mm = 0; mm < 2; ++mm)
#pragma unroll
                    for (int bj = 0; bj < 2; ++bj) { const size_t o = (size_t)(row0 + ai * HALF + (2 * mp + mm) * 16) * ldc + col0 + bj * HALF; bsv[mm][bj] = *(const u32x4*)(base + o); tv[mm][bj] = *(const u32x4*)(PP + o); }
#pragma unroll
                for (int mm = 0; mm < 2; ++mm) { const int m = 2 * mp + mm; const size_t r = (size_t)(row0 + ai * HALF + m * 16), off = r * ldc + col0; float ss = 0.f;
                    const float rs = tbl[wr * 64 + fr + ai * HALF + m * 16];
#pragma unroll
                    for (int bj = 0; bj < 2; ++bj) { const u32x4 t = tv[mm][bj], b = bsv[mm][bj]; const f32x4 a0 = acc[ai][bj][m][0] * rs, a1 = acc[ai][bj][m][1] * rs;
                        f32x4 v0, v1; v0[0] = f16_lo(b.x) + bf_lo(t.x) * sigm(a0[0]); v0[1] = f16_hi(b.x) + bf_hi(t.x) * sigm(a0[1]); v0[2] = f16_lo(b.y) + bf_lo(t.y) * sigm(a0[2]); v0[3] = f16_hi(b.y) + bf_hi(t.y) * sigm(a0[3]);
                        v1[0] = f16_lo(b.z) + bf_lo(t.z) * sigm(a1[0]); v1[1] = f16_hi(b.z) + bf_hi(t.z) * sigm(a1[1]); v1[2] = f16_lo(b.w) + bf_lo(t.w) * sigm(a1[2]); v1[3] = f16_hi(b.w) + bf_hi(t.w) * sigm(a1[3]);
                        u32x4 w; w.x = pk_f16(v0[0], v0[1]); w.y = pk_f16(v0[2], v0[3]); w.z = pk_f16(v1[0], v1[1]); w.w = pk_f16(v1[2], v1[3]); *(u32x4*)(out + off + bj * HALF) = w;
                        ss += ((v0[0] * v0[0] + v0[1] * v0[1]) + (v0[2] * v0[2] + v0[3] * v0[3])) + ((v1[0] * v1[0] + v1[1] * v1[1]) + (v1[2] * v1[2] + v1[3] * v1[3])); }
                    ss = xor_add(ss, lane, 16); ss = xor_add(ss, lane, 32);
                    if (fq == 0) ssp[r * 16 + (u.pn & 3) * 4 + wc] = ss; }
                asm volatile("" ::: "memory");
            }
    }
};

struct EpiBfPlain {
    static constexpr bool PERM = true, AFTER_DRAIN = false;
    bf16_t* O; int ldc;
    __device__ __forceinline__ void operator()(const f32x4 (&acc)[2][2][4][2], const Unit& u, int wr, int wc, int fr, int fq) const {
        { int z_ = 0; asm volatile("" : "+v"(z_)); const int l_ = (int)__builtin_amdgcn_mbcnt_hi(~0u, __builtin_amdgcn_mbcnt_lo(~0u, (unsigned)z_)); fr = l_ & 15; fq = l_ >> 4; }
        const int row0 = u.pm * BM + wr * 64 + fr, col0 = u.pn * BM + wc * 32 + 8 * fq;
#pragma unroll
        for (int ai = 0; ai < 2; ++ai)
#pragma unroll
            for (int m = 0; m < 4; ++m) { bf16_t* rowp = O + (size_t)(row0 + ai * HALF + m * 16) * ldc + col0;
#pragma unroll
                for (int bj = 0; bj < 2; ++bj) { const f32x4 v0 = acc[ai][bj][m][0], v1 = acc[ai][bj][m][1];
                    u32x4 w; w.x = cvtpk(v0[0], v0[1]); w.y = cvtpk(v0[2], v0[3]); w.z = cvtpk(v1[0], v1[1]); w.w = cvtpk(v1[2], v1[3]);
                    *(u32x4*)(rowp + bj * HALF) = w; } }
    }
};

struct EpiZG {
    static constexpr bool PERM = true, AFTER_DRAIN = false;
    bf16_t* O; int ldc; unsigned char* GZ; const PG8_LAS float* tbl;
    __device__ __forceinline__ void operator()(const f32x4 (&acc)[2][2][4][2], const Unit& u, int wr, int wc, int fr, int fq) const {
        const int row0 = u.pm * BM + wr * 64 + fr;
        if (u.pn < 11) { const int col0 = u.pn * BM + wc * 32 + 8 * fq;
#pragma unroll
            for (int ai = 0; ai < 2; ++ai)
#pragma unroll
                for (int m = 0; m < 4; ++m) { const size_t r = (size_t)(row0 + ai * HALF + m * 16); const float s = tbl[wr * 64 + fr + ai * HALF + m * 16]; bf16_t* rowp = O + r * ldc + col0;
#pragma unroll
                    for (int bj = 0; bj < 2; ++bj) { const f32x4 v0 = acc[ai][bj][m][0] * s, v1 = acc[ai][bj][m][1] * s;
                        u32x4 w; w.x = cvtpk(v0[0], v0[1]); w.y = cvtpk(v0[2], v0[3]); w.z = cvtpk(v1[0], v1[1]); w.w = cvtpk(v1[2], v1[3]);
                        *(u32x4*)(rowp + bj * HALF) = w; } }
        } else { const int col0 = (u.pn - 11) * BM + wc * 32 + 8 * fq;
#pragma unroll
            for (int ai = 0; ai < 2; ++ai)
#pragma unroll
                for (int m = 0; m < 4; ++m) { const size_t r = (size_t)(row0 + ai * HALF + m * 16); const float s = tbl[wr * 64 + fr + ai * HALF + m * 16]; unsigned char* rowp = GZ + r * 2048 + col0;
#pragma unroll
                    for (int bj = 0; bj < 2; ++bj) { const f32x4 v0 = acc[ai][bj][m][0] * s, v1 = acc[ai][bj][m][1] * s;
                        unsigned q[8];
#pragma unroll
                        for (int i = 0; i < 4; ++i) { q[i] = (unsigned)(sigm(v0[i]) * 255.f + 0.5f); q[4 + i] = (unsigned)(sigm(v1[i]) * 255.f + 0.5f); if (u.pn >= 15) { q[i] = q[i] < 1u ? 1u : q[i]; q[4 + i] = q[4 + i] < 1u ? 1u : q[4 + i]; } }
                        u32x2 w; w.x = q[0] | (q[1] << 8) | (q[2] << 16) | (q[3] << 24); w.y = q[4] | (q[5] << 8) | (q[6] << 16) | (q[7] << 24);
                        *(u32x2*)(rowp + bj * HALF) = w; } }
        }
    }
};
template <int ADD> struct EpiGate8 {
    static constexpr bool PERM = true, AFTER_DRAIN = false;
    bf16_t* O; int ldc; const unsigned char* G; int ldg;
    __device__ __forceinline__ void operator()(const f32x4 (&acc)[2][2][4][2], const Unit& u, int wr, int wc, int fr, int fq) const {
        { int z_ = 0; asm volatile("" : "+v"(z_)); const int l_ = (int)__builtin_amdgcn_mbcnt_hi(~0u, __builtin_amdgcn_mbcnt_lo(~0u, (unsigned)z_)); fr = l_ & 15; fq = l_ >> 4; }
        const int row0 = u.pm * BM + wr * 64 + fr, col0 = u.pn * BM + wc * 32 + 8 * fq;
#pragma unroll
        for (int ai = 0; ai < 2; ++ai) {
            u32x2 g[4][2]; u32x4 p[4][2];
#pragma unroll
            for (int m = 0; m < 4; ++m)
#pragma unroll
                for (int bj = 0; bj < 2; ++bj) { const size_t r = (size_t)(row0 + ai * HALF + m * 16); const int c = col0 + bj * HALF;
                    g[m][bj] = *(const u32x2*)(G + r * ldg + c); if (ADD) p[m][bj] = *(const u32x4*)(O + r * ldc + c); }
#pragma unroll
            for (int m = 0; m < 4; ++m)
#pragma unroll
                for (int bj = 0; bj < 2; ++bj) { const size_t r = (size_t)(row0 + ai * HALF + m * 16); const int c = col0 + bj * HALF;
                    const u32x2 gg = g[m][bj]; f32x4 v0 = acc[ai][bj][m][0], v1 = acc[ai][bj][m][1]; const float k = 1.f / 255.f;
                    v0[0] *= (float)(gg.x & 255u) * k; v0[1] *= (float)((gg.x >> 8) & 255u) * k; v0[2] *= (float)((gg.x >> 16) & 255u) * k; v0[3] *= (float)(gg.x >> 24) * k;
                    v1[0] *= (float)(gg.y & 255u) * k; v1[1] *= (float)((gg.y >> 8) & 255u) * k; v1[2] *= (float)((gg.y >> 16) & 255u) * k; v1[3] *= (float)(gg.y >> 24) * k;
                    if (ADD) { const u32x4 pp = p[m][bj]; v0[0] += bf_lo(pp.x); v0[1] += bf_hi(pp.x); v0[2] += bf_lo(pp.y); v0[3] += bf_hi(pp.y);
                                                      v1[0] += bf_lo(pp.z); v1[1] += bf_hi(pp.z); v1[2] += bf_lo(pp.w); v1[3] += bf_hi(pp.w); }
                    u32x4 w; w.x = cvtpk(v0[0], v0[1]); w.y = cvtpk(v0[2], v0[3]); w.z = cvtpk(v1[0], v1[1]); w.w = cvtpk(v1[2], v1[3]);
                    *(u32x4*)(O + r * ldc + c) = w; }
            asm volatile("" ::: "memory");
        }
    }
};

struct EpiGateM {
    static constexpr bool PERM = true, AFTER_DRAIN = false;
    bf16_t* O; int ldc; const unsigned char* G; int ldg;
    __device__ __forceinline__ void mid(f32x4 (&acc)[2][2][4][2], const Unit& u, int wr, int wc) const {
        int fr, fq; { int z_ = 0; asm volatile("" : "+v"(z_)); const int l_ = (int)__builtin_amdgcn_mbcnt_hi(~0u, __builtin_amdgcn_mbcnt_lo(~0u, (unsigned)z_)); fr = l_ & 15; fq = l_ >> 4; }
        const int row0 = u.pm * BM + wr * 64 + fr, col0 = u.pn * BM + wc * 32 + 8 * fq;
#pragma unroll
        for (int ai = 0; ai < 2; ++ai) {
            u32x2 ga[4][2], gb[4][2];
#pragma unroll
            for (int m = 0; m < 4; ++m)
#pragma unroll
                for (int bj = 0; bj < 2; ++bj) { const unsigned char* gp = G + (size_t)(row0 + ai * HALF + m * 16) * ldg + col0 + bj * HALF; ga[m][bj] = *(const u32x2*)gp; gb[m][bj] = *(const u32x2*)(gp + 1024); }
#pragma unroll
            for (int m = 0; m < 4; ++m)
#pragma unroll
                for (int bj = 0; bj < 2; ++bj) { const u32x2 a = ga[m][bj], b = gb[m][bj];
#define GM_R(w, sh) ((float)(((a.w) >> (sh)) & 255u) * __builtin_amdgcn_rcpf((float)(((b.w) >> (sh)) & 255u)))
                    acc[ai][bj][m][0][0] *= GM_R(x, 0); acc[ai][bj][m][0][1] *= GM_R(x, 8); acc[ai][bj][m][0][2] *= GM_R(x, 16); acc[ai][bj][m][0][3] *= GM_R(x, 24);
                    acc[ai][bj][m][1][0] *= GM_R(y, 0); acc[ai][bj][m][1][1] *= GM_R(y, 8); acc[ai][bj][m][1][2] *= GM_R(y, 16); acc[ai][bj][m][1][3] *= GM_R(y, 24);
#undef GM_R
                }
        }
    }
    __device__ __forceinline__ void operator()(const f32x4 (&acc)[2][2][4][2], const Unit& u, int wr, int wc, int fr, int fq) const {
        { int z_ = 0; asm volatile("" : "+v"(z_)); const int l_ = (int)__builtin_amdgcn_mbcnt_hi(~0u, __builtin_amdgcn_mbcnt_lo(~0u, (unsigned)z_)); fr = l_ & 15; fq = l_ >> 4; }
        const int row0 = u.pm * BM + wr * 64 + fr, col0 = u.pn * BM + wc * 32 + 8 * fq;
#pragma unroll
        for (int ai = 0; ai < 2; ++ai) {
            u32x2 gb[4][2];
#pragma unroll
            for (int m = 0; m < 4; ++m)
#pragma unroll
                for (int bj = 0; bj < 2; ++bj) gb[m][bj] = *(const u32x2*)(G + (size_t)(row0 + ai * HALF + m * 16) * ldg + 1024 + col0 + bj * HALF);
#pragma unroll
            for (int m = 0; m < 4; ++m)
#pragma unroll
                for (int bj = 0; bj < 2; ++bj) { const size_t r = (size_t)(row0 + ai * HALF + m * 16); const int c = col0 + bj * HALF; const u32x2 b = gb[m][bj]; const float k = 1.f / 255.f;
                    f32x4 v0 = acc[ai][bj][m][0], v1 = acc[ai][bj][m][1];
                    v0[0] *= (float)(b.x & 255u) * k; v0[1] *= (float)((b.x >> 8) & 255u) * k; v0[2] *= (float)((b.x >> 16) & 255u) * k; v0[3] *= (float)(b.x >> 24) * k;
                    v1[0] *= (float)(b.y & 255u) * k; v1[1] *= (float)((b.y >> 8) & 255u) * k; v1[2] *= (float)((b.y >> 16) & 255u) * k; v1[3] *= (float)(b.y >> 24) * k;
                    u32x4 w; w.x = cvtpk(v0[0], v0[1]); w.y = cvtpk(v0[2], v0[3]); w.z = cvtpk(v1[0], v1[1]); w.w = cvtpk(v1[2], v1[3]);
                    *(u32x4*)(O + r * ldc + c) = w; }
        }
    }
};
}
constexpr int NWAVES = 8;
constexpr int D = 1024, NB = 4, S = 4096, DEPTH = 4, M = NB * S;
constexpr int HQ = 8, HKV = 2, DH = 64, WIN = 128;
constexpr int HGH = 4, DK = 128, DV = 128;
constexpr int INW = 4864;
constexpr int OFF_AQ = 0, OFF_AK = 512, OFF_AV = 640, OFF_HQ = 768, OFF_HF = 1280, OFF_HI = 1792, OFF_HG = 2304, OFF_GA = 2816, OFF_GB = 3840;
constexpr int ZW = 2816;
constexpr int FD = 2816, NE = 8, FE = 3584, PLE = 256;
constexpr float EPS = 1e-6f;
constexpr int MOE_ROWS = 2 * M + NE * 256;

constexpr size_t MiB = 1u << 20;
constexpr size_t WS_CTL = 0, CTL_ZERO_BYTES = 2 * MiB;
constexpr size_t WS_TBL = 2 * MiB;
constexpr size_t WS_H = 6 * MiB, WS_U = 70 * MiB, WS_Z = 102 * MiB, WS_ZT = 254 * MiB;
constexpr size_t WS_OA = 342 * MiB, WS_OB = 358 * MiB, WS_MG = 374 * MiB, WS_AG = 342 * MiB, WS_Y = 410 * MiB, WS_PB = 478 * MiB, WS_W = 510 * MiB;
constexpr size_t WS_GZ = WS_Z + 96 * MiB;
constexpr size_t WS_U2 = WS_H;
constexpr size_t W_IN = WS_W, W_A = WS_W + 38 * MiB, W_B = WS_W + 42 * MiB, W_OUT = WS_W + 46 * MiB, W_PG = WS_W + 54 * MiB, W_PP = WS_W + 62 * MiB,
                 W_13D = WS_W + 64 * MiB, W_2D = WS_W + 86 * MiB, W_13M = WS_W + 97 * MiB, W_2M = WS_W + 321 * MiB, WS_END = WS_W + 433 * MiB;
static_assert((size_t)DEPTH * INW * D * 2 == 38 * MiB && (size_t)2 * NE * 2 * FE * D * 2 == 224 * MiB && (size_t)2 * NE * FE * D * 2 == 112 * MiB && (size_t)2 * 2 * FD * D * 2 == 22 * MiB, "weight map");
static_assert((size_t)MOE_ROWS * FE * 2 <= 240 * MiB && (size_t)MOE_ROWS * D * 2 <= 68 * MiB && (size_t)M * INW * 2 == 152 * MiB, "activation map");
constexpr int CW_TMO = 0, CW_CODE = 1;
constexpr int CW_BAR = 8192, BAR_STRIDE = 4096, MAX_LAUNCH = 120;
static_assert((CW_BAR + MAX_LAUNCH * BAR_STRIDE) * 4 <= (int)CTL_ZERO_BYTES, "CTL words inside the memset region");

constexpr int RING_OFF = 0, RING_BYTES = 131072;
constexpr int LDSCTL_OFF = RING_BYTES, MISC_OFF = LDSCTL_OFF + 320;
constexpr int LDS_BYTES = 147456;
constexpr int RSTD_OFF = LDSCTL_OFF + 1024;

#define GAS __attribute__((address_space(1)))
#define LAS __attribute__((address_space(3)))
typedef unsigned short bf16;
typedef unsigned v4u __attribute__((ext_vector_type(4)));
typedef unsigned v2u __attribute__((ext_vector_type(2)));
typedef float f32x4 __attribute__((ext_vector_type(4)));
typedef short bf16x8 __attribute__((ext_vector_type(8)));
typedef GAS unsigned gu32;
#define RLX_AGENT __ATOMIC_RELAXED, __HIP_MEMORY_SCOPE_AGENT
#define LDS_WAIT() asm volatile("s_waitcnt lgkmcnt(0)" ::: "memory")
#define VM_WAIT() asm volatile("s_waitcnt vmcnt(0)" ::: "memory")
__device__ __forceinline__ unsigned f2bf(float f) { unsigned u = __builtin_bit_cast(unsigned, f); return (u + 0x7fffu + ((u >> 16) & 1u)) >> 16; }
__device__ __forceinline__ unsigned pk2(float lo, float hi) { return f2bf(lo) | (f2bf(hi) << 16); }
__device__ __forceinline__ float bf2f(bf16 b) { return __uint_as_float((unsigned)b << 16); }
#define XB_TMO      128
#define XB_XCNT(j)  (256  + 64 * (j))
#define XB_XSUB(j)  (1280 + 64 * (j))
#define XB_XGEN(j)  (2304 + 64 * (j))
#define XB_TOP      3328
#define XB_TOPGEN   3392
#define XCD_BAR_WORDS 3456
#define XB_SPIN_CAP (1u << 18)

__device__ __forceinline__ unsigned xb_ld(unsigned* p)              { return __hip_atomic_load(p, __ATOMIC_RELAXED, __HIP_MEMORY_SCOPE_AGENT); }
__device__ __forceinline__ unsigned xb_add(unsigned* p, unsigned v) { return __hip_atomic_fetch_add(p, v, __ATOMIC_RELAXED, __HIP_MEMORY_SCOPE_AGENT); }
__device__ __forceinline__ unsigned xb_xcc_id() { return (unsigned)__builtin_amdgcn_s_getreg((3 << 11) | 20) & 0xFu; }
#define XB_SPIN(cond, bar) do { unsigned _sp = 0; while (cond) { __builtin_amdgcn_s_sleep(1); \
    if ((++_sp & 255u) == 0u) { if (xb_ld(&(bar)[XB_TMO])) break; if (_sp > XB_SPIN_CAP) { atomicAdd(&(bar)[XB_TMO], 1u); break; } } } } while (0)

struct XcdBarrier {
    unsigned* bar; unsigned x;
    volatile LAS unsigned* st;
};

__device__ __forceinline__ XcdBarrier xcd_barrier_post(unsigned* bar, volatile LAS unsigned* st) {
    XcdBarrier b; b.bar = bar; b.x = xb_xcc_id(); b.st = st;
    if (threadIdx.x == 0) (void)xb_add(&bar[XB_XCNT(b.x)], 1u);
    return b;
}
__device__ __forceinline__ void xcd_barrier_complete(unsigned* bar, unsigned x, unsigned& nloc, unsigned& nx) {
    const unsigned G = gridDim.x * gridDim.y * gridDim.z;
    unsigned sum, cnt, mine, sp = 0u;
    for (;;) {
        sum = 0u; cnt = 0u; mine = 0u;
#pragma unroll
        for (unsigned j = 0; j < 16; ++j) { const unsigned c = xb_ld(&bar[XB_XCNT(j)]); sum += c; cnt += (c > 0u) ? 1u : 0u; mine = (j == x) ? c : mine; }
        if (sum == G) break;
        __builtin_amdgcn_s_sleep(1);
        if ((++sp & 255u) == 0u) { if (xb_ld(&bar[XB_TMO])) break; if (sp > XB_SPIN_CAP) { atomicAdd(&bar[XB_TMO], 1u); break; } }
    }
    nloc = mine > 0u ? mine : 1u; nx = cnt > 0u ? cnt : 1u;
}

__device__ __forceinline__ void xcd_barrier(const XcdBarrier& b, int tid  ) {
    asm volatile("s_waitcnt vmcnt(0)" ::: "memory");
    __syncthreads();
    if (tid == 0) {
        unsigned* bar = b.bar; unsigned xq = b.x; asm volatile("" : "+s"(xq));
        __builtin_amdgcn_s_waitcnt(0);
        unsigned nloc = b.st[0], nx = b.st[1];
        if (nloc == 0u) { xcd_barrier_complete(bar, xq, nloc, nx); b.st[0] = nloc; b.st[1] = nx; }
        const unsigned old = xb_add(&bar[XB_XSUB(xq)], 1u);
        const unsigned gen = old / nloc;
        if (old + 1u == (gen + 1u) * nloc) {
            __builtin_amdgcn_fence(__ATOMIC_RELEASE, "agent");
            asm volatile("s_waitcnt vmcnt(0)" ::: "memory");
            const unsigned og = xb_add(&bar[XB_TOP], 1u);
            const unsigned tg = og / nx;
            if (og + 1u == (tg + 1u) * nx) xb_add(&bar[XB_TOPGEN], 1u);
            else XB_SPIN(xb_ld(&bar[XB_TOPGEN]) == tg, bar);
            __builtin_amdgcn_fence(__ATOMIC_ACQUIRE, "agent");
            xb_add(&bar[XB_XGEN(xq)], 1u);
            asm volatile("s_waitcnt vmcnt(0)" ::: "memory");
        } else {
            XB_SPIN(xb_ld(&bar[XB_XGEN(xq)]) == gen, bar);
            __builtin_amdgcn_fence(__ATOMIC_ACQUIRE, "agent");
            asm volatile("s_waitcnt vmcnt(0)" ::: "memory");
        }
    }
    __syncthreads();
}
constexpr size_t T_SSP = 1 << 20, T_SSP2 = 2 << 20;
struct Args { const float* in[23]; float* out; unsigned char* ws; int ph_lo, ph_hi, li, pad; };
struct Frame {
    LAS unsigned char* lds;
    volatile LAS unsigned* MISC;
    gu32* ctl;
    int tid, lane, wave;
    int vcu, G;
};
__device__ __forceinline__ float wave_sum_n(float v) {
#pragma unroll
    for (int o = 1; o < 64; o <<= 1) v += __shfl_xor(v, o);
    return v;
}
__device__ __forceinline__ float wave_sum(float v, int lane) {
#pragma unroll
    for (int o = 1; o < 64; o <<= 1) v += __builtin_bit_cast(float, __builtin_amdgcn_ds_bpermute((lane ^ o) << 2, __builtin_bit_cast(int, v)));
    return v;
}
template <int MODE, int KL>
__device__ __forceinline__ void p0_cvt_item(const float* W, int K, int N, unsigned char* WT, int il, int which, int item, int lane, const float* gk, float scale, int ldk, int koff) {
    const int nblk = N >> 6, kb = item / nblk, nb = item - kb * nblk, nq = lane & 15, kr = lane >> 4, k0 = 4 * KL * kb + KL * kr, n0 = 64 * nb + 4 * nq;
    const GAS f32x4* src = (const GAS f32x4*)(W + (size_t)k0 * N + n0);
    f32x4 v[KL];
#pragma unroll
    for (int i = 0; i < KL; ++i) v[i] = src[(size_t)i * (N >> 2)];
    if (MODE == 1) {
#pragma unroll
        for (int q = 0; q < KL / 4; ++q) { const f32x4 g = *(const GAS f32x4*)(gk + k0 + 4 * q); v[4 * q] *= g.x; v[4 * q + 1] *= g.y; v[4 * q + 2] *= g.z; v[4 * q + 3] *= g.w; } }
    if (MODE == 2) {
#pragma unroll
        for (int i = 0; i < KL; ++i) v[i] *= scale; }
#pragma unroll
    for (int c = 0; c < 4; ++c) { const int n = n0 + c, row = il ? ((n >> 4) * 32 + which * 16 + (n & 15)) : n;
        if (MODE == 2) { GAS v4u* dst = (GAS v4u*)(WT + (size_t)row * ldk + koff + k0);
#pragma unroll
            for (int q = 0; q < KL / 16; ++q) { v4u o;
                o.x = pg8::pk4_fp8(v[16 * q][c], v[16 * q + 1][c], v[16 * q + 2][c], v[16 * q + 3][c]);     o.y = pg8::pk4_fp8(v[16 * q + 4][c], v[16 * q + 5][c], v[16 * q + 6][c], v[16 * q + 7][c]);
                o.z = pg8::pk4_fp8(v[16 * q + 8][c], v[16 * q + 9][c], v[16 * q + 10][c], v[16 * q + 11][c]); o.w = pg8::pk4_fp8(v[16 * q + 12][c], v[16 * q + 13][c], v[16 * q + 14][c], v[16 * q + 15][c]);
                dst[q] = o; } }
        else { GAS v4u* dst = (GAS v4u*)(WT + ((size_t)row * ldk + koff + k0) * 2);
#pragma unroll
            for (int q = 0; q < KL / 8; ++q) { v4u o;
                if (MODE == 1) { o.x = pg8::pk_f16(v[8 * q][c], v[8 * q + 1][c]); o.y = pg8::pk_f16(v[8 * q + 2][c], v[8 * q + 3][c]); o.z = pg8::pk_f16(v[8 * q + 4][c], v[8 * q + 5][c]); o.w = pg8::pk_f16(v[8 * q + 6][c], v[8 * q + 7][c]); }
                else { o.x = pk2(v[8 * q][c], v[8 * q + 1][c]); o.y = pk2(v[8 * q + 2][c], v[8 * q + 3][c]); o.z = pk2(v[8 * q + 4][c], v[8 * q + 5][c]); o.w = pk2(v[8 * q + 6][c], v[8 * q + 7][c]); }
                dst[q] = o; } } }
}
constexpr int MT_PER = (D / 128) * (FE / 64), MT_SET = 24 * MT_PER;
constexpr int MT_N1 = 3, MT_N4 = 3, MT_G1 = MT_N1 * 64 * NWAVES, MT_G4 = MT_N4 * 128 * NWAVES, MT_TAIL = 2 * MT_G1 + MT_G4;
static_assert(MT_TAIL <= MT_SET, "tile split");
__device__ __forceinline__ void moe_cvt_tile(const Args& a, int set, int id, int lane) {
    const int j = id / MT_PER, item = id - j * MT_PER;
    if (j < 16) { const int e = set * 8 + (j & 7), wh = j >> 3;
        p0_cvt_item<2, 32>(a.in[17 + wh] + (size_t)e * D * FE, D, FE, a.ws + W_13M + (size_t)e * 2 * FE * D, 1, wh, item, lane, nullptr, 32.f, D, 0); }
    else { const int e = set * 8 + (j - 16); p0_cvt_item<2, 32>(a.in[19] + (size_t)e * FE * D, FE, D, a.ws + W_2M + (size_t)e * D * FE, 0, 0, item, lane, nullptr, 64.f, FE, 0); }
}
__device__ __forceinline__ void rms_row_to_bf16(const float* xrow, const float* g, bf16* orow, int lane) {
    const GAS f32x4* xr = (const GAS f32x4*)xrow + lane; const GAS f32x4* gr = (const GAS f32x4*)g + lane;
    f32x4 v[4]; float s = 0.f;
#pragma unroll
    for (int j = 0; j < 4; ++j) { v[j] = xr[64 * j]; s += (v[j].x * v[j].x + v[j].y * v[j].y) + (v[j].z * v[j].z + v[j].w * v[j].w); }
    const float rstd = rsqrtf(wave_sum(s, lane) * (1.f / D) + EPS);
    GAS v2u* o8 = (GAS v2u*)orow + lane;
#pragma unroll
    for (int j = 0; j < 4; ++j) { const f32x4 gg = gr[64 * j]; v2u w; w.x = pk2(v[j].x * rstd * gg.x, v[j].y * rstd * gg.y); w.y = pk2(v[j].z * rstd * gg.z, v[j].w * rstd * gg.w); o8[64 * j] = w; }
}
__device__ __forceinline__ void rms_row_to_f32(const float* xrow, const float* g, float* orow, int lane) {
    const GAS f32x4* xr = (const GAS f32x4*)xrow + lane; const GAS f32x4* gr = (const GAS f32x4*)g + lane;
    f32x4 v[4]; float s = 0.f;
#pragma unroll
    for (int j = 0; j < 4; ++j) { v[j] = xr[64 * j]; s += (v[j].x * v[j].x + v[j].y * v[j].y) + (v[j].z * v[j].z + v[j].w * v[j].w); }
    const float rstd = rsqrtf(wave_sum(s, lane) * (1.f / D) + EPS);
    GAS f32x4* o = (GAS f32x4*)orow + lane;
#pragma unroll
    for (int j = 0; j < 4; ++j) { const f32x4 gg = gr[64 * j]; o[64 * j] = v[j] * rstd * gg; }
}

__device__ __forceinline__ void p0_prologue(Frame& F, const Args& a) {
    const int gw = F.vcu * NWAVES + F.wave, NGW = F.G * NWAVES;
    unsigned char* ws = a.ws;
    constexpr int I_MP = MT_SET - MT_TAIL;
    constexpr int I_IN = (D / 64) * (INW / 64), I_AB = (512 / 64) * (D / 64), I_SQ = (D / 64) * (D / 64), I_PP = (PLE / 64) * (D / 64), I_D1 = (D / 64) * (FD / 64), I_D2 = (FD / 64) * (D / 64);
    constexpr int NITEMS = 2 * I_MP + 4 * I_IN + 8 * I_AB + 8 * I_SQ + 4 * I_PP + 4 * I_D1 + 2 * I_D2;
    for (int it = gw; it < NITEMS; it += NGW) {
        int r = it;
        if (r < 2 * I_MP) { const int set = r / I_MP; moe_cvt_tile(a, set, MT_TAIL + (r - set * I_MP), F.lane); continue; } r -= 2 * I_MP;
        const float* W; const float* gk = nullptr; unsigned char* WT; int K, N, il = 0, wh = 0, ldk, koff = 0, item;
        if (r < 4 * I_IN) { const int l = r / I_IN; item = r - l * I_IN; W = a.in[2] + (size_t)l * D * INW; K = D; N = INW; WT = ws + W_IN + (size_t)l * INW * D * 2; gk = a.in[10] + l * D; ldk = D; }
        else if ((r -= 4 * I_IN) < 4 * I_SQ) { const int l = r / I_SQ; item = r - l * I_SQ; W = a.in[21] + (size_t)l * D * D; K = D; N = D; WT = ws + W_PG + (size_t)l * D * D * 2; gk = a.in[12] + l * D; ldk = D; }
        else if ((r -= 4 * I_SQ) < 4 * I_D1) { const int j = r / I_D1, i = j & 1; wh = j >> 1; item = r - j * I_D1; W = a.in[13 + wh] + (size_t)i * D * FD; K = D; N = FD; WT = ws + W_13D + (size_t)i * 2 * FD * D * 2; gk = a.in[11] + 2 * i * D; ldk = D; il = 1; }
        else if ((r -= 4 * I_D1) < 8 * I_AB) { const int j = r / I_AB, l = j & 3, hb2 = j >> 2; item = r - j * I_AB; W = a.in[7 + hb2] + (size_t)l * 512 * D; K = 512; N = D; WT = ws + W_A + (size_t)l * D * D * 2; ldk = D; koff = 512 * hb2; }
        else if ((r -= 8 * I_AB) < 4 * I_SQ) { const int l = r / I_SQ; item = r - l * I_SQ; W = a.in[9] + (size_t)l * D * D; K = D; N = D; WT = ws + W_OUT + (size_t)l * D * D * 2; ldk = D; }
        else if ((r -= 4 * I_SQ) < 4 * I_PP) { const int l = r / I_PP; item = r - l * I_PP; W = a.in[20] + (size_t)l * PLE * D; K = PLE; N = D; WT = ws + W_PP + (size_t)l * D * PLE * 2; ldk = PLE; }
        else { r -= 4 * I_PP; const int i = r / I_D2; item = r - i * I_D2; W = a.in[15] + (size_t)i * FD * D; K = FD; N = D; WT = ws + W_2D + (size_t)i * D * FD * 2; ldk = FD; }
        if (gk) p0_cvt_item<1, 16>(W, K, N, WT, il, wh, item, F.lane, gk, 1.f, ldk, koff);
        else p0_cvt_item<0, 16>(W, K, N, WT, il, wh, item, F.lane, nullptr, 1.f, ldk, koff);
    }
    if (F.vcu == 0) { const int c = F.tid; const float* lbl = a.in[5]; float* lb = (float*)(ws + WS_TBL);
        float v[DEPTH], mx = -INFINITY, sum = 0.f;
#pragma unroll
        for (int l = 0; l < DEPTH; ++l) { v[l] = lbl[l * 512 + c]; mx = fmaxf(mx, v[l]); }
#pragma unroll
        for (int l = 0; l < DEPTH; ++l) { v[l] = expf(v[l] - mx); sum += v[l]; }
        float cum = 0.f; const float s0 = v[0] / sum;
#pragma unroll
        for (int l = 0; l < DEPTH; ++l) { cum += v[l] / sum; lb[l * 512 + c] = cum - s0; } }
    { float* ssp = (float*)(ws + WS_TBL + T_SSP2); bf16* hb = (bf16*)(ws + WS_U2);
      for (int m = gw; m < M; m += 4 * NGW) { f32x4 v[4][4];
#pragma unroll
          for (int r = 0; r < 4; ++r) { const GAS f32x4* xr = (const GAS f32x4*)(a.in[0] + (size_t)(m + r * NGW) * D) + F.lane;
#pragma unroll
              for (int j = 0; j < 4; ++j) v[r][j] = xr[64 * j]; }
#pragma unroll
          for (int r = 0; r < 4; ++r) { GAS v2u* o8 = (GAS v2u*)(hb + (size_t)(m + r * NGW) * D) + F.lane; float s = 0.f;
#pragma unroll
              for (int j = 0; j < 4; ++j) { const f32x4 x = v[r][j]; s += (x.x * x.x + x.y * x.y) + (x.z * x.z + x.w * x.w); v2u w; w.x = pg8::pk_f16(x.x, x.y); w.y = pg8::pk_f16(x.z, x.w); o8[64 * j] = w; }
              s = wave_sum(s, F.lane); if (F.lane < 16) ssp[(size_t)(m + r * NGW) * 16 + F.lane] = (F.lane == 0) ? s : 0.f; } } }
    { const GAS f32x4* src = (const GAS f32x4*)a.in[1]; GAS v2u* dst = (GAS v2u*)(ws + WS_PB); const size_t n4 = (size_t)DEPTH * M * PLE / 4;
      const size_t st = (size_t)NGW * 64;
      for (size_t i = (size_t)gw * 64 + F.lane; i < n4; i += 16 * st) { f32x4 v[16];
#pragma unroll
          for (int k = 0; k < 16; ++k) v[k] = src[i + k * st];
#pragma unroll
          for (int k = 0; k < 16; ++k) { v2u w; w.x = pk2(v[k].x, v[k].y); w.y = pk2(v[k].z, v[k].w); dst[i + k * st] = w; } } }
}

constexpr size_t T_LB = 0, T_CNT = 16 << 10, T_TOKE = 32 << 10, T_TOKW = 96 << 10, T_POS = 224 << 10, T_ROWW = 352 << 10, T_LISTU = 512 << 10, T_LISTD = 544 << 10, T_NUN = 552 << 10;
constexpr int NT_UP = 2 * FE / 256, NT_DN = D / 256;
typedef int i32x2 __attribute__((ext_vector_type(2)));
typedef int i32x4 __attribute__((ext_vector_type(4)));
typedef float f32x2 __attribute__((ext_vector_type(2)));
__device__ __forceinline__ int ld_agent_i(const int* p) { return (int)__hip_atomic_load((const unsigned*)p, RLX_AGENT); }
__device__ __forceinline__ void moe_tables(LAS int* T, const int* cnt, int G, int wgi, int tid) {
    const int lane = tid & 63, e = tid >> 6;
    int tot = 0, pre = 0;
    for (int t = lane; t < G; t += 64) { const int c = cnt[t * 8 + e]; tot += c; pre += (t < wgi) ? c : 0; }
    const float totf = wave_sum((float)tot, lane), pref = wave_sum((float)pre, lane);
    if (tid < 64) T[tid] = 0;
    __syncthreads();
    if (lane == 0) { T[e] = (int)totf; T[8 + e] = (int)pref; }
    __syncthreads();
    if (tid == 0) { int st = 0, ts = 0;
        for (int e = 0; e < 8; ++e) { const int tl = (T[e] + 255) >> 8; T[16 + e] = st; T[24 + e] = tl; T[32 + e] = ts; st += tl * 256; ts += tl; }
        T[40] = ts; }
    __syncthreads();
}
__device__ __forceinline__ i32x2 moe_unit(const LAS int* T, int L, int NT) {
    i32x2 r = {0, 0};
    for (int e = 0; e < 8; ++e) { const int tl = T[24 + e], ue = tl * NT;
        if (L < ue) { const int nig = 8 * NT, gid = L / nig, fm = gid * 8, gsz = (tl - fm) < 8 ? (tl - fm) : 8; r.x = T[32 + e] + fm + (L % nig) % gsz; r.y = e * NT + (L % nig) / gsz; return r; }
        L -= ue; }
    return r;
}
namespace pg8 {
struct ListOrder {
    const int* list; int n, G, c;
    __device__ __forceinline__ bool next(int i, Unit& u) const {
        const long L = (long)i * G + c; if (L >= n) return false;
        int wgid = (int)L; { const int q = n / NXCD, r = n % NXCD, xcd = wgid % NXCD, off = wgid / NXCD; wgid = (xcd < r ? xcd * (q + 1) : r * (q + 1) + (xcd - r) * q) + off; }
        u.pm = __builtin_amdgcn_readfirstlane(ld_agent_i(list + 2 * wgid)); u.pn = __builtin_amdgcn_readfirstlane(ld_agent_i(list + 2 * wgid + 1)); return true;
    }
    __device__ __forceinline__ void a_ready(const Unit&) const {}
    __device__ __forceinline__ void done(const Unit&) const {}
};
struct ListOrderL {
    const PG8_LAS int* ul; int n, G, c;
    __device__ __forceinline__ bool next(int i, Unit& u) const {
        const long L = (long)i * G + c; if (L >= n) return false;
        u.pm = __builtin_amdgcn_readfirstlane(ul[2 * i]); u.pn = __builtin_amdgcn_readfirstlane(ul[2 * i + 1]); return true;
    }
    __device__ __forceinline__ void a_ready(const Unit&) const {}
    __device__ __forceinline__ void done(const Unit&) const {}
};
}

constexpr int AT_KSTR = 72, AT_VSTR = 260;
constexpr int AT_K_OFF = 0, AT_V_OFF = 256 * AT_KSTR * 2, AT_TB_OFF = AT_V_OFF + 64 * AT_VSTR * 2, AT_LDS_END = AT_TB_OFF + 4 * 384 * 4;
static_assert(AT_LDS_END <= RING_BYTES && AT_V_OFF % 16 == 0 && AT_TB_OFF % 16 == 0, "attention LDS map");
typedef float f32x16 __attribute__((ext_vector_type(16)));
typedef short s16x4 __attribute__((ext_vector_type(4)));
__device__ __forceinline__ int t5_bucket_d(int d) {
    if (d < 16) return d;
    int large = 16 + (int)(logf((float)d / 16.f) / logf(8.f) * 16.f);
    return large < 31 ? large : 31;
}
__device__ __forceinline__ void attn_phase(LAS unsigned char* lds, const bf16* z, const float* sinks_l, const float* rel_bias, bf16* oa, int tid, int vcu, int G) {
    const int lane = tid & 63, wave = __builtin_amdgcn_readfirstlane(tid >> 6), l31 = lane & 31, h2 = lane >> 5;
    LAS bf16* Kt = (LAS bf16*)(lds + AT_K_OFF); LAS bf16* Vt = (LAS bf16*)(lds + AT_V_OFF); LAS float* tb = (LAS float*)(lds + AT_TB_OFF);
    for (int unit = vcu; unit < NB * (S / 128) * HKV; unit += G) {
        const int b = unit >> 6, n = (unit >> 1) & 31, kvh = unit & 1;
        __syncthreads();
        for (int i = tid; i < 4 * 384; i += NWAVES * 64) { const int g = i / 384, dist = i % 384 - 128;
            tb[i] = (dist >= 0 && dist < WIN) ? rel_bias[t5_bucket_d(dist) * HQ + kvh * 4 + g] : -1e30f; }
        v4u kq[4], vq[2][2];
#pragma unroll
        for (int j = 0; j < 4; ++j) { const int idx = tid + 512 * j, row = idx >> 3, ch = idx & 7; const bool valid = (n > 0) || (row >= 128);
            const size_t tok = (size_t)b * S + n * 128 - 128 + row;
            kq[j] = (v4u){0u, 0u, 0u, 0u};
            if (valid) kq[j] = *(const GAS v4u*)(z + tok * ZW + OFF_AK + kvh * 64 + ch * 8); }
#pragma unroll
        for (int j = 0; j < 2; ++j) { const int gq = wave + 8 * j, p = 16 * (gq & 7) + (lane & 15), ch = 4 * (gq >> 3) + (lane >> 4); const bool valid = (n > 0) || (p >= 64);
            const size_t tok = (size_t)b * S + n * 128 - 128 + 2 * p;
            vq[j][0] = (v4u){0u, 0u, 0u, 0u}; vq[j][1] = vq[j][0];
            if (valid) { vq[j][0] = *(const GAS v4u*)(z + tok * ZW + OFF_AV + kvh * 64 + ch * 8); vq[j][1] = *(const GAS v4u*)(z + (tok + 1) * ZW + OFF_AV + kvh * 64 + ch * 8); } }
#pragma unroll
        for (int j = 0; j < 4; ++j) { const int idx = tid + 512 * j, row = idx >> 3, ch = idx & 7; *(LAS v4u*)(Kt + row * AT_KSTR + ch * 8) = kq[j]; }
#pragma unroll
        for (int j = 0; j < 2; ++j) { const int gq = wave + 8 * j, p = 16 * (gq & 7) + (lane & 15), ch = 4 * (gq >> 3) + (lane >> 4);
            LAS unsigned* vp = (LAS unsigned*)(Vt + (ch * 8) * AT_VSTR + 2 * p); const v4u va = vq[j][0], vb = vq[j][1];
            vp[0 * (AT_VSTR / 2)] = __builtin_amdgcn_perm(vb.x, va.x, 0x05040100u); vp[1 * (AT_VSTR / 2)] = __builtin_amdgcn_perm(vb.x, va.x, 0x07060302u);
            vp[2 * (AT_VSTR / 2)] = __builtin_amdgcn_perm(vb.y, va.y, 0x05040100u); vp[3 * (AT_VSTR / 2)] = __builtin_amdgcn_perm(vb.y, va.y, 0x07060302u);
            vp[4 * (AT_VSTR / 2)] = __builtin_amdgcn_perm(vb.z, va.z, 0x05040100u); vp[5 * (AT_VSTR / 2)] = __builtin_amdgcn_perm(vb.z, va.z, 0x07060302u);
            vp[6 * (AT_VSTR / 2)] = __builtin_amdgcn_perm(vb.w, va.w, 0x05040100u); vp[7 * (AT_VSTR / 2)] = __builtin_amdgcn_perm(vb.w, va.w, 0x07060302u); }
        __syncthreads();
        const int g = wave >> 1, hq = kvh * 4 + g; const float sink = sinks_l[hq];
        for (int s2 = 0; s2 < 2; ++s2) {
            const int sb = (wave & 1) * 2 + s2, q0 = 32 * sb; const size_t qtok = (size_t)b * S + n * 128 + q0 + l31;
            bf16x8 Qf[4];
#pragma unroll
            for (int d0 = 0; d0 < 4; ++d0) Qf[d0] = *(const GAS bf16x8*)(z + qtok * ZW + OFF_AQ + hq * 64 + 16 * d0 + 8 * h2);
            f32x16 Sc[5];
#pragma unroll
            for (int i = 0; i < 5; ++i) { f32x16 acc = {0.f, 0.f, 0.f, 0.f, 0.f, 0.f, 0.f, 0.f, 0.f, 0.f, 0.f, 0.f, 0.f, 0.f, 0.f, 0.f};
#pragma unroll
                for (int d0 = 0; d0 < 4; ++d0) { const bf16x8 kf = *(const LAS bf16x8*)(Kt + (32 * (sb + i) + l31) * AT_KSTR + 16 * d0 + 8 * h2); acc = __builtin_amdgcn_mfma_f32_32x32x16_bf16(kf, Qf[d0], acc, 0, 0, 0); }
                Sc[i] = acc; }
            float mx = sink;
#pragma unroll
            for (int i = 0; i < 5; ++i)
#pragma unroll
                for (int r = 0; r < 16; ++r) { const int kj = 32 * (sb + i) + (r & 3) + 8 * (r >> 2) + 4 * h2; float sv = Sc[i][r] * 0.125f + tb[g * 384 + (q0 + l31) + 256 - kj];
                    if (n == 0 && kj < 128) sv = -1e30f; Sc[i][r] = sv; mx = fmaxf(mx, sv); }
            mx = fmaxf(mx, __builtin_bit_cast(float, __builtin_amdgcn_ds_bpermute((lane ^ 32) << 2, __builtin_bit_cast(int, mx))));
            float sum = 0.f;
#pragma unroll
            for (int i = 0; i < 5; ++i)
#pragma unroll
                for (int r = 0; r < 16; ++r) { const float p = __expf(Sc[i][r] - mx); Sc[i][r] = p; sum += p; }
            sum += __builtin_bit_cast(float, __builtin_amdgcn_ds_bpermute((lane ^ 32) << 2, __builtin_bit_cast(int, sum)));
            sum += __expf(sink - mx);
            f32x16 O0 = {0.f, 0.f, 0.f, 0.f, 0.f, 0.f, 0.f, 0.f, 0.f, 0.f, 0.f, 0.f, 0.f, 0.f, 0.f, 0.f}, O1 = O0;
#pragma unroll
            for (int i = 0; i < 5; ++i)
#pragma unroll
                for (int ks = 0; ks < 2; ++ks) {
                    v4u pw; pw.x = pg8::cvtpk(Sc[i][8 * ks + 0], Sc[i][8 * ks + 1]); pw.y = pg8::cvtpk(Sc[i][8 * ks + 2], Sc[i][8 * ks + 3]); pw.z = pg8::cvtpk(Sc[i][8 * ks + 4], Sc[i][8 * ks + 5]); pw.w = pg8::cvtpk(Sc[i][8 * ks + 6], Sc[i][8 * ks + 7]);
                    const bf16x8 pf = __builtin_bit_cast(bf16x8, pw);
                    const int kb = 32 * (sb + i) + 16 * ks + 4 * h2;
                    { const LAS bf16* vp = Vt + l31 * AT_VSTR + kb; const s16x4 a = *(const LAS s16x4*)vp, c = *(const LAS s16x4*)(vp + 8);
                      const bf16x8 vf = {a[0], a[1], a[2], a[3], c[0], c[1], c[2], c[3]}; O0 = __builtin_amdgcn_mfma_f32_32x32x16_bf16(vf, pf, O0, 0, 0, 0); }
                    { const LAS bf16* vp = Vt + (32 + l31) * AT_VSTR + kb; const s16x4 a = *(const LAS s16x4*)vp, c = *(const LAS s16x4*)(vp + 8);
                      const bf16x8 vf = {a[0], a[1], a[2], a[3], c[0], c[1], c[2], c[3]}; O1 = __builtin_amdgcn_mfma_f32_32x32x16_bf16(vf, pf, O1, 0, 0, 0); }
                }
            const float inv = 1.f / sum;
            bf16* orow = oa + qtok * 1024 + hq * 64 + 4 * h2;
#pragma unroll
            for (int rg = 0; rg < 4; ++rg) {
                v2u w0; w0.x = pg8::cvtpk(O0[4 * rg] * inv, O0[4 * rg + 1] * inv); w0.y = pg8::cvtpk(O0[4 * rg + 2] * inv, O0[4 * rg + 3] * inv); *(GAS v2u*)(orow + 8 * rg) = w0;
                v2u w1; w1.x = pg8::cvtpk(O1[4 * rg] * inv, O1[4 * rg + 1] * inv); w1.y = pg8::cvtpk(O1[4 * rg + 2] * inv, O1[4 * rg + 3] * inv); *(GAS v2u*)(orow + 32 + 8 * rg) = w1; }
        }
    }
    __syncthreads();
}

constexpr size_t WS_QC = WS_ZT, WS_OLOC = WS_ZT + 16 * MiB, WS_SEND = WS_ZT + 48 * MiB, WS_DTOT = WS_ZT + 80 * MiB, WS_SINIT = WS_Y;
constexpr int HG_SCL = 256, HG_NSC = S / HG_SCL;
constexpr int H1_QSTR = 136, H1_TSTR = 72;
constexpr int H1_QD = 0, H1_KI = 64 * H1_QSTR * 2, H1_KT = 2 * 64 * H1_QSTR * 2, H1_VT = H1_KT + 128 * H1_TSTR * 2, H1_DC = H1_VT + 128 * H1_TSTR * 2, H1_AL = H1_DC + 2048, H1_RT = H1_AL + 2048, H1_PB = H1_RT + 512, H1_END = H1_PB + 2048;
static_assert(H1_END <= RING_BYTES, "HGRN LDS map");
typedef short s16x4v __attribute__((ext_vector_type(4)));
__device__ __forceinline__ bf16x8 cat8(s16x4v a, s16x4v b) { return (bf16x8){a[0], a[1], a[2], a[3], b[0], b[1], b[2], b[3]}; }
__device__ __forceinline__ s16x4v pack4(f32x4 v) { v2u w; w.x = pg8::cvtpk(v[0], v[1]); w.y = pg8::cvtpk(v[2], v[3]); return __builtin_bit_cast(s16x4v, w); }
__device__ __forceinline__ void hgrn_pass1(LAS unsigned char* lds, unsigned char* ws, const bf16* z, const float* lbl, int tid, int vcu, int G) {
    const int lane = tid & 63, wave = __builtin_amdgcn_readfirstlane(tid >> 6), l15 = lane & 15, q4 = lane >> 4;
    LAS bf16* QD = (LAS bf16*)(lds + H1_QD); LAS bf16* KI = (LAS bf16*)(lds + H1_KI); LAS bf16* KT = (LAS bf16*)(lds + H1_KT); LAS bf16* VT = (LAS bf16*)(lds + H1_VT);
    LAS float* DC = (LAS float*)(lds + H1_DC); LAS float* AL = (LAS float*)(lds + H1_AL); LAS float* RT = (LAS float*)(lds + H1_RT); LAS s16x4v* PB = (LAS s16x4v*)(lds + H1_PB);
    GAS bf16* qc = (GAS bf16*)(ws + WS_QC); GAS bf16* oloc = (GAS bf16*)(ws + WS_OLOC); GAS float* send = (GAS float*)(ws + WS_SEND); GAS float* dtot = (GAS float*)(ws + WS_DTOT);
    const GAS bf16* zg = (const GAS bf16*)z; const GAS float* lblg = (const GAS float*)lbl;
    for (int item = vcu; item < NB * HGH * HG_NSC; item += G) {
        const int sc = item % HG_NSC, hh = (item / HG_NSC) & 3, b = item / (HG_NSC * 4);
        const size_t tok0 = (size_t)b * S + sc * HG_SCL;
        f32x4 St[8];
#pragma unroll
        for (int i = 0; i < 8; ++i) St[i] = (f32x4){0.f, 0.f, 0.f, 0.f};
        __syncthreads();
        if (tid < 128) RT[tid] = 0.f;
        v4u vraw[2]; bf16 qraw[16], fraw[16];
        const float lbv = lblg[hh * 128 + (tid & 127)];
        const int vt2 = 16 * (wave & 1) + (lane & 15), vch = 4 * (wave >> 1) + (lane >> 4);
#define H1_LOAD(hf) do { const size_t tk_ = tok0 + 64 * (hf); \
            _Pragma("unroll") for (int j = 0; j < 2; ++j) vraw[j] = *(const GAS v4u*)(zg + (tk_ + 2 * vt2 + j) * ZW + OFF_HI + hh * 128 + 8 * vch); \
            _Pragma("unroll") for (int t = 0; t < 16; ++t) { const GAS bf16* zp_ = zg + (tk_ + 16 * (tid >> 7) + t) * ZW + hh * 128 + (tid & 127); fraw[t] = zp_[OFF_HF]; qraw[t] = zp_[OFF_HQ]; } } while (0)
        H1_LOAD(0);
        for (int half = 0; half < HG_SCL / 64; ++half) {
            const size_t tokh = tok0 + 64 * half;
            { const int c = tid >> 7, d = tid & 127;
              float fA[16], EA[16]; float eA = 1.f;
#pragma unroll
              for (int t = 0; t < 16; ++t) { const float f = lbv + (1.f - lbv) * pg8::sigm(bf2f(fraw[t])); eA = fmaxf(eA * f, 1e-30f); fA[t] = f; EA[t] = eA; }
              AL[c * 128 + d] = __logf(eA);
              __syncthreads();
              float base = RT[d];
              for (int cc = 0; cc < c; ++cc) base += AL[cc * 128 + d];
              const float ebase = __expf(base);
              unsigned kw[8], kprev = 0u;
#pragma unroll
              for (int t = 0; t < 16; ++t) { const size_t tok = tokh + 16 * c + t; const float q = bf2f(qraw[t]);
                  const float qd = q * EA[t], ki = (1.f - fA[t]) * __builtin_amdgcn_rcpf(EA[t]);
                  const unsigned qk = pg8::cvtpk(qd, ki); const bf16 kib = (bf16)(qk >> 16);
                  QD[(16 * c + t) * H1_QSTR + d] = (bf16)(qk & 0xffffu); KI[(16 * c + t) * H1_QSTR + d] = kib;
                  if (t & 1) kw[t >> 1] = kprev | (qk & 0xffff0000u); else kprev = qk >> 16;
                  qc[tok * 512 + hh * 128 + d] = (bf16)(pg8::cvtpk(qd * ebase, 0.f) & 0xffffu); }
              { LAS v4u* kt = (LAS v4u*)(KT + d * H1_TSTR + 16 * c); kt[0] = (v4u){kw[0], kw[1], kw[2], kw[3]}; kt[1] = (v4u){kw[4], kw[5], kw[6], kw[7]}; }
              DC[c * 128 + d] = eA;
            }
            { LAS unsigned* vp = (LAS unsigned*)(VT + (8 * vch) * H1_TSTR + 2 * vt2); const v4u va = vraw[0], vb = vraw[1];
              vp[0 * (H1_TSTR / 2)] = __builtin_amdgcn_perm(vb.x, va.x, 0x05040100u); vp[1 * (H1_TSTR / 2)] = __builtin_amdgcn_perm(vb.x, va.x, 0x07060302u);
              vp[2 * (H1_TSTR / 2)] = __builtin_amdgcn_perm(vb.y, va.y, 0x05040100u); vp[3 * (H1_TSTR / 2)] = __builtin_amdgcn_perm(vb.y, va.y, 0x07060302u);
              vp[4 * (H1_TSTR / 2)] = __builtin_amdgcn_perm(vb.z, va.z, 0x05040100u); vp[5 * (H1_TSTR / 2)] = __builtin_amdgcn_perm(vb.z, va.z, 0x07060302u);
              vp[6 * (H1_TSTR / 2)] = __builtin_amdgcn_perm(vb.w, va.w, 0x05040100u); vp[7 * (H1_TSTR / 2)] = __builtin_amdgcn_perm(vb.w, va.w, 0x07060302u); }
            __syncthreads();
            if (half + 1 < HG_SCL / 64) H1_LOAD(half + 1);
            if (tid < 128) { float r = RT[tid]; for (int cc = 0; cc < 4; ++cc) r += AL[cc * 128 + tid]; RT[tid] = r; if (half == HG_SCL / 64 - 1) dtot[(size_t)item * 128 + tid] = __expf(r); }
            if (wave < 4) { const int c = wave; f32x4 PT = {0.f, 0.f, 0.f, 0.f};
                const LAS bf16* qrow = QD + (16 * c + l15) * H1_QSTR; const LAS bf16* krow = KI + (16 * c + l15) * H1_QSTR;
#pragma unroll
                for (int kk = 0; kk < 4; ++kk) { const bf16x8 ka = *(const LAS bf16x8*)(krow + 32 * kk + 8 * q4), qb = *(const LAS bf16x8*)(qrow + 32 * kk + 8 * q4);
                    PT = __builtin_amdgcn_mfma_f32_16x16x32_bf16(ka, qb, PT, 0, 0, 0); }
#pragma unroll
                for (int i = 0; i < 4; ++i) if (4 * q4 + i > l15) PT[i] = 0.f;
                PB[c * 64 + lane] = pack4(PT); }
            __syncthreads();
            const int e0 = 16 * wave;
            for (int c = 0; c < 4; ++c) {
                f32x4 O = {0.f, 0.f, 0.f, 0.f};
                const LAS bf16* qrow = QD + (16 * c + l15) * H1_QSTR;
#pragma unroll
                for (int kk = 0; kk < 4; ++kk) {
                    const bf16x8 sb = cat8(pack4(St[2 * kk]), pack4(St[2 * kk + 1]));
                    const bf16x8 qa = cat8(*(const LAS s16x4v*)(qrow + 32 * kk + 4 * q4), *(const LAS s16x4v*)(qrow + 32 * kk + 16 + 4 * q4));
                    O = __builtin_amdgcn_mfma_f32_16x16x32_bf16(qa, sb, O, 0, 0, 0);
                }
                const s16x4v vf = *(const LAS s16x4v*)(VT + (e0 + l15) * H1_TSTR + 16 * c + 4 * q4);
                O = __builtin_amdgcn_mfma_f32_16x16x16bf16_1k(PB[c * 64 + lane], vf, O, 0, 0, 0);
#pragma unroll
                for (int db = 0; db < 8; ++db) {
                    const s16x4v kf = *(const LAS s16x4v*)(KT + (16 * db + l15) * H1_TSTR + 16 * c + 4 * q4);
                    St[db] = __builtin_amdgcn_mfma_f32_16x16x16bf16_1k(kf, vf, St[db], 0, 0, 0);
                    const f32x4 dc = *(const LAS f32x4*)(DC + c * 128 + 16 * db + 4 * q4);
                    St[db] = St[db] * dc;
                }
#pragma unroll
                for (int i = 0; i < 4; ++i) oloc[(tokh + 16 * c + 4 * q4 + i) * 512 + hh * 128 + e0 + l15] = (bf16)(pg8::cvtpk(O[i], 0.f) & 0xffffu);
            }
            __syncthreads();
        }
#pragma unroll
        for (int db = 0; db < 8; ++db) *(GAS f32x4*)(send + ((size_t)item * 128 + 16 * wave + l15) * 128 + 16 * db + 4 * q4) = St[db];
    }
    __syncthreads();
}
#undef H1_LOAD
__device__ __forceinline__ void hgrn_scan(unsigned char* ws, int tid, int vcu, int G) {
    const float* send = (const float*)(ws + WS_SEND); const float* dtot = (const float*)(ws + WS_DTOT); unsigned* sinit = (unsigned*)(ws + WS_SINIT);
    for (int gid = vcu * (NWAVES * 64) + tid; gid < NB * HGH * 64 * 128; gid += G * NWAVES * 64) {
        const int dp = gid & 63, e = (gid >> 6) & 127, bh = gid >> 13;
        float s0 = 0.f, s1 = 0.f;
#pragma unroll
        for (int sc = 0; sc < HG_NSC - 1; ++sc) { const size_t item = (size_t)bh * HG_NSC + sc;
            const f32x2 av = *(const GAS f32x2*)(send + (item * 128 + e) * 128 + 2 * dp), dv = *(const GAS f32x2*)(dtot + item * 128 + 2 * dp);
            s0 = fmaf(dv.x, s0, av.x); s1 = fmaf(dv.y, s1, av.y);
            sinit[((item + 1) * 128 + e) * 64 + dp] = pk2(s0, s1); }
    }
}
__device__ __forceinline__ void hgrn_pass3(LAS unsigned char* lds, unsigned char* ws, const bf16* z, const float* ng, bf16* ob, int tid, int vcu, int G) {
    const int lane = tid & 63, wave = __builtin_amdgcn_readfirstlane(tid >> 6), l15 = lane & 15, q4 = lane >> 4;
    const bf16* qc = (const bf16*)(ws + WS_QC); const bf16* oloc = (const bf16*)(ws + WS_OLOC); const bf16* sinit = (const bf16*)(ws + WS_SINIT);
    for (int item = vcu; item < NB * HGH * HG_NSC; item += G) {
        const int sc = item % HG_NSC, hh = (item / HG_NSC) & 3, b = item / (HG_NSC * 4);
        constexpr int TB = HG_SCL / 128;
        const size_t tokw = (size_t)b * S + sc * HG_SCL + 16 * TB * wave + l15;
        f32x4 acc[TB][8]; v2u gzv[TB][8]; f32x4 gnv[8];
#pragma unroll
        for (int tb = 0; tb < TB; ++tb)
#pragma unroll
            for (int eb = 0; eb < 8; ++eb) { { const v2u ol = *(const GAS v2u*)(oloc + (tokw + 16 * tb) * 512 + hh * 128 + 16 * eb + 4 * q4); acc[tb][eb] = (f32x4){pg8::bf_lo(ol.x), pg8::bf_hi(ol.x), pg8::bf_lo(ol.y), pg8::bf_hi(ol.y)}; }
                gzv[tb][eb] = *(const GAS v2u*)(z + (tokw + 16 * tb) * ZW + OFF_HG + hh * 128 + 16 * eb + 4 * q4); }
#pragma unroll
        for (int eb = 0; eb < 8; ++eb) gnv[eb] = *(const GAS f32x4*)(ng + 16 * eb + 4 * q4);
        if (sc > 0) {
            __syncthreads();
            { LAS v4u* SL = (LAS v4u*)lds; const GAS v4u* sg = (const GAS v4u*)(sinit + (size_t)item * 128 * 128);
              v4u t4[4];
#pragma unroll
              for (int i = 0; i < 4; ++i) t4[i] = sg[tid + 512 * i];
#pragma unroll
              for (int i = 0; i < 4; ++i) { const int idx = tid + 512 * i, row = idx >> 4, ch = idx & 15; SL[row * 17 + ch] = t4[i]; } }
            __syncthreads();
            bf16x8 bq[TB][4];
#pragma unroll
            for (int tb = 0; tb < TB; ++tb)
#pragma unroll
                for (int kk = 0; kk < 4; ++kk) bq[tb][kk] = *(const GAS bf16x8*)(qc + (tokw + 16 * tb) * 512 + hh * 128 + 32 * kk + 8 * q4);
#pragma unroll
            for (int eb = 0; eb < 8; ++eb)
#pragma unroll
                for (int kk = 0; kk < 4; ++kk) { const bf16x8 sa = *(const LAS bf16x8*)(lds + ((16 * eb + l15) * 17 + 4 * kk + q4) * 16);
#pragma unroll
                    for (int tb = 0; tb < TB; ++tb) acc[tb][eb] = __builtin_amdgcn_mfma_f32_16x16x32_bf16(sa, bq[tb][kk], acc[tb][eb], 0, 0, 0); }
        }
#pragma unroll
        for (int tb = 0; tb < TB; ++tb) { const size_t tok = tokw + 16 * tb;
            float ss = 0.f;
#pragma unroll
            for (int eb = 0; eb < 8; ++eb) {
                ss += (acc[tb][eb][0] * acc[tb][eb][0] + acc[tb][eb][1] * acc[tb][eb][1]) + (acc[tb][eb][2] * acc[tb][eb][2] + acc[tb][eb][3] * acc[tb][eb][3]); }
            ss += __builtin_bit_cast(float, __builtin_amdgcn_ds_bpermute((lane ^ 16) << 2, __builtin_bit_cast(int, ss)));
            ss += __builtin_bit_cast(float, __builtin_amdgcn_ds_bpermute((lane ^ 32) << 2, __builtin_bit_cast(int, ss)));
            const float r = rsqrtf(ss * (1.f / DV) + EPS);
#pragma unroll
            for (int eb = 0; eb < 8; ++eb) { const int e = 16 * eb + 4 * q4;
                const f32x4 gn = gnv[eb]; const v2u gz = gzv[tb][eb];
                const float g0 = pg8::bf_lo(gz.x), g1 = pg8::bf_hi(gz.x), g2 = pg8::bf_lo(gz.y), g3 = pg8::bf_hi(gz.y);
                v2u w; w.x = pg8::cvtpk(acc[tb][eb][0] * r * gn[0] * pg8::silu(g0), acc[tb][eb][1] * r * gn[1] * pg8::silu(g1)); w.y = pg8::cvtpk(acc[tb][eb][2] * r * gn[2] * pg8::silu(g2), acc[tb][eb][3] * r * gn[3] * pg8::silu(g3));
                *(GAS v2u*)(ob + tok * 1024 + hh * 128 + e) = w; } }
    }
}
constexpr int PH_PRO = 0, PH_L0 = 1, PH_PER_LAYER = 16, PH_FINAL = PH_L0 + DEPTH * PH_PER_LAYER, PH_END = PH_FINAL + 1;
constexpr int P_N1 = 0, P_G1 = 1, P_ATT = 2, P_SCAN = 3, P_HG3 = 4, P_G2 = 5, P_G3 = 6, P_N2 = 7, P_R2 = 8, P_G4 = 9, P_G5 = 10, P_CMB = 11, P_N3 = 12, P_G6 = 13, P_G6B = 14;

__global__ void __launch_bounds__(NWAVES * 64, 2) mk_fwd(Args args) {
    extern __shared__ __attribute__((aligned(16))) unsigned char lds[];
    Frame F;
    F.lds = (LAS unsigned char*)lds;
    F.MISC = (volatile LAS unsigned*)(F.lds + MISC_OFF);
    F.tid = threadIdx.x; F.lane = F.tid & 63; F.wave = __builtin_amdgcn_readfirstlane(F.tid >> 6);
    F.G = gridDim.x; { const int bx = blockIdx.x; F.vcu = (F.G % 8 == 0) ? (bx % 8) * (F.G / 8) + bx / 8 : bx; }
    const Args* ap = (const Args*)__builtin_amdgcn_kernarg_segment_ptr();
    unsigned char* ws = ap->ws;
    F.ctl = (gu32*)(ws + WS_CTL);
    for (int u = F.tid; u < (LDS_BYTES - LDSCTL_OFF) / 4; u += NWAVES * 64) ((LAS unsigned*)(F.lds + LDSCTL_OFF))[u] = 0u;
    __syncthreads();
    XcdBarrier bar = xcd_barrier_post((unsigned*)(F.ctl + CW_BAR) + ap->li * BAR_STRIDE, F.MISC + 8);
    int lo = ap->ph_lo, hi = ap->ph_hi;
#define OPQ_RANGE() asm volatile("" : "+s"(lo), "+s"(hi), "+s"(ws), "+s"(ap))
#define IN(k) (lo <= (k) && (k) < hi)
#define SEAM(k) do { if (hi > (k) + 1) { OPQ_LANE(); xcd_barrier(bar, tidv); } } while (0)
#define ROWLOOP(m) int m = gw; asm volatile("" : "+s"(m)); for (; m < M; m += NGW)
#define OPQ_LANE() int z_ = 0; asm volatile("" : "+v"(z_)); const int ln = (int)__builtin_amdgcn_mbcnt_hi(~0u, __builtin_amdgcn_mbcnt_lo(~0u, (unsigned)z_)); const int tidv = F.wave * 64 + ln; (void)tidv; int bix = blockIdx.x; asm volatile("" : "+s"(bix)); (void)bix

    const int gw = F.vcu * NWAVES + F.wave, NGW = F.G * NWAVES;
#define RSTD_TBL(So, sspp) LAS float* rtb = (LAS float*)(F.lds + RSTD_OFF); int tpm; { pg8::Unit u0{0, 0}; (void)So.next(0, u0); tpm = u0.pm; if (ln + 64 * F.wave < 256) rtb[tidv] = pg8::row_rstd((sspp), (size_t)tpm * 256 + tidv); __syncthreads(); }
#define ULIST_FILL(listp, nn) LAS int* ulp = (LAS int*)(F.lds + LDSCTL_OFF + 4096); { const int i_ = ln + 64 * F.wave; if (i_ < 32) { const long L_ = (long)i_ * F.G + bix; if (L_ < (nn)) { int w_ = (int)L_; \
        { const int q_ = (nn) / 8, r_ = (nn) % 8, x_ = w_ % 8, o_ = w_ / 8; w_ = (x_ < r_ ? x_ * (q_ + 1) : r_ * (q_ + 1) + (x_ - r_) * q_) + o_; } ulp[2 * i_] = ld_agent_i((listp) + 2 * w_); ulp[2 * i_ + 1] = ld_agent_i((listp) + 2 * w_ + 1); } } __syncthreads(); }
#define WSPTRS() bf16* const un = (bf16*)(ws + WS_OA + 34 * MiB); (void)un;     \
    unsigned short* const hx = (unsigned short*)(ws + WS_U2); unsigned short* const hy = (unsigned short*)(ws + WS_U); (void)hx; (void)hy; bf16* const ub = (bf16*)(ws + WS_U); bf16* const zb = (bf16*)(ws + WS_Z); bf16* const oa = (bf16*)(ws + WS_OA); bf16* const ob = (bf16*)(ws + WS_OA) + 512; bf16* const mg = (bf16*)(ws + WS_MG); \
    (void)ub; (void)zb; (void)oa; (void)ob; (void)mg

    if (IN(PH_PRO)) { p0_prologue(F, *ap); SEAM(PH_PRO); }

    for (int l = 0; l < DEPTH; ++l) {
        OPQ_RANGE();
        WSPTRS();
        const int pb = PH_L0 + l * PH_PER_LAYER;
        if (IN(pb + P_G1)) {
            OPQ_LANE();
            if (bix >= 192) {
                const int rk = (bix - 192) * NWAVES + F.wave, id0 = (l & 1) ? MT_G1 + MT_G4 : 0;
                for (int k = 0; k < MT_N1; ++k) moe_cvt_tile(*ap, l >> 1, id0 + rk + k * (64 * NWAVES), ln); }
            pg8::Gemm g{(const bf16*)(ws + WS_U2), (const bf16*)(ws + W_IN) + (size_t)l * INW * D, M, INW, D}; pg8::StaticOrder So; So.init(M, INW, F.G, bix);
            RSTD_TBL(So, (const float*)(ws + WS_TBL + T_SSP2));
            pg8::EpiZG E{zb, ZW, (unsigned char*)(ws + WS_GZ), rtb}; (void)tpm;
            pg8::gemm_phase<pg8::EpiZG, pg8::StaticOrder, true, true, 2>(F.lds + RING_OFF, g, So, E, tidv);
            SEAM(pb + P_G1);
        }
        if (IN(pb + P_ATT)) {
            OPQ_LANE();
            attn_phase(F.lds + RING_OFF, zb, ap->in[3] + l * HQ, ap->in[4], oa, tidv, F.vcu, F.G);
            hgrn_pass1(F.lds + RING_OFF, ws, zb, (const float*)(ws + WS_TBL + T_LB) + l * 512, tidv, F.vcu, F.G);
            SEAM(pb + P_ATT);
        }
        if (IN(pb + P_SCAN)) {
            OPQ_LANE();
            hgrn_scan(ws, tidv, F.vcu, F.G);
            SEAM(pb + P_SCAN);
        }
        if (IN(pb + P_HG3)) {
            OPQ_LANE();
            hgrn_pass3(F.lds + RING_OFF, ws, zb, ap->in[6] + l * DV, ob, tidv, F.vcu, F.G);
            SEAM(pb + P_HG3);
        }
        if (IN(pb + P_G2)) {
            OPQ_LANE();
            pg8::StaticOrder So; So.init(M, D, F.G, bix);
            { pg8::Gemm g{oa, (const bf16*)(ws + W_A) + (size_t)l * D * D, M, D, D};
              pg8::EpiGateM E{mg, D, (const unsigned char*)(ws + WS_GZ), 2 * D};
              pg8::gemm_phase<pg8::EpiGateM, pg8::StaticOrder, true, true, 0, true>(F.lds + RING_OFF, g, So, E, tidv); }
            SEAM(pb + P_G2);
        }
        if (IN(pb + P_G3)) {
            OPQ_LANE();
            pg8::Gemm g{mg, (const bf16*)(ws + W_OUT) + (size_t)l * D * D, M, D, D}; pg8::StaticOrder So; So.init(M, D, F.G, bix);
            pg8::EpiResH E{hx, hy, (float*)(ws + WS_TBL + T_SSP), D, 1.f};
            pg8::gemm_phase<pg8::EpiResH, pg8::StaticOrder, true, true>(F.lds + RING_OFF, g, So, E, tidv);
            SEAM(pb + P_G3);
        }
        if (IN(pb + P_N2)) {
            if (l & 1) {
                OPQ_LANE();
                LAS int* T = (LAS int*)(F.lds + RING_OFF);
                if (tidv < 8) T[tidv] = 0;
                __syncthreads();
                const float* rw = ap->in[16] + (size_t)(l >> 1) * D * NE; const float* gn = ap->in[11] + l * D;
                LAS f32x4* RW = (LAS f32x4*)(F.lds + RING_OFF + 1024);
#pragma unroll
                for (int i = 0; i < 4; ++i) { const int j = tidv + 512 * i, k = j >> 1;
                    RW[((((k >> 8) * 4 + (k & 3)) * 2 + (j & 1)) << 6) + ((k >> 2) & 63)] = ((const GAS f32x4*)rw)[j]; }
                f32x4 gv[4];
#pragma unroll
                for (int q = 0; q < 4; ++q) gv[q] = ((const GAS f32x4*)gn)[ln + 64 * q];
                __syncthreads();
                const int tpw = M / F.G / NWAVES;
                int* toke = (int*)(ws + WS_TBL + T_TOKE); f32x2* tokw = (f32x2*)(ws + WS_TBL + T_TOKW);
                const int tw0 = (F.vcu * NWAVES + F.wave) * tpw;
                v2u hn[2][4];
#pragma unroll
                for (int r = 0; r < 2; ++r) { const GAS v2u* xr = (const GAS v2u*)(hy + (size_t)(tw0 + r) * D) + ln;
#pragma unroll
                    for (int q = 0; q < 4; ++q) hn[r][q] = xr[64 * q]; }
                for (int j = 0; j < tpw; j += 2) {
                    const int t0 = tw0 + j;
                    f32x4 v[2][4]; float ss[2] = {0.f, 0.f};
#pragma unroll
                    for (int r = 0; r < 2; ++r)
#pragma unroll
                        for (int q = 0; q < 4; ++q) { const v2u hv = hn[r][q]; v[r][q] = (f32x4){pg8::f16_lo(hv.x), pg8::f16_hi(hv.x), pg8::f16_lo(hv.y), pg8::f16_hi(hv.y)}; }
                    if (j + 2 < tpw) {
#pragma unroll
                        for (int r = 0; r < 2; ++r) { const GAS v2u* xr = (const GAS v2u*)(hy + (size_t)(t0 + 2 + r) * D) + ln;
#pragma unroll
                            for (int q = 0; q < 4; ++q) hn[r][q] = xr[64 * q]; } }
#pragma unroll
                    for (int r = 0; r < 2; ++r) {
#pragma unroll
                        for (int q = 0; q < 4; ++q) ss[r] += (v[r][q].x * v[r][q].x + v[r][q].y * v[r][q].y) + (v[r][q].z * v[r][q].z + v[r][q].w * v[r][q].w); }
                    float rstd[2]; rstd[0] = rsqrtf(wave_sum(ss[0], ln) * (1.f / D) + EPS); rstd[1] = rsqrtf(wave_sum(ss[1], ln) * (1.f / D) + EPS);
                    float lg[2][8];
#pragma unroll
                    for (int r = 0; r < 2; ++r)
#pragma unroll
                        for (int e = 0; e < 8; ++e) lg[r][e] = 0.f;
#pragma unroll
                    for (int q = 0; q < 4; ++q) { f32x4 uu[2];
#pragma unroll
                        for (int r = 0; r < 2; ++r) { uu[r] = v[r][q] * rstd[r] * gv[q]; ((GAS unsigned*)((unsigned char*)un + (size_t)(t0 + r) * D) + ln)[64 * q] = pg8::pk4_fp8(uu[r].x, uu[r].y, uu[r].z, uu[r].w); }
                        const LAS f32x4* wr4 = RW + q * 512 + ln;
#pragma unroll
                        for (int c = 0; c < 4; ++c) { const f32x4 w0 = wr4[128 * c], w1 = wr4[128 * c + 64];
#pragma unroll
                            for (int r = 0; r < 2; ++r) { const float xv = uu[r][c];
                                lg[r][0] = fmaf(xv, w0.x, lg[r][0]); lg[r][1] = fmaf(xv, w0.y, lg[r][1]); lg[r][2] = fmaf(xv, w0.z, lg[r][2]); lg[r][3] = fmaf(xv, w0.w, lg[r][3]);
                                lg[r][4] = fmaf(xv, w1.x, lg[r][4]); lg[r][5] = fmaf(xv, w1.y, lg[r][5]); lg[r][6] = fmaf(xv, w1.z, lg[r][6]); lg[r][7] = fmaf(xv, w1.w, lg[r][7]); } } }
#pragma unroll
                    for (int r = 0; r < 2; ++r)
#pragma unroll
                        for (int e = 0; e < 8; ++e) lg[r][e] = wave_sum(lg[r][e], ln);
#pragma unroll
                    for (int r = 0; r < 2; ++r) {
                        int i1 = 0; float v1 = lg[r][0];
#pragma unroll
                        for (int e = 1; e < 8; ++e) if (lg[r][e] > v1) { v1 = lg[r][e]; i1 = e; }
                        int i2 = -1; float v2 = -INFINITY;
#pragma unroll
                        for (int e = 0; e < 8; ++e) if (e != i1 && lg[r][e] > v2) { v2 = lg[r][e]; i2 = e; }
                        const float e2 = __expf(v2 - v1), w1g = 1.f / (1.f + e2), w2g = e2 / (1.f + e2);
                        if (ln == 0) { toke[t0 + r] = i1 | (i2 << 8); tokw[t0 + r] = (f32x2){w1g, w2g}; atomicAdd((int*)&T[i1], 1); atomicAdd((int*)&T[i2], 1); } }
                }
                __syncthreads();
                if (tidv < 8) ((int*)(ws + WS_TBL + T_CNT))[F.vcu * 8 + tidv] = T[tidv];
            }
            if (l & 1) SEAM(pb + P_N2);
        }
        if (IN(pb + P_R2)) {
            if (l & 1) {
                OPQ_LANE();
                LAS int* T = (LAS int*)(F.lds + RING_OFF);
                const int tpg = M / F.G;
                v4u a4[16];
#pragma unroll
                for (int k = 0; k < 16; ++k) { const int r = F.wave + k * NWAVES, t = F.vcu * tpg + (r >> 1); a4[k] = ((const GAS v4u*)((const unsigned char*)un + (size_t)t * D))[ln]; }
                moe_tables(T, (const int*)(ws + WS_TBL + T_CNT), F.G, F.vcu, tidv);
                const int* toke = (const int*)(ws + WS_TBL + T_TOKE); const f32x2* tokw = (const f32x2*)(ws + WS_TBL + T_TOKW);
                i32x2* posg = (i32x2*)(ws + WS_TBL + T_POS); float* roww = (float*)(ws + WS_TBL + T_ROWW);
                bf16* ag = (bf16*)(ws + WS_AG);
                LAS int* P = T + 64;
                if (F.wave == 0) {
                    for (int t0 = 0; t0 < tpg; t0 += 64) {
                        const int tl = t0 + ln, t = F.vcu * tpg + tl; const bool ok = tl < tpg;
                        const int ee = ok ? toke[t] : 0x0808; const int e1 = ee & 255, e2 = ee >> 8;
                        int p1 = 0, p2 = 0;
#pragma unroll
                        for (int e = 0; e < 8; ++e) { const unsigned long long mk = __ballot(ok && (e1 == e || e2 == e)); const int rk = __popcll(mk & ((1ull << ln) - 1ull));
                            const int base = T[16 + e] + T[8 + e] + T[48 + e];
                            if (e1 == e) p1 = base + rk; if (e2 == e) p2 = base + rk;
                            if (ln == 0) T[48 + e] += __popcll(mk); }
                        if (ok) { P[2 * tl] = p1; P[2 * tl + 1] = p2; posg[t] = (i32x2){p1, p2}; const f32x2 w = tokw[t]; roww[p1] = w.x; roww[p2] = w.y; }
                    }
                }
                __syncthreads();
#pragma unroll
                for (int k = 0; k < 16; ++k) ((GAS v4u*)((unsigned char*)ag + (size_t)P[F.wave + k * NWAVES] * D))[ln] = a4[k];
                if (F.vcu < 8) {
                    const int e = F.vcu, r0 = T[16 + e] + T[e], r1 = T[16 + e] + T[24 + e] * 256;
                    for (int r = r0 + F.wave; r < r1; r += NWAVES) { GAS v2u* dst = (GAS v2u*)((unsigned char*)ag + (size_t)r * D) + ln; dst[0] = (v2u){0u, 0u}; dst[64] = (v2u){0u, 0u}; if (ln == 0) roww[r] = 0.f; }
                }
                {
                    const int nu = T[40] * NT_UP, nd = T[40] * NT_DN;
                    i32x2* lu = (i32x2*)(ws + WS_TBL + T_LISTU); i32x2* ld = (i32x2*)(ws + WS_TBL + T_LISTD);
                    for (int L = F.vcu * (NWAVES * 64) + tidv; L < nu; L += F.G * NWAVES * 64) lu[L] = moe_unit(T, L, NT_UP);
                    for (int L = F.vcu * (NWAVES * 64) + tidv; L < nd; L += F.G * NWAVES * 64) ld[L] = moe_unit(T, L, NT_DN);
                    if (F.vcu == 8 % F.G && tidv == 0) { ((int*)(ws + WS_TBL + T_NUN))[0] = nu; ((int*)(ws + WS_TBL + T_NUN))[1] = nd; }
                }
                __syncthreads();
            }
            if (l & 1) SEAM(pb + P_R2);
        }
        if (IN(pb + P_G4)) {
            OPQ_LANE();
            if (l & 1) {
                OPQ_LANE();
                const int nu = __builtin_amdgcn_readfirstlane(ld_agent_i((const int*)(ws + WS_TBL + T_NUN)));
                pg8::Gemm g{(const bf16*)(ws + WS_AG), (const bf16*)(ws + W_13M + (size_t)(l >> 1) * NE * 2 * FE * D), MOE_ROWS, NE * 2 * FE, D / 2};
                ULIST_FILL((const int*)(ws + WS_TBL + T_LISTU), nu);
                pg8::ListOrderL So{ulp, nu, F.G, bix};
                pg8::EpiSwiglu8 E{(unsigned char*)zb, FE, NT_UP, 1.f / 32.f};
                pg8::gemm_phase<pg8::EpiSwiglu8, pg8::ListOrderL, true, true, true>(F.lds + RING_OFF, g, So, E, tidv);
            }
            if ((l & 1) == 0) {
                if (bix >= 128) { const int rk = (bix - 128) * NWAVES + F.wave;
                    for (int k = 0; k < MT_N4; ++k) moe_cvt_tile(*ap, l >> 1, MT_G1 + rk + k * (128 * NWAVES), ln); }
                { OPQ_LANE();
                  const int nun = (M / 256) * (2 * FD / 256), nfull = nun / F.G, nbusy = nun - nfull * F.G, nsub = F.G - nbusy;
                  pg8::SubOrder Sp{nsub > 0 ? (bix >= nbusy ? bix - nbusy : -1) : bix, nsub > 0 ? nsub : F.G, (M / 256) * (D / 256)};
                  int kple = PLE; asm volatile("" : "+s"(kple));
                  pg8::Gemm gp{(const bf16*)(ws + WS_PB) + (size_t)l * M * PLE, (const bf16*)(ws + W_PP) + (size_t)l * D * PLE, M, D, kple};
                  pg8::EpiBfPlain Ep{mg, D};
                  pg8::gemm_phase<pg8::EpiBfPlain, pg8::SubOrder, true, true>(F.lds + RING_OFF, gp, Sp, Ep, tidv); }
                OPQ_LANE();
                pg8::Gemm g{ub, (const bf16*)(ws + W_13D) + (size_t)(l >> 1) * 2 * FD * D, M, 2 * FD, D}; pg8::StaticOrder So; So.init(M, 2 * FD, F.G, bix);
                RSTD_TBL(So, (const float*)(ws + WS_TBL + T_SSP));
                pg8::EpiSwigluN E{zb, FD, (const float*)(ws + WS_TBL + T_SSP), rtb, tpm};
                pg8::gemm_phase<pg8::EpiSwigluN, pg8::StaticOrder, true, true, 2>(F.lds + RING_OFF, g, So, E, tidv);

            }
            SEAM(pb + P_G4);
        }
        if (IN(pb + P_G5)) {
            OPQ_LANE();
            if (l & 1) {
                { OPQ_LANE(); const int nd = __builtin_amdgcn_readfirstlane(ld_agent_i((const int*)(ws + WS_TBL + T_NUN) + 1));
                  const int nfull = nd / F.G, nbusy = nd - nfull * F.G, nsub = F.G - nbusy;
                  pg8::SubOrder Sp{nsub > 0 ? (bix >= nbusy ? bix - nbusy : -1) : bix, nsub > 0 ? nsub : F.G, (M / 256) * (D / 256)};
                  int kple = PLE; asm volatile("" : "+s"(kple));
                  pg8::Gemm gp{(const bf16*)(ws + WS_PB) + (size_t)l * M * PLE, (const bf16*)(ws + W_PP) + (size_t)l * D * PLE, M, D, kple};
                  pg8::EpiBfPlain Ep{mg, D};
                  pg8::gemm_phase<pg8::EpiBfPlain, pg8::SubOrder, true, true>(F.lds + RING_OFF, gp, Sp, Ep, tidv); }
                { OPQ_LANE(); const int nd = __builtin_amdgcn_readfirstlane(ld_agent_i((const int*)(ws + WS_TBL + T_NUN) + 1));
                  pg8::Gemm g{zb, (const bf16*)(ws + W_2M + (size_t)(l >> 1) * NE * D * FE), MOE_ROWS, NE * D, FE / 2};
                  ULIST_FILL((const int*)(ws + WS_TBL + T_LISTD), nd);
                  pg8::ListOrderL So{ulp, nd, F.G, bix};
                  pg8::EpiMoeDown E{(bf16*)(ws + WS_Y), D, (const float*)(ws + WS_TBL + T_ROWW), NT_DN, 1.f / 256.f};
                  pg8::gemm_phase<pg8::EpiMoeDown, pg8::ListOrderL, true, true, true>(F.lds + RING_OFF, g, So, E, tidv); }

            }
            if ((l & 1) == 0) {
                OPQ_LANE();
                pg8::Gemm g{zb, (const bf16*)(ws + W_2D) + (size_t)(l >> 1) * D * FD, M, D, FD}; pg8::StaticOrder So; So.init(M, D, F.G, bix);
                pg8::EpiResH E{hy, hy, (float*)(ws + WS_TBL + T_SSP), D, 1.f};
                pg8::gemm_phase<pg8::EpiResH, pg8::StaticOrder, true, true>(F.lds + RING_OFF, g, So, E, tidv);
            }
            SEAM(pb + P_G5);
        }
        if (IN(pb + P_CMB)) {
            if (l & 1) {
                OPQ_LANE();
                const bf16* Y = (const bf16*)(ws + WS_Y); const int* posg = (const int*)(ws + WS_TBL + T_POS);
                int gwo = gw; asm volatile("" : "+s"(gwo));
                const int pr = gwo + (ln & 7) * NGW; const int p1v = ld_agent_i(posg + 2 * pr), p2v = ld_agent_i(posg + 2 * pr + 1);
                for (int k0 = 0; k0 < M / NGW; k0 += 4) {
                    v2u hv[4][4], ya[4][4], yb[4][4];
#pragma unroll
                    for (int r = 0; r < 4; ++r) { const int p1 = __builtin_amdgcn_readlane(p1v, k0 + r), p2 = __builtin_amdgcn_readlane(p2v, k0 + r);
                        const GAS v2u* xr = (const GAS v2u*)(hy + (size_t)(gwo + (k0 + r) * NGW) * D) + ln;
                        const GAS v2u* y1 = (const GAS v2u*)(Y + (size_t)p1 * D) + ln; const GAS v2u* y2 = (const GAS v2u*)(Y + (size_t)p2 * D) + ln;
#pragma unroll
                        for (int q = 0; q < 4; ++q) { hv[r][q] = xr[64 * q]; ya[r][q] = y1[64 * q]; yb[r][q] = y2[64 * q]; } }
#pragma unroll
                    for (int r = 0; r < 4; ++r) { const int mr = gwo + (k0 + r) * NGW; float ss = 0.f; f32x4 v[4];
#pragma unroll
                        for (int q = 0; q < 4; ++q) { const v2u h = hv[r][q], a = ya[r][q], b = yb[r][q];
                            v[q].x = pg8::f16_lo(h.x) + (pg8::bf_lo(a.x) + pg8::bf_lo(b.x)); v[q].y = pg8::f16_hi(h.x) + (pg8::bf_hi(a.x) + pg8::bf_hi(b.x));
                            v[q].z = pg8::f16_lo(h.y) + (pg8::bf_lo(a.y) + pg8::bf_lo(b.y)); v[q].w = pg8::f16_hi(h.y) + (pg8::bf_hi(a.y) + pg8::bf_hi(b.y));
                            ss += (v[q].x * v[q].x + v[q].y * v[q].y) + (v[q].z * v[q].z + v[q].w * v[q].w); }
                        ss = wave_sum(ss, ln);
                        GAS v2u* o8 = (GAS v2u*)(ub + (size_t)mr * D) + ln;
#pragma unroll
                        for (int q = 0; q < 4; ++q) { v2u w; w.x = pg8::pk_f16(v[q].x, v[q].y); w.y = pg8::pk_f16(v[q].z, v[q].w); o8[64 * q] = w; }
                        if (ln < 16) ((float*)(ws + WS_TBL + T_SSP))[(size_t)mr * 16 + ln] = (ln == 0) ? ss : 0.f; }
                }
            }
            if (l & 1) SEAM(pb + P_CMB);
        }
        if (IN(pb + P_G6)) {
            OPQ_LANE();
            pg8::StaticOrder So; So.init(M, D, F.G, bix);
            { pg8::Gemm g{ub, (const bf16*)(ws + W_PG) + (size_t)l * D * D, M, D, D};
              RSTD_TBL(So, (const float*)(ws + WS_TBL + T_SSP)); (void)tpm;
              pg8::EpiPleH E{hy, hx, mg, (float*)(ws + WS_TBL + T_SSP2), D, rtb};
              pg8::gemm_phase<pg8::EpiPleH, pg8::StaticOrder, true, true, 2>(F.lds + RING_OFF, g, So, E, tidv); }
            SEAM(pb + P_G6B);
        }
    }
    OPQ_RANGE();
    if (IN(PH_FINAL)) {
        WSPTRS();
        OPQ_LANE();
        { int m = gw; asm volatile("" : "+s"(m)); const GAS f32x4* gr = (const GAS f32x4*)ap->in[22] + ln;
          for (; m < M; m += 2 * NGW) { f32x4 v[2][4]; float ss[2] = {0.f, 0.f};
#pragma unroll
              for (int r = 0; r < 2; ++r) { const GAS v2u* xr = (const GAS v2u*)(hx + (size_t)(m + r * NGW) * D) + ln;
#pragma unroll
                  for (int q = 0; q < 4; ++q) { const v2u hv = xr[64 * q]; v[r][q] = (f32x4){pg8::f16_lo(hv.x), pg8::f16_hi(hv.x), pg8::f16_lo(hv.y), pg8::f16_hi(hv.y)}; } }
#pragma unroll
              for (int r = 0; r < 2; ++r) {
#pragma unroll
                  for (int q = 0; q < 4; ++q) ss[r] += (v[r][q].x * v[r][q].x + v[r][q].y * v[r][q].y) + (v[r][q].z * v[r][q].z + v[r][q].w * v[r][q].w);
                  const float rstd = rsqrtf(wave_sum(ss[r], ln) * (1.f / D) + EPS); GAS f32x4* o = (GAS f32x4*)(ap->out + (size_t)(m + r * NGW) * D) + ln;
#pragma unroll
                  for (int q = 0; q < 4; ++q) o[64 * q] = v[r][q] * rstd * gr[64 * q]; } } }
    }
#undef IN
#undef SEAM
#undef OPQ_LANE
#undef ROWLOOP
#undef OPQ_RANGE
#undef WSPTRS
#undef ULIST_FILL
#undef RSTD_TBL
}

extern "C" void kernel_launch(void* const* d_in, const int* in_sizes, int n_in, void* d_out, int out_size, void* d_ws, size_t ws_size, hipStream_t stream) {
    static int grid = 0;
    if (grid == 0) {
        if (n_in != 23 || out_size != M * D || ws_size < WS_END) { fprintf(stderr, "kernel_launch: unexpected sizes (n_in %d out %d ws %zu need %zu)\n", n_in, out_size, ws_size, (size_t)WS_END); grid = -1; return; }
        int dev = 0, cus = 0, per_cu = 0;
        if (hipGetDevice(&dev) != hipSuccess || hipDeviceGetAttribute(&cus, hipDeviceAttributeMultiprocessorCount, dev) != hipSuccess) { grid = -1; return; }
        if (hipFuncSetAttribute((const void*)mk_fwd, hipFuncAttributeMaxDynamicSharedMemorySize, LDS_BYTES) != hipSuccess) { fprintf(stderr, "hipFuncSetAttribute failed\n"); grid = -1; return; }
        if (hipOccupancyMaxActiveBlocksPerMultiprocessor(&per_cu, (const void*)mk_fwd, NWAVES * 64, LDS_BYTES) != hipSuccess || per_cu < 1) { fprintf(stderr, "occupancy query: %d\n", per_cu); }
        (void)hipGetLastError();
        if (cus != 256) { fprintf(stderr, "kernel_launch: built for a 256-CU device (one workgroup per CU; the unit deal and the row-rstd tables assume it), found %d CUs; nothing launched\n", cus); grid = -1; return; }
        grid = cus;
    }
    if (grid < 0) return;
    if (hipMemsetAsync((char*)d_ws + WS_CTL, 0, CTL_ZERO_BYTES, stream) != hipSuccess) return;
    Args a{};
    for (int i = 0; i < 23; ++i) a.in[i] = (const float*)d_in[i];
    a.out = (float*)d_out; a.ws = (unsigned char*)d_ws;
    int li = 0;
    auto run = [&](int lo, int hi) { a.ph_lo = lo; a.ph_hi = hi; a.li = li++; hipLaunchKernelGGL(mk_fwd, dim3(grid), dim3(NWAVES * 64), LDS_BYTES, stream, a); };

    run(PH_PRO, PH_END);
}
```

```cpp
#include <hip/hip_runtime.h>
#include <cstdio>
#include <cstdint>
#include <cmath>
#define DBG_STOP 0
namespace pg8 {
#define PG8_LAS __attribute__((address_space(3)))
typedef unsigned short bf16_t;
typedef short bf16x8 __attribute__((ext_vector_type(8)));
typedef float f32x4 __attribute__((ext_vector_type(4)));
typedef unsigned u32x4 __attribute__((ext_vector_type(4)));
constexpr int BM = 256, BK = 64, HALF = 128, HTB = HALF * BK * 2  , STAGE_BYTES = 8 * HTB, NXCD = 8, WGM = 8;

__host__ __device__ __forceinline__ int lds_byte(int r, int c) { const int st = (r >> 4) * 2 + (c >> 5), rr = r & 15, cc = c & 31, ob = rr * 64 + cc * 2; return st * 1024 + (ob ^ (((ob >> 9) & 1) << 5)); }
__host__ __device__ __forceinline__ void stage_rc(int b, int& R, int& C) { const int st = b / 1024, sb = b % 1024, swz = sb ^ (((sb >> 9) & 1) << 5); R = (st >> 1) * 16 + swz / 64; C = (st & 1) * 32 + (swz % 64) / 2; }
__host__ __device__ __forceinline__ int perm32(int rho) { const int n = rho >> 4, i = rho & 15; return 8 * (i >> 2) + 4 * n + (i & 3); }

struct Unit { int pm, pn; };
struct Gemm { const bf16_t* A; const bf16_t* Bt; int M, N, K; };

struct StaticOrder {
    int nM, nN, nwg, G, c;
    __host__ __device__ void init(int M, int N, int G_, int c_) { nM = M / BM; nN = N / BM; nwg = nM * nN; G = G_; c = c_; }
    __host__ __device__ bool next(int i, Unit& u) const {
        const long L = (long)i * G + c; if (L >= nwg) return false;
        int wgid = (int)L; { const int q = nwg / NXCD, r = nwg % NXCD, xcd = wgid % NXCD, off = wgid / NXCD; wgid = (xcd < r ? xcd * (q + 1) : r * (q + 1) + (xcd - r) * q) + off; }
        const int nig = WGM * nN, gid = wgid / nig, fm = gid * WGM, gsz = (nM - fm) < WGM ? (nM - fm) : WGM;
        u.pm = fm + ((wgid % nig) % gsz); u.pn = (wgid % nig) / gsz; return true;
    }
    __device__ __forceinline__ void a_ready(const Unit&) const {}
    __device__ __forceinline__ void done(const Unit&) const {}
};

__device__ __forceinline__ unsigned cvt_pk_bf16(float lo, float hi) { unsigned r; asm volatile("v_cvt_pk_bf16_f32 %0, %1, %2" : "=v"(r) : "v"(lo), "v"(hi)); return r; }
typedef float f32x2 __attribute__((ext_vector_type(2)));
__device__ __forceinline__ f32x2 gelu_pk(f32x2 v) {
    const f32x2 av = __builtin_elementwise_abs(v), d = av * 0.2316418882f + 1.0f;
    f32x2 t; t.x = __builtin_amdgcn_rcpf(d.x); t.y = __builtin_amdgcn_rcpf(d.y);
    f32x2 q = t * 0.5307027145f + (-0.7265760135f); q = q * t + 0.7107068705f; q = q * t + (-0.142248368f); q = q * t + 0.127414796f; q = q * t;
    const f32x2 s = (v * v) * (-0.72134752044f);
    f32x2 e; e.x = __builtin_amdgcn_exp2f(s.x); e.y = __builtin_amdgcn_exp2f(s.y);
    const f32x2 m = v * (q * e), r = v - m;
    f32x2 o; o.x = v.x < 0.f ? m.x : r.x; o.y = v.y < 0.f ? m.y : r.y; return o;
}

template <int ACT  > struct EpiBf16 {
    static constexpr bool PERM = true, AFTER_DRAIN = false; static_assert(ACT == 0 || ACT == 1, "EpiBf16: ACT is 0 (none) or 1 (gelu_pk)");
    bf16_t* O; int ldc; const float* bias; int split_cols; size_t split_stride; float scale0;
    __device__ __forceinline__ void operator()(const f32x4 (&acc)[2][2][4][2], const Unit& u, int wr, int wc, int fr, int fq) const {
        const int row0 = u.pm * BM + wr * 64 + fr; int colt = u.pn * BM; bf16_t* base = O;
        float sc = 1.f; if (split_cols) { const int t = colt / split_cols; base += (size_t)t * split_stride; colt -= t * split_cols; if (t == 0) sc = scale0; }
        const int col0 = colt + wc * 32 + 8 * fq, bcol0 = u.pn * BM + wc * 32 + 8 * fq;
        f32x4 bv[2][2];
#pragma unroll
        for (int bj = 0; bj < 2; ++bj)
#pragma unroll
            for (int n = 0; n < 2; ++n) bv[bj][n] = bias ? *(const f32x4*)(bias + bcol0 + bj * HALF + 4 * n) : (f32x4){0.f, 0.f, 0.f, 0.f};
#pragma unroll
        for (int ai = 0; ai < 2; ++ai)
#pragma unroll
            for (int m = 0; m < 4; ++m) { bf16_t* rowp = base + (size_t)(row0 + ai * HALF + m * 16) * ldc + col0;
#pragma unroll
                for (int bj = 0; bj < 2; ++bj) { f32x4 v0 = acc[ai][bj][m][0] + bv[bj][0], v1 = acc[ai][bj][m][1] + bv[bj][1];
                    if (ACT == 1) { f32x2 a = gelu_pk((f32x2){v0[0], v0[1]}), b = gelu_pk((f32x2){v0[2], v0[3]}), c = gelu_pk((f32x2){v1[0], v1[1]}), d = gelu_pk((f32x2){v1[2], v1[3]});
                        v0 = (f32x4){a.x, a.y, b.x, b.y}; v1 = (f32x4){c.x, c.y, d.x, d.y}; }
                    v0 = v0 * sc; v1 = v1 * sc; u32x4 w; w.x = cvt_pk_bf16(v0[0], v0[1]); w.y = cvt_pk_bf16(v0[2], v0[3]); w.z = cvt_pk_bf16(v1[0], v1[1]); w.w = cvt_pk_bf16(v1[2], v1[3]);
                    *(u32x4*)(rowp + bj * HALF) = w; } }
    }
};
typedef _Float16 pg8_h8 __attribute__((ext_vector_type(8)));
typedef int pg8_v8i __attribute__((ext_vector_type(8))); typedef int pg8_v4i __attribute__((ext_vector_type(4)));
__device__ __forceinline__ pg8_v8i pg8_ld8(const PG8_LAS unsigned char* p) { const pg8_v4i a = *(const PG8_LAS pg8_v4i*)p, c = *(const PG8_LAS pg8_v4i*)(p + 1024); return __builtin_shufflevector(a, c, 0, 1, 2, 3, 4, 5, 6, 7); }
template <class Epi, class Sched, bool ALIGN_EPI = false, bool SP2 = false, int DT = 0, bool MID = false>
__device__ __forceinline__ void gemm_phase(PG8_LAS unsigned char* lds, const Gemm g, const Sched& S, const Epi& E, int tid_in) {
    constexpr bool FP8 = (DT == 1);
    int tid_o = tid_in; asm volatile("" : "+v"(tid_o));
    const int tid = tid_o, wid = __builtin_amdgcn_readfirstlane(tid >> 6), lane = tid & 63, wr = wid >> 2, wc = wid & 3, fr = lane & 15, fq = lane >> 4;
    const int K = g.K, nt = K / BK;
    unsigned voffA[2], voffB[2];
#pragma unroll
    for (int i = 0; i < 2; ++i) { int R, C; stage_rc(tid * 16 + i * 8192, R, C); const int Rb = Epi::PERM ? ((R & ~31) + perm32(R & 31)) : R;
        voffA[i] = (unsigned)(R * K + C) * 2u; voffB[i] = (unsigned)(Rb * K + C) * 2u; }
    const size_t kstep = (size_t)(BK * 2);
    const size_t hstep = (size_t)HALF * K * 2;
    const size_t tstep = 2 * hstep;
    const unsigned ldsw = (unsigned)wid * 1024u;
    const int aoff = lds_byte(wr * 64 + fr, fq * 8), boff = lds_byte(wc * 32 + fr, fq * 8);
#define PG8_SA(b, h) (((b) * 2 + (h)) * HTB)
#define PG8_SB(b, h) ((4 + (b) * 2 + (h)) * HTB)
#define PG8_STAGE(bufoff, gbase, voff) do { _Pragma("unroll") for (int _i = 0; _i < 2; ++_i) \
        __builtin_amdgcn_global_load_lds((const unsigned*)((const char*)(gbase) + (voff)[_i]), (PG8_LAS unsigned*)(lds + (bufoff) + ldsw + _i * 8192), 16, 0, 0); } while (0)
#define PG8_LDA(dst, b, h) do { if constexpr (FP8) { _Pragma("unroll") for (int m = 0; m < 4; ++m) dst##8[m] = pg8_ld8(lds + PG8_SA(b, h) + aoff + m * 2048); } \
        else { _Pragma("unroll") for (int m = 0; m < 4; ++m) _Pragma("unroll") for (int k = 0; k < 2; ++k) dst[m][k] = *(const PG8_LAS bf16x8*)(lds + PG8_SA(b, h) + aoff + m * 2048 + k * 1024); } } while (0)
#define PG8_LDB(dst, b, h) do { if constexpr (FP8) { _Pragma("unroll") for (int n = 0; n < 2; ++n) dst##8[n] = pg8_ld8(lds + PG8_SB(b, h) + boff + n * 2048); } \
        else { _Pragma("unroll") for (int n = 0; n < 2; ++n) _Pragma("unroll") for (int k = 0; k < 2; ++k) dst[n][k] = *(const PG8_LAS bf16x8*)(lds + PG8_SB(b, h) + boff + n * 2048 + k * 1024); } } while (0)
#define PG8_MMA(ai, bj, At, Bt) do { __builtin_amdgcn_s_setprio(1); _Pragma("unroll") for (int m = 0; m < 4; ++m) _Pragma("unroll") for (int n = 0; n < 2; ++n) { \
        if constexpr (FP8) asm volatile("v_mfma_scale_f32_16x16x128_f8f6f4 %0, %1, %2, %0, %3, %3 op_sel_hi:[0,0,0]" : "+v"(acc[ai][bj][m][n]) : "v"(Bt##8[n]), "v"(At##8[m]), "v"(sc7f));     \
        else { _Pragma("unroll") for (int k = 0; k < 2; ++k) { if constexpr (DT == 2) acc[ai][bj][m][n] = __builtin_amdgcn_mfma_f32_16x16x32_f16(__builtin_bit_cast(pg8_h8, Bt[n][k]), __builtin_bit_cast(pg8_h8, At[m][k]), acc[ai][bj][m][n], 0, 0, 0); \
            else acc[ai][bj][m][n] = __builtin_amdgcn_mfma_f32_16x16x32_bf16(Bt[n][k], At[m][k], acc[ai][bj][m][n], 0, 0, 0); } } } __builtin_amdgcn_s_setprio(0); } while (0)
#define PG8_WAIT_V(n) asm volatile("s_waitcnt vmcnt(" #n ")" ::: "memory")
#define PG8_WAIT_L(n) asm volatile("s_waitcnt lgkmcnt(" #n ")" ::: "memory")
#define PG8_BAR __builtin_amdgcn_s_barrier()
#define PG8_SCHED __builtin_amdgcn_sched_barrier(0)
    Unit cur, nxt; int ui = 0;
    if (!S.next(0, cur)) return;
    f32x4 acc[2][2][4][2];
#pragma unroll
    for (int a = 0; a < 2; ++a)
#pragma unroll
        for (int b = 0; b < 2; ++b)
#pragma unroll
            for (int m = 0; m < 4; ++m)
#pragma unroll
                for (int n = 0; n < 2; ++n) acc[a][b][m][n] = (f32x4){0.f, 0.f, 0.f, 0.f};
    bf16x8 At[4][2], B0[2][2], B1[2][2];
    int sc7f = 0x7F7F7F7F; asm volatile("" : "+v"(sc7f));
    pg8_v8i At8[4], B08[2], B18[2];
    const char* cA = (const char*)g.A + (size_t)cur.pm * tstep; const char* cB = (const char*)g.Bt + (size_t)cur.pn * tstep;
    S.a_ready(cur);
    if constexpr (SP2) {
        PG8_STAGE(PG8_SB(0, 0), cB, voffB); PG8_STAGE(PG8_SB(0, 1), cB + hstep, voffB); PG8_STAGE(PG8_SA(0, 0), cA, voffA); PG8_STAGE(PG8_SA(0, 1), cA + hstep, voffA);
        if (wr == 1) PG8_BAR;
        PG8_WAIT_V(2); PG8_BAR;
        PG8_STAGE(PG8_SB(1, 0), cB + kstep, voffB); PG8_STAGE(PG8_SA(1, 0), cA + kstep, voffA); PG8_STAGE(PG8_SB(1, 1), cB + hstep + kstep, voffB);
        PG8_WAIT_V(6); PG8_BAR;
    } else {
        PG8_STAGE(PG8_SB(0, 0), cB, voffB); PG8_STAGE(PG8_SA(0, 0), cA, voffA); PG8_STAGE(PG8_SB(0, 1), cB + hstep, voffB); PG8_STAGE(PG8_SA(0, 1), cA + hstep, voffA);
        if (wr == 1) PG8_BAR;
        PG8_WAIT_V(4); PG8_BAR;
        PG8_STAGE(PG8_SB(1, 0), cB + kstep, voffB); PG8_STAGE(PG8_SA(1, 0), cA + kstep, voffA); PG8_STAGE(PG8_SB(1, 1), cB + hstep + kstep, voffB);
        PG8_WAIT_V(6); PG8_BAR;
    }
    for (;;) {
        const bool has_next = S.next(ui + 1, nxt);
        const char* nA = has_next ? (const char*)g.A + (size_t)nxt.pm * tstep : cA; const char* nB = has_next ? (const char*)g.Bt + (size_t)nxt.pn * tstep : cB;
        for (int t = 0; t < nt; t += 2) {
            if constexpr (MID) { if (t == (nt >> 1)) E.mid(acc, cur, wr, wc); }
            const bool last = (t == nt - 2);
            const char* a1 = cA + (size_t)(t + 1) * kstep;
            const char* a2 = last ? nA : cA + (size_t)(t + 2) * kstep; const char* b2 = last ? nB : cB + (size_t)(t + 2) * kstep;
            const char* a3 = a2 + kstep; const char* b3 = b2 + kstep;
            if (last && has_next) S.a_ready(nxt);
            if constexpr (SP2) {
            PG8_LDB(B0, 0, 0); PG8_LDB(B1, 0, 1); PG8_SCHED; PG8_LDA(At, 0, 0); PG8_STAGE(PG8_SA(1, 1), a1 + hstep, voffA);
            PG8_WAIT_V(8); PG8_WAIT_L(0); PG8_BAR; PG8_MMA(0, 0, At, B0); PG8_MMA(0, 1, At, B1); PG8_BAR; PG8_SCHED;
            PG8_LDA(At, 0, 1); PG8_STAGE(PG8_SB(0, 0), b2, voffB); PG8_STAGE(PG8_SB(0, 1), b2 + hstep, voffB); PG8_STAGE(PG8_SA(0, 0), a2, voffA);
            PG8_WAIT_V(8); PG8_WAIT_L(0); PG8_BAR; PG8_MMA(1, 0, At, B0); PG8_MMA(1, 1, At, B1); PG8_BAR; PG8_SCHED;
            PG8_LDB(B0, 1, 0); PG8_LDB(B1, 1, 1); PG8_SCHED; PG8_LDA(At, 1, 0); PG8_STAGE(PG8_SA(0, 1), a2 + hstep, voffA);
            PG8_WAIT_V(8); PG8_WAIT_L(0); PG8_BAR; PG8_MMA(0, 0, At, B0); PG8_MMA(0, 1, At, B1); PG8_BAR; PG8_SCHED;
            PG8_LDA(At, 1, 1); PG8_STAGE(PG8_SB(1, 0), b3, voffB); PG8_STAGE(PG8_SB(1, 1), b3 + hstep, voffB); PG8_STAGE(PG8_SA(1, 0), a3, voffA);
            PG8_WAIT_V(8); PG8_WAIT_L(0); PG8_BAR; PG8_MMA(1, 0, At, B0); PG8_MMA(1, 1, At, B1); PG8_BAR; PG8_SCHED;
            } else {
            PG8_LDB(B0, 0, 0); PG8_SCHED; PG8_LDA(At, 0, 0); PG8_STAGE(PG8_SA(1, 1), a1 + hstep, voffA);
            PG8_WAIT_L(8); PG8_BAR; PG8_WAIT_L(0); PG8_MMA(0, 0, At, B0); PG8_BAR; PG8_SCHED;
            PG8_LDB(B1, 0, 1); PG8_STAGE(PG8_SB(0, 0), b2, voffB);
            PG8_BAR; PG8_WAIT_L(0); PG8_MMA(0, 1, At, B1); PG8_BAR;
            PG8_LDA(At, 0, 1); PG8_STAGE(PG8_SA(0, 0), a2, voffA);
            PG8_BAR; PG8_WAIT_L(0); PG8_MMA(1, 0, At, B0); PG8_BAR; PG8_SCHED;
            PG8_STAGE(PG8_SB(0, 1), b2 + hstep, voffB);
            PG8_WAIT_V(6); PG8_BAR; PG8_MMA(1, 1, At, B1); PG8_BAR;
            PG8_LDB(B0, 1, 0); PG8_SCHED; PG8_LDA(At, 1, 0); PG8_STAGE(PG8_SA(0, 1), a2 + hstep, voffA);
            PG8_WAIT_L(8); PG8_BAR; PG8_WAIT_L(0); PG8_MMA(0, 0, At, B0); PG8_BAR; PG8_SCHED;
            PG8_LDB(B1, 1, 1); PG8_STAGE(PG8_SB(1, 0), b3, voffB);
            PG8_BAR; PG8_WAIT_L(0); PG8_MMA(0, 1, At, B1); PG8_BAR;
            PG8_LDA(At, 1, 1); PG8_STAGE(PG8_SA(1, 0), a3, voffA);
            PG8_BAR; PG8_WAIT_L(0); PG8_MMA(1, 0, At, B0); PG8_BAR; PG8_SCHED;
            PG8_STAGE(PG8_SB(1, 1), b3 + hstep, voffB);
            PG8_WAIT_V(6); PG8_BAR; PG8_MMA(1, 1, At, B1); PG8_BAR;
            }
        }
        if constexpr (FP8) asm volatile("s_nop 15\n\ts_nop 15" ::: "memory");
        if constexpr (ALIGN_EPI) { if (wr == 0) PG8_BAR; }
        if constexpr (!Epi::AFTER_DRAIN) { E(acc, cur, wr, wc, fr, fq); S.done(cur); }
        if (!has_next) break;
#pragma unroll
        for (int a = 0; a < 2; ++a)
#pragma unroll
            for (int b = 0; b < 2; ++b)
#pragma unroll
                for (int m = 0; m < 4; ++m)
#pragma unroll
                    for (int n = 0; n < 2; ++n) acc[a][b][m][n] = (f32x4){0.f, 0.f, 0.f, 0.f};
        cur = nxt; cA = nA; cB = nB; ++ui;
        if constexpr (ALIGN_EPI) { if (wr == 1) PG8_BAR; }
    }
    PG8_WAIT_V(0);
    if constexpr (!ALIGN_EPI) { if (wr == 0) PG8_BAR; }
    PG8_BAR;
    if constexpr (Epi::AFTER_DRAIN) { E.fused(acc, cur, wr, wc, fr, fq, lds, wid, lane); S.done(cur); }
#undef PG8_SA
#undef PG8_SB
#undef PG8_STAGE
#undef PG8_LDA
#undef PG8_LDB
#undef PG8_MMA
#undef PG8_WAIT_V
#undef PG8_WAIT_L
#undef PG8_BAR
#undef PG8_SCHED
}
}
namespace pg8 {
typedef unsigned u32x2 __attribute__((ext_vector_type(2)));
typedef float f32x2_t __attribute__((ext_vector_type(2))); typedef __bf16 bf16x2_t __attribute__((ext_vector_type(2)));
__device__ __forceinline__ unsigned cvtpk(float lo, float hi) { f32x2_t v = {lo, hi}; bf16x2_t b = __builtin_convertvector(v, bf16x2_t); return __builtin_bit_cast(unsigned, b); }
__device__ __forceinline__ float bf_lo(unsigned u) { return __uint_as_float(u << 16); }
__device__ __forceinline__ float bf_hi(unsigned u) { return __uint_as_float(u & 0xffff0000u); }
__device__ __forceinline__ float sigm(float x) { return __builtin_amdgcn_rcpf(1.f + __expf(-x)); }
__device__ __forceinline__ float silu(float x) { return x * sigm(x); }
typedef float f32x2v __attribute__((ext_vector_type(2)));
__device__ __forceinline__ f32x4 swiglu4(f32x4 a, f32x4 b, float k1, float k3) {
    const f32x2v a0 = {a[0], a[1]}, a1 = {a[2], a[3]}, b0 = {b[0], b[1]}, b1 = {b[2], b[3]};
    const f32x2v t0 = a0 * k1, t1 = a1 * k1;
    const f32x2v e0 = {__builtin_amdgcn_exp2f(t0[0]), __builtin_amdgcn_exp2f(t0[1])}, e1 = {__builtin_amdgcn_exp2f(t1[0]), __builtin_amdgcn_exp2f(t1[1])};
    const f32x2v d0 = e0 * k3 + k3, d1 = e1 * k3 + k3;
    const f32x2v r0 = {__builtin_amdgcn_rcpf(d0[0]), __builtin_amdgcn_rcpf(d0[1])}, r1 = {__builtin_amdgcn_rcpf(d1[0]), __builtin_amdgcn_rcpf(d1[1])};
    const f32x2v y0 = (a0 * b0) * r0, y1 = (a1 * b1) * r1;
    return (f32x4){y0[0], y0[1], y1[0], y1[1]};
}

template <int ADD> struct EpiGate {
    static constexpr bool PERM = true, AFTER_DRAIN = false;
    bf16_t* O; int ldc; const bf16_t* G; int ldg;
    __device__ __forceinline__ void operator()(const f32x4 (&acc)[2][2][4][2], const Unit& u, int wr, int wc, int fr, int fq) const {
        { int z_ = 0; asm volatile("" : "+v"(z_)); const int l_ = (int)__builtin_amdgcn_mbcnt_hi(~0u, __builtin_amdgcn_mbcnt_lo(~0u, (unsigned)z_)); fr = l_ & 15; fq = l_ >> 4; }
        const int row0 = u.pm * BM + wr * 64 + fr, col0 = u.pn * BM + wc * 32 + 8 * fq;
        u32x4 g[2][2][2], p[2][2][2];
#define EG_LOAD(bt, buf) _Pragma("unroll") for (int mm = 0; mm < 2; ++mm) _Pragma("unroll") for (int bj = 0; bj < 2; ++bj) { const size_t r = (size_t)(row0 + ((bt) >> 1) * HALF + (2 * ((bt) & 1) + mm) * 16); const int c = col0 + bj * HALF; \
            g[buf][mm][bj] = *(const u32x4*)(G + r * ldg + c); if (ADD) p[buf][mm][bj] = *(const u32x4*)(O + r * ldc + c); }
        EG_LOAD(0, 0);
#pragma unroll
        for (int bt = 0; bt < 4; ++bt) { const int buf = bt & 1, ai = bt >> 1, mp = bt & 1;
            if (bt == 0) { EG_LOAD(1, 1); } else if (bt == 1) { EG_LOAD(2, 0); } else if (bt == 2) { EG_LOAD(3, 1); }
#pragma unroll
            for (int mm = 0; mm < 2; ++mm)
#pragma unroll
                for (int bj = 0; bj < 2; ++bj) { const int m = 2 * mp + mm; const size_t r = (size_t)(row0 + ai * HALF + m * 16); const int c = col0 + bj * HALF;
                    const u32x4 gg = g[buf][mm][bj]; f32x4 v0 = acc[ai][bj][m][0], v1 = acc[ai][bj][m][1];
                    v0[0] *= sigm(bf_lo(gg.x)); v0[1] *= sigm(bf_hi(gg.x)); v0[2] *= sigm(bf_lo(gg.y)); v0[3] *= sigm(bf_hi(gg.y));
                    v1[0] *= sigm(bf_lo(gg.z)); v1[1] *= sigm(bf_hi(gg.z)); v1[2] *= sigm(bf_lo(gg.w)); v1[3] *= sigm(bf_hi(gg.w));
                    if (ADD) { const u32x4 pp = p[buf][mm][bj]; v0[0] += bf_lo(pp.x); v0[1] += bf_hi(pp.x); v0[2] += bf_lo(pp.y); v0[3] += bf_hi(pp.y);
                                                      v1[0] += bf_lo(pp.z); v1[1] += bf_hi(pp.z); v1[2] += bf_lo(pp.w); v1[3] += bf_hi(pp.w); }
                    u32x4 w; w.x = cvtpk(v0[0], v0[1]); w.y = cvtpk(v0[2], v0[3]); w.z = cvtpk(v1[0], v1[1]); w.w = cvtpk(v1[2], v1[3]);
                    *(u32x4*)(O + r * ldc + c) = w; }
        }
#undef EG_LOAD
    }
};
struct EpiRes {
    static constexpr bool PERM = false, AFTER_DRAIN = false;
    const float* base; float* out; int ldc;
    __device__ __forceinline__ void operator()(const f32x4 (&acc)[2][2][4][2], const Unit& u, int wr, int wc, int fr, int fq) const {
        const int row0 = u.pm * BM + wr * 64 + fr, col0 = u.pn * BM + wc * 32 + 4 * fq;
#pragma unroll
        for (int ai = 0; ai < 2; ++ai)
#pragma unroll
            for (int m = 0; m < 4; ++m) { const size_t off = (size_t)(row0 + ai * HALF + m * 16) * ldc + col0;
#pragma unroll
                for (int bj = 0; bj < 2; ++bj)
#pragma unroll
                    for (int n = 0; n < 2; ++n) { const f32x4 b = *(const f32x4*)(base + off + bj * HALF + n * 16); *(f32x4*)(out + off + bj * HALF + n * 16) = b + acc[ai][bj][m][n]; } }
    }
};
struct EpiSwiglu {
    static constexpr bool PERM = false, AFTER_DRAIN = false;
    bf16_t* O; int ldc; int nmod;
    __device__ __forceinline__ void operator()(const f32x4 (&acc)[2][2][4][2], const Unit& u, int wr, int wc, int fr, int fq) const {
        const int row0 = u.pm * BM + wr * 64 + fr, hc0 = (u.pn % nmod) * 128 + wc * 16 + 4 * fq;
#pragma unroll
        for (int ai = 0; ai < 2; ++ai)
#pragma unroll
            for (int m = 0; m < 4; ++m) { bf16_t* rowp = O + (size_t)(row0 + ai * HALF + m * 16) * ldc + hc0;
#pragma unroll
                for (int bj = 0; bj < 2; ++bj) { const f32x4 a = acc[ai][bj][m][0], b = acc[ai][bj][m][1];
                    u32x2 w; w.x = cvtpk(silu(a[0]) * b[0], silu(a[1]) * b[1]); w.y = cvtpk(silu(a[2]) * b[2], silu(a[3]) * b[3]);
                    *(u32x2*)(rowp + bj * 64) = w; } }
    }
};
struct EpiSigT {
    static constexpr bool PERM = false, AFTER_DRAIN = false;
    bf16_t* T; int ldc;
    __device__ __forceinline__ void operator()(const f32x4 (&acc)[2][2][4][2], const Unit& u, int wr, int wc, int fr, int fq) const {
        const int row0 = u.pm * BM + wr * 64 + fr, col0 = u.pn * BM + wc * 32 + 4 * fq;
#pragma unroll
        for (int ai = 0; ai < 2; ++ai)
#pragma unroll
            for (int m = 0; m < 4; ++m) { bf16_t* rowp = T + (size_t)(row0 + ai * HALF + m * 16) * ldc + col0;
#pragma unroll
                for (int bj = 0; bj < 2; ++bj)
#pragma unroll
                    for (int n = 0; n < 2; ++n) { const f32x4 a = acc[ai][bj][m][n]; u32x2 w; w.x = cvtpk(sigm(a[0]), sigm(a[1])); w.y = cvtpk(sigm(a[2]), sigm(a[3]));
                        *(u32x2*)(rowp + bj * HALF + n * 16) = w; } }
    }
};
struct EpiPle {
    static constexpr bool PERM = false, AFTER_DRAIN = false;
    const float* base; float* out; const bf16_t* T; int ldc;
    __device__ __forceinline__ void operator()(const f32x4 (&acc)[2][2][4][2], const Unit& u, int wr, int wc, int fr, int fq) const {
        const int row0 = u.pm * BM + wr * 64 + fr, col0 = u.pn * BM + wc * 32 + 4 * fq;
#pragma unroll
        for (int ai = 0; ai < 2; ++ai)
#pragma unroll
            for (int m = 0; m < 4; ++m) { const size_t off = (size_t)(row0 + ai * HALF + m * 16) * ldc + col0;
#pragma unroll
                for (int bj = 0; bj < 2; ++bj)
#pragma unroll
                    for (int n = 0; n < 2; ++n) { const size_t o = off + bj * HALF + n * 16; const u32x2 t = *(const u32x2*)(T + o); const f32x4 b = *(const f32x4*)(base + o); const f32x4 a = acc[ai][bj][m][n];
                        f32x4 r; r[0] = b[0] + bf_lo(t.x) * a[0]; r[1] = b[1] + bf_hi(t.x) * a[1]; r[2] = b[2] + bf_lo(t.y) * a[2]; r[3] = b[3] + bf_hi(t.y) * a[3];
                        *(f32x4*)(out + o) = r; } }
    }
};
struct EpiMoeDown {
    static constexpr bool PERM = true, AFTER_DRAIN = false;
    bf16_t* Y; int ldc; const float* gw; int nmod; float sc;
    __device__ __forceinline__ void operator()(const f32x4 (&acc)[2][2][4][2], const Unit& u, int wr, int wc, int fr, int fq) const {
        const int row0 = u.pm * BM + wr * 64 + fr, col0 = (u.pn % nmod) * BM + wc * 32 + 8 * fq;
#pragma unroll
        for (int ai = 0; ai < 2; ++ai)
#pragma unroll
            for (int m = 0; m < 4; ++m) { const size_t r = (size_t)(row0 + ai * HALF + m * 16); const float s = gw[r] * sc; bf16_t* rowp = Y + r * ldc + col0;
#pragma unroll
                for (int bj = 0; bj < 2; ++bj) { const f32x4 v0 = acc[ai][bj][m][0] * s, v1 = acc[ai][bj][m][1] * s;
                    u32x4 w; w.x = cvtpk(v0[0], v0[1]); w.y = cvtpk(v0[2], v0[3]); w.z = cvtpk(v1[0], v1[1]); w.w = cvtpk(v1[2], v1[3]);
                    *(u32x4*)(rowp + bj * HALF) = w; } }
    }
};

__device__ __forceinline__ float row_rstd(const float* ssp, size_t row) {
    const f32x4* p = (const f32x4*)(ssp + row * 16); const f32x4 a = p[0], b = p[1], c = p[2], d = p[3];
    const float s = (((a[0] + a[1]) + (a[2] + a[3])) + ((b[0] + b[1]) + (b[2] + b[3]))) + (((c[0] + c[1]) + (c[2] + c[3])) + ((d[0] + d[1]) + (d[2] + d[3])));
    return rsqrtf(s * (1.f / 1024.f) + 1e-6f);
}
__device__ __forceinline__ float xor_add(float v, int lane, int o) { return v + __builtin_bit_cast(float, __builtin_amdgcn_ds_bpermute((lane ^ o) << 2, __builtin_bit_cast(int, v))); }
struct EpiZn {
    static constexpr bool PERM = true, AFTER_DRAIN = false;
    bf16_t* O; int ldc; const float* ssp; const PG8_LAS float* tbl; int tpm;
    __device__ __forceinline__ void operator()(const f32x4 (&acc)[2][2][4][2], const Unit& u, int wr, int wc, int fr, int fq) const {
        const int row0 = u.pm * BM + wr * 64 + fr, col0 = u.pn * BM + wc * 32 + 8 * fq;
#pragma unroll
        for (int ai = 0; ai < 2; ++ai)
#pragma unroll
            for (int m = 0; m < 4; ++m) { const size_t r = (size_t)(row0 + ai * HALF + m * 16); const float s = tbl[wr * 64 + fr + ai * HALF + m * 16];     bf16_t* rowp = O + r * ldc + col0;
#pragma unroll
                for (int bj = 0; bj < 2; ++bj) { const f32x4 v0 = acc[ai][bj][m][0] * s, v1 = acc[ai][bj][m][1] * s;
                    u32x4 w; w.x = cvtpk(v0[0], v0[1]); w.y = cvtpk(v0[2], v0[3]); w.z = cvtpk(v1[0], v1[1]); w.w = cvtpk(v1[2], v1[3]);
                    *(u32x4*)(rowp + bj * HALF) = w; } }
    }
};
struct EpiSwigluN {
    static constexpr bool PERM = false, AFTER_DRAIN = false;
    bf16_t* O; int ldc; const float* ssp; const PG8_LAS float* tbl; int tpm;
    __device__ __forceinline__ void operator()(const f32x4 (&acc)[2][2][4][2], const Unit& u, int wr, int wc, int fr, int fq) const {
        const int row0 = u.pm * BM + wr * 64 + fr, hc0 = u.pn * 128 + wc * 16 + 4 * fq;
#pragma unroll
        for (int ai = 0; ai < 2; ++ai)
#pragma unroll
            for (int m = 0; m < 4; ++m) { const size_t r = (size_t)(row0 + ai * HALF + m * 16); const float s = tbl[wr * 64 + fr + ai * HALF + m * 16];     bf16_t* rowp = O + r * ldc + hc0; const float k1 = s * -1.44269504f, k3 = __builtin_amdgcn_rcpf(s * s);
#pragma unroll
                for (int bj = 0; bj < 2; ++bj) { const f32x4 y = swiglu4(acc[ai][bj][m][0], acc[ai][bj][m][1], k1, k3);
                    u32x2 w; w.x = cvtpk(y[0], y[1]); w.y = cvtpk(y[2], y[3]);
                    *(u32x2*)(rowp + bj * 64) = w; } }
    }
};
struct EpiSigTN {
    static constexpr bool PERM = false, AFTER_DRAIN = false;
    bf16_t* T; int ldc; const float* ssp; const PG8_LAS float* tbl; int tpm;
    __device__ __forceinline__ void operator()(const f32x4 (&acc)[2][2][4][2], const Unit& u, int wr, int wc, int fr, int fq) const {
        const int row0 = u.pm * BM + wr * 64 + fr, col0 = u.pn * BM + wc * 32 + 4 * fq;
#pragma unroll
        for (int ai = 0; ai < 2; ++ai)
#pragma unroll
            for (int m = 0; m < 4; ++m) { const size_t r = (size_t)(row0 + ai * HALF + m * 16); const float s = tbl[wr * 64 + fr + ai * HALF + m * 16];     bf16_t* rowp = T + r * ldc + col0;
#pragma unroll
                for (int bj = 0; bj < 2; ++bj)
#pragma unroll
                    for (int n = 0; n < 2; ++n) { const f32x4 a = acc[ai][bj][m][n] * s; u32x2 w; w.x = cvtpk(sigm(a[0]), sigm(a[1])); w.y = cvtpk(sigm(a[2]), sigm(a[3]));
                        *(u32x2*)(rowp + bj * HALF + n * 16) = w; } }
    }
};
struct EpiResSS {
    static constexpr bool PERM = false, AFTER_DRAIN = false;
    const float* base; float* out; bf16_t* hb; float* ssp; int ldc;
    __device__ __forceinline__ void operator()(const f32x4 (&acc)[2][2][4][2], const Unit& u, int wr, int wc, int fr, int fq) const {
        { int z_ = 0; asm volatile("" : "+v"(z_)); const int l_ = (int)__builtin_amdgcn_mbcnt_hi(~0u, __builtin_amdgcn_mbcnt_lo(~0u, (unsigned)z_)); fr = l_ & 15; fq = l_ >> 4; }
        const int row0 = u.pm * BM + wr * 64 + fr, col0 = u.pn * BM + wc * 32 + 4 * fq, lane = fq * 16 + fr;
#pragma unroll
        for (int ai = 0; ai < 2; ++ai)
#pragma unroll
            for (int mp = 0; mp < 2; ++mp) {
                f32x4 bsv[2][2][2];
#pragma unroll
                for (int mm = 0; mm < 2; ++mm)
#pragma unroll
                    for (int bj = 0; bj < 2; ++bj)
#pragma unroll
                        for (int n = 0; n < 2; ++n) bsv[mm][bj][n] = *(const f32x4*)(base + (size_t)(row0 + ai * HALF + (2 * mp + mm) * 16) * ldc + col0 + bj * HALF + n * 16);
#pragma unroll
                for (int mm = 0; mm < 2; ++mm) { const int m = 2 * mp + mm; const size_t r = (size_t)(row0 + ai * HALF + m * 16), off = r * ldc + col0; float ss = 0.f;
#pragma unroll
                    for (int bj = 0; bj < 2; ++bj)
#pragma unroll
                        for (int n = 0; n < 2; ++n) { const size_t o = off + bj * HALF + n * 16; const f32x4 v = bsv[mm][bj][n] + acc[ai][bj][m][n]; *(f32x4*)(out + o) = v;
                            u32x2 w; w.x = cvtpk(v[0], v[1]); w.y = cvtpk(v[2], v[3]); *(u32x2*)(hb + o) = w; ss += (v[0] * v[0] + v[1] * v[1]) + (v[2] * v[2] + v[3] * v[3]); }
                    ss = xor_add(ss, lane, 16); ss = xor_add(ss, lane, 32);
                    if (fq == 0) ssp[r * 16 + (u.pn & 3) * 4 + wc] = ss; }
                asm volatile("" ::: "memory");
            }
    }
};
struct EpiPleSS {
    static constexpr bool PERM = false, AFTER_DRAIN = false;
    const float* base; float* out; const bf16_t* T; bf16_t* hb; float* ssp; int ldc;
    __device__ __forceinline__ void operator()(const f32x4 (&acc)[2][2][4][2], const Unit& u, int wr, int wc, int fr, int fq) const {
        { int z_ = 0; asm volatile("" : "+v"(z_)); const int l_ = (int)__builtin_amdgcn_mbcnt_hi(~0u, __builtin_amdgcn_mbcnt_lo(~0u, (unsigned)z_)); fr = l_ & 15; fq = l_ >> 4; }
        const int row0 = u.pm * BM + wr * 64 + fr, col0 = u.pn * BM + wc * 32 + 4 * fq, lane = fq * 16 + fr;
#pragma unroll
        for (int ai = 0; ai < 2; ++ai)
#pragma unroll
            for (int mp = 0; mp < 2; ++mp) {
                f32x4 bsv[2][2][2]; u32x2 tv[2][2][2];
#pragma unroll
                for (int mm = 0; mm < 2; ++mm)
#pragma unroll
                    for (int bj = 0; bj < 2; ++bj)
#pragma unroll
                        for (int n = 0; n < 2; ++n) { const size_t o = (size_t)(row0 + ai * HALF + (2 * mp + mm) * 16) * ldc + col0 + bj * HALF + n * 16; bsv[mm][bj][n] = *(const f32x4*)(base + o); tv[mm][bj][n] = *(const u32x2*)(T + o); }
#pragma unroll
                for (int mm = 0; mm < 2; ++mm) { const int m = 2 * mp + mm; const size_t r = (size_t)(row0 + ai * HALF + m * 16), off = r * ldc + col0; float ss = 0.f;
#pragma unroll
                    for (int bj = 0; bj < 2; ++bj)
#pragma unroll
                        for (int n = 0; n < 2; ++n) { const size_t o = off + bj * HALF + n * 16; const u32x2 t = tv[mm][bj][n]; const f32x4 b = bsv[mm][bj][n]; const f32x4 a = acc[ai][bj][m][n];
                            f32x4 v; v[0] = b[0] + bf_lo(t.x) * a[0]; v[1] = b[1] + bf_hi(t.x) * a[1]; v[2] = b[2] + bf_lo(t.y) * a[2]; v[3] = b[3] + bf_hi(t.y) * a[3];
                            *(f32x4*)(out + o) = v; u32x2 w; w.x = cvtpk(v[0], v[1]); w.y = cvtpk(v[2], v[3]); *(u32x2*)(hb + o) = w; ss += (v[0] * v[0] + v[1] * v[1]) + (v[2] * v[2] + v[3] * v[3]); }
                    ss = xor_add(ss, lane, 16); ss = xor_add(ss, lane, 32);
                    if (fq == 0) ssp[r * 16 + (u.pn & 3) * 4 + wc] = ss; }
                asm volatile("" ::: "memory");
            }
    }
};

__device__ __forceinline__ unsigned pk4_fp8(float a, float b, float c, float d) { int w = 0; w = __builtin_amdgcn_cvt_pk_fp8_f32(a, b, w, false); w = __builtin_amdgcn_cvt_pk_fp8_f32(c, d, w, true); return (unsigned)w; }
__device__ __forceinline__ u32x4 xpose4(unsigned d0, unsigned d1, unsigned d2, unsigned d3) {
    const auto s01 = __builtin_amdgcn_permlane16_swap(d0, d1, false, false), s23 = __builtin_amdgcn_permlane16_swap(d2, d3, false, false);
    const auto t02 = __builtin_amdgcn_permlane32_swap(s01[0], s23[0], false, false), t13 = __builtin_amdgcn_permlane32_swap(s01[1], s23[1], false, false);
    u32x4 q; q.x = t02[0]; q.y = t13[0]; q.z = t02[1]; q.w = t13[1]; return q;
}
struct EpiSwiglu8 {
    static constexpr bool PERM = false, AFTER_DRAIN = false;
    unsigned char* O; int ldc; int nmod; float sc;
    __device__ __forceinline__ void operator()(const f32x4 (&acc)[2][2][4][2], const Unit& u, int wr, int wc, int fr, int fq) const {
        const int row0 = u.pm * BM + wr * 64 + fr, hc0 = (u.pn % nmod) * 128 + wc * 16;
        const float k1 = sc * -1.44269504f, k3 = 1.f / (4.f * sc * sc);
#pragma unroll
        for (int ai = 0; ai < 2; ++ai)
#pragma unroll
            for (int bj = 0; bj < 2; ++bj) { unsigned d[4];
#pragma unroll
                for (int m = 0; m < 4; ++m) { const f32x4 y = swiglu4(acc[ai][bj][m][0], acc[ai][bj][m][1], k1, k3);
                    d[m] = pk4_fp8(y[0], y[1], y[2], y[3]); }
                const u32x4 q = xpose4(d[0], d[1], d[2], d[3]);
                *(u32x4*)(O + (size_t)(row0 + ai * HALF + 16 * fq) * ldc + hc0 + bj * 64) = q; }
    }
};

struct EpiPleFused {
    static constexpr bool PERM = false, AFTER_DRAIN = false;
    const float* base; float* out; const bf16_t* PP; bf16_t* hb; float* ssp; int ldc; const PG8_LAS float* tbl;
    __device__ __forceinline__ void operator()(const f32x4 (&acc)[2][2][4][2], const Unit& u, int wr, int wc, int fr, int fq) const {
        { int z_ = 0; asm volatile("" : "+v"(z_)); const int l_ = (int)__builtin_amdgcn_mbcnt_hi(~0u, __builtin_amdgcn_mbcnt_lo(~0u, (unsigned)z_)); fr = l_ & 15; fq = l_ >> 4; }
        const int row0 = u.pm * BM + wr * 64 + fr, col0 = u.pn * BM + wc * 32 + 4 * fq, lane = fq * 16 + fr;
#pragma unroll
        for (int ai = 0; ai < 2; ++ai)
#pragma unroll
            for (int mp = 0; mp < 2; ++mp) {
                f32x4 bsv[2][2][2]; u32x2 tv[2][2][2];
#pragma unroll
                for (int mm = 0; mm < 2; ++mm)
#pragma unroll
                    for (int bj = 0; bj < 2; ++bj)
#pragma unroll
                        for (int n = 0; n < 2; ++n) { const size_t o = (size_t)(row0 + ai * HALF + (2 * mp + mm) * 16) * ldc + col0 + bj * HALF + n * 16; bsv[mm][bj][n] = *(const f32x4*)(base + o); tv[mm][bj][n] = *(const u32x2*)(PP + o); }
#pragma unroll
                for (int mm = 0; mm < 2; ++mm) { const int m = 2 * mp + mm; const size_t r = (size_t)(row0 + ai * HALF + m * 16), off = r * ldc + col0; float ss = 0.f;
                    const float rs = tbl[wr * 64 + fr + ai * HALF + m * 16];
#pragma unroll
                    for (int bj = 0; bj < 2; ++bj)
#pragma unroll
                        for (int n = 0; n < 2; ++n) { const size_t o = off + bj * HALF + n * 16; const u32x2 t = tv[mm][bj][n]; const f32x4 b = bsv[mm][bj][n]; const f32x4 a = acc[ai][bj][m][n] * rs;
                            f32x4 v; v[0] = b[0] + bf_lo(t.x) * sigm(a[0]); v[1] = b[1] + bf_hi(t.x) * sigm(a[1]); v[2] = b[2] + bf_lo(t.y) * sigm(a[2]); v[3] = b[3] + bf_hi(t.y) * sigm(a[3]);
                            *(f32x4*)(out + o) = v; u32x2 w; w.x = cvtpk(v[0], v[1]); w.y = cvtpk(v[2], v[3]); *(u32x2*)(hb + o) = w; ss += (v[0] * v[0] + v[1] * v[1]) + (v[2] * v[2] + v[3] * v[3]); }
                    ss = xor_add(ss, lane, 16); ss = xor_add(ss, lane, 32);
                    if (fq == 0) ssp[r * 16 + (u.pn & 3) * 4 + wc] = ss; }
                asm volatile("" ::: "memory");
            }
    }
};
struct SubOrder {
    int j, nsub, n;
    __device__ __forceinline__ bool next(int i, Unit& u) const { if (j < 0) return false; const int L = i * nsub + j; if (L >= n) return false; u.pm = L >> 2; u.pn = L & 3; return true; }
    __device__ __forceinline__ void a_ready(const Unit&) const {}
    __device__ __forceinline__ void done(const Unit&) const {}
};

typedef _Float16 h16x2 __attribute__((ext_vector_type(2)));
__device__ __forceinline__ unsigned pk_f16(float a, float b) { const h16x2 v = {(_Float16)a, (_Float16)b}; return __builtin_bit_cast(unsigned, v); }
__device__ __forceinline__ float f16_lo(unsigned u) { return (float)__builtin_bit_cast(h16x2, u)[0]; }
__device__ __forceinline__ float f16_hi(unsigned u) { return (float)__builtin_bit_cast(h16x2, u)[1]; }
struct EpiResH {
    static constexpr bool PERM = true, AFTER_DRAIN = false;
    const unsigned short* base; unsigned short* out; float* ssp; int ldc; float sc;
    __device__ __forceinline__ void operator()(const f32x4 (&acc)[2][2][4][2], const Unit& u, int wr, int wc, int fr, int fq) const {
        { int z_ = 0; asm volatile("" : "+v"(z_)); const int l_ = (int)__builtin_amdgcn_mbcnt_hi(~0u, __builtin_amdgcn_mbcnt_lo(~0u, (unsigned)z_)); fr = l_ & 15; fq = l_ >> 4; }
        const int row0 = u.pm * BM + wr * 64 + fr, col0 = u.pn * BM + wc * 32 + 8 * fq, lane = fq * 16 + fr;
#pragma unroll
        for (int ai = 0; ai < 2; ++ai)
#pragma unroll
            for (int mp = 0; mp < 2; ++mp) {
                u32x4 bsv[2][2];
#pragma unroll
                for (int mm = 0; mm < 2; ++mm)
#pragma unroll
                    for (int bj = 0; bj < 2; ++bj) bsv[mm][bj] = *(const u32x4*)(base + (size_t)(row0 + ai * HALF + (2 * mp + mm) * 16) * ldc + col0 + bj * HALF);
#pragma unroll
                for (int mm = 0; mm < 2; ++mm) { const int m = 2 * mp + mm; const size_t r = (size_t)(row0 + ai * HALF + m * 16), off = r * ldc + col0; float ss = 0.f;
#pragma unroll
                    for (int bj = 0; bj < 2; ++bj) { const u32x4 b = bsv[mm][bj]; const f32x4 a0 = acc[ai][bj][m][0] * sc, a1 = acc[ai][bj][m][1] * sc;
                        f32x4 v0, v1; v0[0] = f16_lo(b.x) + a0[0]; v0[1] = f16_hi(b.x) + a0[1]; v0[2] = f16_lo(b.y) + a0[2]; v0[3] = f16_hi(b.y) + a0[3];
                        v1[0] = f16_lo(b.z) + a1[0]; v1[1] = f16_hi(b.z) + a1[1]; v1[2] = f16_lo(b.w) + a1[2]; v1[3] = f16_hi(b.w) + a1[3];
                        u32x4 w; w.x = pk_f16(v0[0], v0[1]); w.y = pk_f16(v0[2], v0[3]); w.z = pk_f16(v1[0], v1[1]); w.w = pk_f16(v1[2], v1[3]); *(u32x4*)(out + off + bj * HALF) = w;
                        ss += ((v0[0] * v0[0] + v0[1] * v0[1]) + (v0[2] * v0[2] + v0[3] * v0[3])) + ((v1[0] * v1[0] + v1[1] * v1[1]) + (v1[2] * v1[2] + v1[3] * v1[3])); }
                    ss = xor_add(ss, lane, 16); ss = xor_add(ss, lane, 32);
                    if (fq == 0) ssp[r * 16 + (u.pn & 3) * 4 + wc] = ss; }
                asm volatile("" ::: "memory");
            }
    }
};
struct EpiPleH {
    static constexpr bool PERM = true, AFTER_DRAIN = false;
    const unsigned short* base; unsigned short* out; const bf16_t* PP; float* ssp; int ldc; const PG8_LAS float* tbl;
    __device__ __forceinline__ void operator()(const f32x4 (&acc)[2][2][4][2], const Unit& u, int wr, int wc, int fr, int fq) const {
        { int z_ = 0; asm volatile("" : "+v"(z_)); const int l_ = (int)__builtin_amdgcn_mbcnt_hi(~0u, __builtin_amdgcn_mbcnt_lo(~0u, (unsigned)z_)); fr = l_ & 15; fq = l_ >> 4; }
        const int row0 = u.pm * BM + wr * 64 + fr, col0 = u.pn * BM + wc * 32 + 8 * fq, lane = fq * 16 + fr;
#pragma unroll
        for (int ai = 0; ai < 2; ++ai)
#pragma unroll
            for (int mp = 0; mp < 2; ++mp) {
                u32x4 bsv[2][2], tv[2][2];
#pragma unroll
                for (int mm = 0; mm < 2; ++mm)
#pragma unroll
                    for (int bj = 0; bj < 2; ++bj) { const size_t o = (size_t)(row0 + ai * HALF + (2 * mp + mm) * 16) * ldc + col0 + bj * HALF; bsv[mm][bj] = *(const u32x4*)(base + o); tv[mm][bj] = *(const u32x4*)(PP + o); }
#pragma unroll
                for (int mm = 0; mm < 2; ++mm) { const int m = 2 * mp + mm; const size_t r = (size_t)(row0 + ai * HALF + m * 16), off = r * ldc + col0; float ss = 0.f;
                    const float rs = tbl[wr * 64 + fr + ai * HALF + m * 16];
#pragma unroll
                    for (int bj = 0; bj < 2; ++bj) { const u32x4 t = tv[mm][bj], b = bsv[mm][bj]; const f32x4 a0 = acc[ai][bj][m][0] * rs, a1 = acc[ai][bj][m][1] * rs;
                        f32x4 v0, v1; v0[0] = f16_lo(b.x) + bf_lo(t.x) * sigm(a0[0]); v0[1] = f16_hi(b.x) + bf_hi(t.x) * sigm(a0[1]); v0[2] = f16_lo(b.y) + bf_lo(t.y) * sigm(a0[2]); v0[3] = f16_hi(b.y) + bf_hi(t.y) * sigm(a0[3]);
                        v1[0] = f16_lo(b.z) + bf_lo(t.z) * sigm(a1[0]); v1[1] = f16_hi(b.z) + bf_hi(t.z) * sigm(a1[1]); v1[2] = f16_lo(b.w) + bf_lo(t.w) * sigm(a1[2]); v1[3] = f16_hi(b.w) + bf_hi(t.w) * sigm(a1[3]);
                        u32x4 w; w.x = pk_f16(v0[0], v0[1]); w.y = pk_f16(v0[2], v0[3]); w.z = pk_f16(v1[0], v1[1]); w.w = pk_f16(v1[2], v1[3]); *(u32x4*)(out + off + bj * HALF) = w;
                        ss += ((v0[0] * v0[0] + v0[1] * v0[1]) + (v0[2] * v0[2] + v0[3] * v0[3])) + ((v1[0] * v1[0] + v1[1] * v1[1]) + (v1[2] * v1[2] + v1[3] * v1[3])); }
                    ss = xor_add(ss, lane, 16); ss = xor_add(ss, lane, 32);
                    if (fq == 0) ssp[r * 16 + (u.pn & 3) * 4 + wc] = ss; }
                asm volatile("" ::: "memory");
            }
    }
};

struct EpiBfPlain {
    static constexpr bool PERM = true, AFTER_DRAIN = false;
    bf16_t* O; int ldc;
    __device__ __forceinline__ void operator()(const f32x4 (&acc)[2][2][4][2], const Unit& u, int wr, int wc, int fr, int fq) const {
        { int z_ = 0; asm volatile("" : "+v"(z_)); const int l_ = (int)__builtin_amdgcn_mbcnt_hi(~0u, __builtin_amdgcn_mbcnt_lo(~0u, (unsigned)z_)); fr = l_ & 15; fq = l_ >> 4; }
        const int row0 = u.pm * BM + wr * 64 + fr, col0 = u.pn * BM + wc * 32 + 8 * fq;
#pragma unroll
        for (int ai = 0; ai < 2; ++ai)
#pragma unroll
            for (int m = 0; m < 4; ++m) { bf16_t* rowp = O + (size_t)(row0 + ai * HALF + m * 16) * ldc + col0;
#pragma unroll
                for (int bj = 0; bj < 2; ++bj) { const f32x4 v0 = acc[ai][bj][m][0], v1 = acc[ai][bj][m][1];
                    u32x4 w; w.x = cvtpk(v0[0], v0[1]); w.y = cvtpk(v0[2], v0[3]); w.z = cvtpk(v1[0], v1[1]); w.w = cvtpk(v1[2], v1[3]);
                    *(u32x4*)(rowp + bj * HALF) = w; } }
    }
};

struct EpiZG {
    static constexpr bool PERM = true, AFTER_DRAIN = false;
    bf16_t* O; int ldc; unsigned char* GZ; const PG8_LAS float* tbl;
    __device__ __forceinline__ void operator()(const f32x4 (&acc)[2][2][4][2], const Unit& u, int wr, int wc, int fr, int fq) const {
        const int row0 = u.pm * BM + wr * 64 + fr;
        if (u.pn < 11) { const int col0 = u.pn * BM + wc * 32 + 8 * fq;
#pragma unroll
            for (int ai = 0; ai < 2; ++ai)
#pragma unroll
                for (int m = 0; m < 4; ++m) { const size_t r = (size_t)(row0 + ai * HALF + m * 16); const float s = tbl[wr * 64 + fr + ai * HALF + m * 16]; bf16_t* rowp = O + (size_t)u.pn * ldc + r * 256 + (wc * 32 + 8 * fq);
#pragma unroll
                    for (int bj = 0; bj < 2; ++bj) { const f32x4 v0 = acc[ai][bj][m][0] * s, v1 = acc[ai][bj][m][1] * s;
                        u32x4 w; w.x = cvtpk(v0[0], v0[1]); w.y = cvtpk(v0[2], v0[3]); w.z = cvtpk(v1[0], v1[1]); w.w = cvtpk(v1[2], v1[3]);
                        *(u32x4*)(rowp + bj * HALF) = w; } }
        } else { const int col0 = (u.pn - 11) * BM + wc * 32 + 8 * fq;
#pragma unroll
            for (int ai = 0; ai < 2; ++ai)
#pragma unroll
                for (int m = 0; m < 4; ++m) { const size_t r = (size_t)(row0 + ai * HALF + m * 16); const float s = tbl[wr * 64 + fr + ai * HALF + m * 16]; unsigned char* rowp = GZ + r * 2048 + col0;
#pragma unroll
                    for (int bj = 0; bj < 2; ++bj) { const f32x4 v0 = acc[ai][bj][m][0] * s, v1 = acc[ai][bj][m][1] * s;
                        unsigned q[8];
#pragma unroll
                        for (int i = 0; i < 4; ++i) { q[i] = (unsigned)(sigm(v0[i]) * 255.f + 0.5f); q[4 + i] = (unsigned)(sigm(v1[i]) * 255.f + 0.5f); if (u.pn >= 15) { q[i] = q[i] < 1u ? 1u : q[i]; q[4 + i] = q[4 + i] < 1u ? 1u : q[4 + i]; } }
                        u32x2 w; w.x = q[0] | (q[1] << 8) | (q[2] << 16) | (q[3] << 24); w.y = q[4] | (q[5] << 8) | (q[6] << 16) | (q[7] << 24);
                        *(u32x2*)(rowp + bj * HALF) = w; } }
        }
    }
};
template <int ADD> struct EpiGate8 {
    static constexpr bool PERM = true, AFTER_DRAIN = false;
    bf16_t* O; int ldc; const unsigned char* G; int ldg;
    __device__ __forceinline__ void operator()(const f32x4 (&acc)[2][2][4][2], const Unit& u, int wr, int wc, int fr, int fq) const {
        { int z_ = 0; asm volatile("" : "+v"(z_)); const int l_ = (int)__builtin_amdgcn_mbcnt_hi(~0u, __builtin_amdgcn_mbcnt_lo(~0u, (unsigned)z_)); fr = l_ & 15; fq = l_ >> 4; }
        const int row0 = u.pm * BM + wr * 64 + fr, col0 = u.pn * BM + wc * 32 + 8 * fq;
#pragma unroll
        for (int ai = 0; ai < 2; ++ai) {
            u32x2 g[4][2]; u32x4 p[4][2];
#pragma unroll
            for (int m = 0; m < 4; ++m)
#pragma unroll
                for (int bj = 0; bj < 2; ++bj) { const size_t r = (size_t)(row0 + ai * HALF + m * 16); const int c = col0 + bj * HALF;
                    g[m][bj] = *(const u32x2*)(G + r * ldg + c); if (ADD) p[m][bj] = *(const u32x4*)(O + r * ldc + c); }
#pragma unroll
            for (int m = 0; m < 4; ++m)
#pragma unroll
                for (int bj = 0; bj < 2; ++bj) { const size_t r = (size_t)(row0 + ai * HALF + m * 16); const int c = col0 + bj * HALF;
                    const u32x2 gg = g[m][bj]; f32x4 v0 = acc[ai][bj][m][0], v1 = acc[ai][bj][m][1]; const float k = 1.f / 255.f;
                    v0[0] *= (float)(gg.x & 255u) * k; v0[1] *= (float)((gg.x >> 8) & 255u) * k; v0[2] *= (float)((gg.x >> 16) & 255u) * k; v0[3] *= (float)(gg.x >> 24) * k;
                    v1[0] *= (float)(gg.y & 255u) * k; v1[1] *= (float)((gg.y >> 8) & 255u) * k; v1[2] *= (float)((gg.y >> 16) & 255u) * k; v1[3] *= (float)(gg.y >> 24) * k;
                    if (ADD) { const u32x4 pp = p[m][bj]; v0[0] += bf_lo(pp.x); v0[1] += bf_hi(pp.x); v0[2] += bf_lo(pp.y); v0[3] += bf_hi(pp.y);
                                                      v1[0] += bf_lo(pp.z); v1[1] += bf_hi(pp.z); v1[2] += bf_lo(pp.w); v1[3] += bf_hi(pp.w); }
                    u32x4 w; w.x = cvtpk(v0[0], v0[1]); w.y = cvtpk(v0[2], v0[3]); w.z = cvtpk(v1[0], v1[1]); w.w = cvtpk(v1[2], v1[3]);
                    *(u32x4*)(O + r * ldc + c) = w; }
            asm volatile("" ::: "memory");
        }
    }
};

struct EpiGateM {
    static constexpr bool PERM = true, AFTER_DRAIN = false;
    bf16_t* O; int ldc; const unsigned char* G; int ldg;
    __device__ __forceinline__ void mid(f32x4 (&acc)[2][2][4][2], const Unit& u, int wr, int wc) const {
        int fr, fq; { int z_ = 0; asm volatile("" : "+v"(z_)); const int l_ = (int)__builtin_amdgcn_mbcnt_hi(~0u, __builtin_amdgcn_mbcnt_lo(~0u, (unsigned)z_)); fr = l_ & 15; fq = l_ >> 4; }
        const int row0 = u.pm * BM + wr * 64 + fr, col0 = u.pn * BM + wc * 32 + 8 * fq;
#pragma unroll
        for (int ai = 0; ai < 2; ++ai) {
            u32x2 ga[4][2], gb[4][2];
#pragma unroll
            for (int m = 0; m < 4; ++m)
#pragma unroll
                for (int bj = 0; bj < 2; ++bj) { const unsigned char* gp = G + (size_t)(row0 + ai * HALF + m * 16) * ldg + col0 + bj * HALF; ga[m][bj] = *(const u32x2*)gp; gb[m][bj] = *(const u32x2*)(gp + 1024); }
#pragma unroll
            for (int m = 0; m < 4; ++m)
#pragma unroll
                for (int bj = 0; bj < 2; ++bj) { const u32x2 a = ga[m][bj], b = gb[m][bj];
#define GM_R(w, sh) ((float)(((a.w) >> (sh)) & 255u) * __builtin_amdgcn_rcpf((float)(((b.w) >> (sh)) & 255u)))
                    acc[ai][bj][m][0][0] *= GM_R(x, 0); acc[ai][bj][m][0][1] *= GM_R(x, 8); acc[ai][bj][m][0][2] *= GM_R(x, 16); acc[ai][bj][m][0][3] *= GM_R(x, 24);
                    acc[ai][bj][m][1][0] *= GM_R(y, 0); acc[ai][bj][m][1][1] *= GM_R(y, 8); acc[ai][bj][m][1][2] *= GM_R(y, 16); acc[ai][bj][m][1][3] *= GM_R(y, 24);
#undef GM_R
                }
        }
    }
    __device__ __forceinline__ void operator()(const f32x4 (&acc)[2][2][4][2], const Unit& u, int wr, int wc, int fr, int fq) const {
        { int z_ = 0; asm volatile("" : "+v"(z_)); const int l_ = (int)__builtin_amdgcn_mbcnt_hi(~0u, __builtin_amdgcn_mbcnt_lo(~0u, (unsigned)z_)); fr = l_ & 15; fq = l_ >> 4; }
        const int row0 = u.pm * BM + wr * 64 + fr, col0 = u.pn * BM + wc * 32 + 8 * fq;
#pragma unroll
        for (int ai = 0; ai < 2; ++ai) {
            u32x2 gb[4][2];
#pragma unroll
            for (int m = 0; m < 4; ++m)
#pragma unroll
                for (int bj = 0; bj < 2; ++bj) gb[m][bj] = *(const u32x2*)(G + (size_t)(row0 + ai * HALF + m * 16) * ldg + 1024 + col0 + bj * HALF);
#pragma unroll
            for (int m = 0; m < 4; ++m)
#pragma unroll
                for (int bj = 0; bj < 2; ++bj) { const size_t r = (size_t)(row0 + ai * HALF + m * 16); const int c = col0 + bj * HALF; const u32x2 b = gb[m][bj]; const float k = 1.f / 255.f;
                    f32x4 v0 = acc[ai][bj][m][0], v1 = acc[ai][bj][m][1];
                    v0[0] *= (float)(b.x & 255u) * k; v0[1] *= (float)((b.x >> 8) & 255u) * k; v0[2] *= (float)((b.x >> 16) & 255u) * k; v0[3] *= (float)(b.x >> 24) * k;
                    v1[0] *= (float)(b.y & 255u) * k; v1[1] *= (float)((b.y >> 8) & 255u) * k; v1[2] *= (float)((b.y >> 16) & 255u) * k; v1[3] *= (float)(b.y >> 24) * k;
                    u32x4 w; w.x = cvtpk(v0[0], v0[1]); w.y = cvtpk(v0[2], v0[3]); w.z = cvtpk(v1[0], v1[1]); w.w = cvtpk(v1[2], v1[3]);
                    *(u32x4*)(O + r * ldc + c) = w; }
        }
    }
};
}
constexpr int NWAVES = 8;
constexpr int D = 1024, NB = 4, S = 4096, DEPTH = 4, M = NB * S;
constexpr int HQ = 8, HKV = 2, DH = 64, WIN = 128;
constexpr int HGH = 4, DK = 128, DV = 128;
constexpr int INW = 4864;
constexpr int OFF_AQ = 0, OFF_AK = 512, OFF_AV = 640, OFF_HQ = 768, OFF_HF = 1280, OFF_HI = 1792, OFF_HG = 2304, OFF_GA = 2816, OFF_GB = 3840;
constexpr int ZW = 2816;
constexpr int FD = 2816, NE = 8, FE = 3584, PLE = 256;
constexpr float EPS = 1e-6f;
constexpr int MOE_ROWS = 2 * M + NE * 256;

constexpr size_t MiB = 1u << 20;
constexpr size_t WS_CTL = 0, CTL_ZERO_BYTES = 2 * MiB;
constexpr size_t WS_TBL = 2 * MiB;
constexpr size_t WS_H = 6 * MiB, WS_U = 70 * MiB, WS_Z = 102 * MiB, WS_ZT = 254 * MiB;
constexpr size_t WS_OA = 342 * MiB, WS_OB = 358 * MiB, WS_MG = 374 * MiB, WS_AG = 342 * MiB, WS_Y = 410 * MiB, WS_PB = 478 * MiB, WS_W = 510 * MiB;
constexpr size_t WS_GZ = WS_Z + 96 * MiB;
constexpr size_t WS_U2 = WS_H;
constexpr size_t W_IN = WS_W, W_A = WS_W + 38 * MiB, W_B = WS_W + 42 * MiB, W_OUT = WS_W + 46 * MiB, W_PG = WS_W + 54 * MiB, W_PP = WS_W + 62 * MiB,
                 W_13D = WS_W + 64 * MiB, W_2D = WS_W + 86 * MiB, W_13M = WS_W + 97 * MiB, W_2M = WS_W + 321 * MiB, WS_END = WS_W + 433 * MiB;
static_assert((size_t)DEPTH * INW * D * 2 == 38 * MiB && (size_t)2 * NE * 2 * FE * D * 2 == 224 * MiB && (size_t)2 * NE * FE * D * 2 == 112 * MiB && (size_t)2 * 2 * FD * D * 2 == 22 * MiB, "weight map");
static_assert((size_t)MOE_ROWS * FE * 2 <= 240 * MiB && (size_t)MOE_ROWS * D * 2 <= 68 * MiB && (size_t)M * INW * 2 == 152 * MiB, "activation map");
constexpr int CW_TMO = 0, CW_CODE = 1;
constexpr int CW_BAR = 8192, BAR_STRIDE = 4096, MAX_LAUNCH = 120;
static_assert((CW_BAR + MAX_LAUNCH * BAR_STRIDE) * 4 <= (int)CTL_ZERO_BYTES, "CTL words inside the memset region");

constexpr int RING_OFF = 0, RING_BYTES = 131072;
constexpr int LDSCTL_OFF = RING_BYTES, MISC_OFF = LDSCTL_OFF + 320;
constexpr int LDS_BYTES = 147456;
constexpr int RSTD_OFF = LDSCTL_OFF + 1024;

#define GAS __attribute__((address_space(1)))
#define LAS __attribute__((address_space(3)))
typedef unsigned short bf16;
typedef unsigned v4u __attribute__((ext_vector_type(4)));
typedef unsigned v2u __attribute__((ext_vector_type(2)));
typedef float f32x4 __attribute__((ext_vector_type(4)));
typedef short bf16x8 __attribute__((ext_vector_type(8)));
typedef GAS unsigned gu32;
#define RLX_AGENT __ATOMIC_RELAXED, __HIP_MEMORY_SCOPE_AGENT
#define LDS_WAIT() asm volatile("s_waitcnt lgkmcnt(0)" ::: "memory")
#define VM_WAIT() asm volatile("s_waitcnt vmcnt(0)" ::: "memory")
__device__ __forceinline__ unsigned f2bf(float f) { unsigned u = __builtin_bit_cast(unsigned, f); return (u + 0x7fffu + ((u >> 16) & 1u)) >> 16; }
__device__ __forceinline__ unsigned pk2(float lo, float hi) { return f2bf(lo) | (f2bf(hi) << 16); }
__device__ __forceinline__ float bf2f(bf16 b) { return __uint_as_float((unsigned)b << 16); }
#define XB_TMO      128
#define XB_XCNT(j)  (256  + 64 * (j))
#define XB_XSUB(j)  (1280 + 64 * (j))
#define XB_XGEN(j)  (2304 + 64 * (j))
#define XB_TOP      3328
#define XB_TOPGEN   3392
#define XCD_BAR_WORDS 3456
#define XB_SPIN_CAP (1u << 18)

__device__ __forceinline__ unsigned xb_ld(unsigned* p)              { return __hip_atomic_load(p, __ATOMIC_RELAXED, __HIP_MEMORY_SCOPE_AGENT); }
__device__ __forceinline__ unsigned xb_add(unsigned* p, unsigned v) { return __hip_atomic_fetch_add(p, v, __ATOMIC_RELAXED, __HIP_MEMORY_SCOPE_AGENT); }
__device__ __forceinline__ unsigned xb_xcc_id() { return (unsigned)__builtin_amdgcn_s_getreg((3 << 11) | 20) & 0xFu; }
#define XB_SPIN(cond, bar) do { unsigned _sp = 0; while (cond) { __builtin_amdgcn_s_sleep(1); \
    if ((++_sp & 255u) == 0u) { if (xb_ld(&(bar)[XB_TMO])) break; if (_sp > XB_SPIN_CAP) { atomicAdd(&(bar)[XB_TMO], 1u); break; } } } } while (0)

struct XcdBarrier {
    unsigned* bar; unsigned x;
    volatile LAS unsigned* st;
};

__device__ __forceinline__ XcdBarrier xcd_barrier_post(unsigned* bar, volatile LAS unsigned* st) {
    XcdBarrier b; b.bar = bar; b.x = xb_xcc_id(); b.st = st;
    if (threadIdx.x == 0) (void)xb_add(&bar[XB_XCNT(b.x)], 1u);
    return b;
}
__device__ __forceinline__ void xcd_barrier_complete(unsigned* bar, unsigned x, unsigned& nloc, unsigned& nx) {
    const unsigned G = gridDim.x * gridDim.y * gridDim.z;
    unsigned sum, cnt, mine, sp = 0u;
    for (;;) {
        sum = 0u; cnt = 0u; mine = 0u;
#pragma unroll
        for (unsigned j = 0; j < 16; ++j) { const unsigned c = xb_ld(&bar[XB_XCNT(j)]); sum += c; cnt += (c > 0u) ? 1u : 0u; mine = (j == x) ? c : mine; }
        if (sum == G) break;
        __builtin_amdgcn_s_sleep(1);
        if ((++sp & 255u) == 0u) { if (xb_ld(&bar[XB_TMO])) break; if (sp > XB_SPIN_CAP) { atomicAdd(&bar[XB_TMO], 1u); break; } }
    }
    nloc = mine > 0u ? mine : 1u; nx = cnt > 0u ? cnt : 1u;
}

__device__ __forceinline__ void xcd_barrier(const XcdBarrier& b, int tid  ) {
    asm volatile("s_waitcnt vmcnt(0)" ::: "memory");
    __syncthreads();
    if (tid == 0) {
        unsigned* bar = b.bar; unsigned xq = b.x; asm volatile("" : "+s"(xq));
        __builtin_amdgcn_s_waitcnt(0);
        unsigned nloc = b.st[0], nx = b.st[1];
        if (nloc == 0u) { xcd_barrier_complete(bar, xq, nloc, nx); b.st[0] = nloc; b.st[1] = nx; }
        const unsigned old = xb_add(&bar[XB_XSUB(xq)], 1u);
        const unsigned gen = old / nloc;
        if (old + 1u == (gen + 1u) * nloc) {
            __builtin_amdgcn_fence(__ATOMIC_RELEASE, "agent");
            asm volatile("s_waitcnt vmcnt(0)" ::: "memory");
            const unsigned og = xb_add(&bar[XB_TOP], 1u);
            const unsigned tg = og / nx;
            if (og + 1u == (tg + 1u) * nx) xb_add(&bar[XB_TOPGEN], 1u);
            else XB_SPIN(xb_ld(&bar[XB_TOPGEN]) == tg, bar);
            __builtin_amdgcn_fence(__ATOMIC_ACQUIRE, "agent");
            xb_add(&bar[XB_XGEN(xq)], 1u);
            asm volatile("s_waitcnt vmcnt(0)" ::: "memory");
        } else {
            XB_SPIN(xb_ld(&bar[XB_XGEN(xq)]) == gen, bar);
            __builtin_amdgcn_fence(__ATOMIC_ACQUIRE, "agent");
            asm volatile("s_waitcnt vmcnt(0)" ::: "memory");
        }
    }
    __syncthreads();
}
constexpr size_t T_SSP = 1 << 20, T_SSP2 = 2 << 20;
#define ZIDX(tok, col) ((size_t)((col) >> 8) * ((size_t)M * 256) + (size_t)(tok) * 256 + (size_t)((col) & 255))
struct Args { const float* in[23]; float* out; unsigned char* ws; int ph_lo, ph_hi, li, pad; };
struct Frame {
    LAS unsigned char* lds;
    volatile LAS unsigned* MISC;
    gu32* ctl;
    int tid, lane, wave;
    int vcu, G;
};
__device__ __forceinline__ float wave_sum_n(float v) {
#pragma unroll
    for (int o = 1; o < 64; o <<= 1) v += __shfl_xor(v, o);
    return v;
}
__device__ __forceinline__ float wave_sum(float v, int lane) {
#pragma unroll
    for (int o = 1; o < 64; o <<= 1) v += __builtin_bit_cast(float, __builtin_amdgcn_ds_bpermute((lane ^ o) << 2, __builtin_bit_cast(int, v)));
    return v;
}
template <int MODE, int KL>
__device__ __forceinline__ void p0_cvt_item(const float* W, int K, int N, unsigned char* WT, int il, int which, int item, int lane, const float* gk, float scale, int ldk, int koff) {
    const int nblk = N >> 6, kb = item / nblk, nb = item - kb * nblk, nq = lane & 15, kr = lane >> 4, k0 = 4 * KL * kb + KL * kr, n0 = 64 * nb + 4 * nq;
    const GAS f32x4* src = (const GAS f32x4*)(W + (size_t)k0 * N + n0);
    f32x4 v[KL];
#pragma unroll
    for (int i = 0; i < KL; ++i) v[i] = src[(size_t)i * (N >> 2)];
    if (MODE == 1) {
#pragma unroll
        for (int q = 0; q < KL / 4; ++q) { const f32x4 g = *(const GAS f32x4*)(gk + k0 + 4 * q); v[4 * q] *= g.x; v[4 * q + 1] *= g.y; v[4 * q + 2] *= g.z; v[4 * q + 3] *= g.w; } }
    if (MODE == 2) {
#pragma unroll
        for (int i = 0; i < KL; ++i) v[i] *= scale; }
#pragma unroll
    for (int c = 0; c < 4; ++c) { const int n = n0 + c, row = il ? ((n >> 4) * 32 + which * 16 + (n & 15)) : n;
        if (MODE == 2) { GAS v4u* dst = (GAS v4u*)(WT + (size_t)row * ldk + koff + k0);
#pragma unroll
            for (int q = 0; q < KL / 16; ++q) { v4u o;
                o.x = pg8::pk4_fp8(v[16 * q][c], v[16 * q + 1][c], v[16 * q + 2][c], v[16 * q + 3][c]);     o.y = pg8::pk4_fp8(v[16 * q + 4][c], v[16 * q + 5][c], v[16 * q + 6][c], v[16 * q + 7][c]);
                o.z = pg8::pk4_fp8(v[16 * q + 8][c], v[16 * q + 9][c], v[16 * q + 10][c], v[16 * q + 11][c]); o.w = pg8::pk4_fp8(v[16 * q + 12][c], v[16 * q + 13][c], v[16 * q + 14][c], v[16 * q + 15][c]);
                dst[q] = o; } }
        else { GAS v4u* dst = (GAS v4u*)(WT + ((size_t)row * ldk + koff + k0) * 2);
#pragma unroll
            for (int q = 0; q < KL / 8; ++q) { v4u o;
                if (MODE == 1) { o.x = pg8::pk_f16(v[8 * q][c], v[8 * q + 1][c]); o.y = pg8::pk_f16(v[8 * q + 2][c], v[8 * q + 3][c]); o.z = pg8::pk_f16(v[8 * q + 4][c], v[8 * q + 5][c]); o.w = pg8::pk_f16(v[8 * q + 6][c], v[8 * q + 7][c]); }
                else { o.x = pk2(v[8 * q][c], v[8 * q + 1][c]); o.y = pk2(v[8 * q + 2][c], v[8 * q + 3][c]); o.z = pk2(v[8 * q + 4][c], v[8 * q + 5][c]); o.w = pk2(v[8 * q + 6][c], v[8 * q + 7][c]); }
                dst[q] = o; } } }
}
constexpr int MT_PER = (D / 128) * (FE / 64), MT_SET = 24 * MT_PER;
constexpr int MT_N1 = 3, MT_N4 = 3, MT_G1 = MT_N1 * 64 * NWAVES, MT_G4 = MT_N4 * 128 * NWAVES, MT_TAIL = 2 * MT_G1 + MT_G4;
static_assert(MT_TAIL <= MT_SET, "tile split");
__device__ __forceinline__ void moe_cvt_tile(const Args& a, int set, int id, int lane) {
    const int j = id / MT_PER, item = id - j * MT_PER;
    if (j < 16) { const int e = set * 8 + (j & 7), wh = j >> 3;
        p0_cvt_item<2, 32>(a.in[17 + wh] + (size_t)e * D * FE, D, FE, a.ws + W_13M + (size_t)e * 2 * FE * D, 1, wh, item, lane, nullptr, 32.f, D, 0); }
    else { const int e = set * 8 + (j - 16); p0_cvt_item<2, 32>(a.in[19] + (size_t)e * FE * D, FE, D, a.ws + W_2M + (size_t)e * D * FE, 0, 0, item, lane, nullptr, 64.f, FE, 0); }
}
__device__ __forceinline__ void rms_row_to_bf16(const float* xrow, const float* g, bf16* orow, int lane) {
    const GAS f32x4* xr = (const GAS f32x4*)xrow + lane; const GAS f32x4* gr = (const GAS f32x4*)g + lane;
    f32x4 v[4]; float s = 0.f;
#pragma unroll
    for (int j = 0; j < 4; ++j) { v[j] = xr[64 * j]; s += (v[j].x * v[j].x + v[j].y * v[j].y) + (v[j].z * v[j].z + v[j].w * v[j].w); }
    const float rstd = rsqrtf(wave_sum(s, lane) * (1.f / D) + EPS);
    GAS v2u* o8 = (GAS v2u*)orow + lane;
#pragma unroll
    for (int j = 0; j < 4; ++j) { const f32x4 gg = gr[64 * j]; v2u w; w.x = pk2(v[j].x * rstd * gg.x, v[j].y * rstd * gg.y); w.y = pk2(v[j].z * rstd * gg.z, v[j].w * rstd * gg.w); o8[64 * j] = w; }
}
__device__ __forceinline__ void rms_row_to_f32(const float* xrow, const float* g, float* orow, int lane) {
    const GAS f32x4* xr = (const GAS f32x4*)xrow + lane; const GAS f32x4* gr = (const GAS f32x4*)g + lane;
    f32x4 v[4]; float s = 0.f;
#pragma unroll
    for (int j = 0; j < 4; ++j) { v[j] = xr[64 * j]; s += (v[j].x * v[j].x + v[j].y * v[j].y) + (v[j].z * v[j].z + v[j].w * v[j].w); }
    const float rstd = rsqrtf(wave_sum(s, lane) * (1.f / D) + EPS);
    GAS f32x4* o = (GAS f32x4*)orow + lane;
#pragma unroll
    for (int j = 0; j < 4; ++j) { const f32x4 gg = gr[64 * j]; o[64 * j] = v[j] * rstd * gg; }
}

__device__ __forceinline__ void p0_prologue(Frame& F, const Args& a) {
    const int gw = F.vcu * NWAVES + F.wave, NGW = F.G * NWAVES;
    unsigned char* ws = a.ws;
    constexpr int I_MP = MT_SET - MT_TAIL;
    constexpr int I_IN = (D / 64) * (INW / 64), I_AB = (512 / 64) * (D / 64), I_SQ = (D / 64) * (D / 64), I_PP = (PLE / 64) * (D / 64), I_D1 = (D / 64) * (FD / 64), I_D2 = (FD / 64) * (D / 64);
    constexpr int NITEMS = 2 * I_MP + 4 * I_IN + 8 * I_AB + 8 * I_SQ + 4 * I_PP + 4 * I_D1 + 2 * I_D2;
    for (int it = gw; it < NITEMS; it += NGW) {
        int r = it;
        if (r < 2 * I_MP) { const int set = r / I_MP; moe_cvt_tile(a, set, MT_TAIL + (r - set * I_MP), F.lane); continue; } r -= 2 * I_MP;
        const float* W; const float* gk = nullptr; unsigned char* WT; int K, N, il = 0, wh = 0, ldk, koff = 0, item;
        if (r < 4 * I_IN) { const int l = r / I_IN; item = r - l * I_IN; W = a.in[2] + (size_t)l * D * INW; K = D; N = INW; WT = ws + W_IN + (size_t)l * INW * D * 2; gk = a.in[10] + l * D; ldk = D; }
        else if ((r -= 4 * I_IN) < 4 * I_SQ) { const int l = r / I_SQ; item = r - l * I_SQ; W = a.in[21] + (size_t)l * D * D; K = D; N = D; WT = ws + W_PG + (size_t)l * D * D * 2; gk = a.in[12] + l * D; ldk = D; }
        else if ((r -= 4 * I_SQ) < 4 * I_D1) { const int j = r / I_D1, i = j & 1; wh = j >> 1; item = r - j * I_D1; W = a.in[13 + wh] + (size_t)i * D * FD; K = D; N = FD; WT = ws + W_13D + (size_t)i * 2 * FD * D * 2; gk = a.in[11] + 2 * i * D; ldk = D; il = 1; }
        else if ((r -= 4 * I_D1) < 8 * I_AB) { const int j = r / I_AB, l = j & 3, hb2 = j >> 2; item = r - j * I_AB; W = a.in[7 + hb2] + (size_t)l * 512 * D; K = 512; N = D; WT = ws + W_A + (size_t)l * D * D * 2; ldk = D; koff = 512 * hb2; }
        else if ((r -= 8 * I_AB) < 4 * I_SQ) { const int l = r / I_SQ; item = r - l * I_SQ; W = a.in[9] + (size_t)l * D * D; K = D; N = D; WT = ws + W_OUT + (size_t)l * D * D * 2; ldk = D; }
        else if ((r -= 4 * I_SQ) < 4 * I_PP) { const int l = r / I_PP; item = r - l * I_PP; W = a.in[20] + (size_t)l * PLE * D; K = PLE; N = D; WT = ws + W_PP + (size_t)l * D * PLE * 2; ldk = PLE; }
        else { r -= 4 * I_PP; const int i = r / I_D2; item = r - i * I_D2; W = a.in[15] + (size_t)i * FD * D; K = FD; N = D; WT = ws + W_2D + (size_t)i * D * FD * 2; ldk = FD; }
        if (gk) p0_cvt_item<1, 16>(W, K, N, WT, il, wh, item, F.lane, gk, 1.f, ldk, koff);
        else p0_cvt_item<0, 16>(W, K, N, WT, il, wh, item, F.lane, nullptr, 1.f, ldk, koff);
    }
    if (F.vcu == 0) { const int c = F.tid; const float* lbl = a.in[5]; float* lb = (float*)(ws + WS_TBL);
        float v[DEPTH], mx = -INFINITY, sum = 0.f;
#pragma unroll
        for (int l = 0; l < DEPTH; ++l) { v[l] = lbl[l * 512 + c]; mx = fmaxf(mx, v[l]); }
#pragma unroll
        for (int l = 0; l < DEPTH; ++l) { v[l] = expf(v[l] - mx); sum += v[l]; }
        float cum = 0.f; const float s0 = v[0] / sum;
#pragma unroll
        for (int l = 0; l < DEPTH; ++l) { cum += v[l] / sum; lb[l * 512 + c] = cum - s0; } }
    { float* ssp = (float*)(ws + WS_TBL + T_SSP2); bf16* hb = (bf16*)(ws + WS_U2);
      for (int m = gw; m < M; m += 4 * NGW) { f32x4 v[4][4];
#pragma unroll
          for (int r = 0; r < 4; ++r) { const GAS f32x4* xr = (const GAS f32x4*)(a.in[0] + (size_t)(m + r * NGW) * D) + F.lane;
#pragma unroll
              for (int j = 0; j < 4; ++j) v[r][j] = xr[64 * j]; }
#pragma unroll
          for (int r = 0; r < 4; ++r) { GAS v2u* o8 = (GAS v2u*)(hb + (size_t)(m + r * NGW) * D) + F.lane; float s = 0.f;
#pragma unroll
              for (int j = 0; j < 4; ++j) { const f32x4 x = v[r][j]; s += (x.x * x.x + x.y * x.y) + (x.z * x.z + x.w * x.w); v2u w; w.x = pg8::pk_f16(x.x, x.y); w.y = pg8::pk_f16(x.z, x.w); o8[64 * j] = w; }
              s = wave_sum(s, F.lane); if (F.lane < 16) ssp[(size_t)(m + r * NGW) * 16 + F.lane] = (F.lane == 0) ? s : 0.f; } } }
    { const GAS f32x4* src = (const GAS f32x4*)a.in[1]; GAS v2u* dst = (GAS v2u*)(ws + WS_PB); const size_t n4 = (size_t)DEPTH * M * PLE / 4;
      const size_t st = (size_t)NGW * 64;
      for (size_t i = (size_t)gw * 64 + F.lane; i < n4; i += 16 * st) { f32x4 v[16];
#pragma unroll
          for (int k = 0; k < 16; ++k) v[k] = src[i + k * st];
#pragma unroll
          for (int k = 0; k < 16; ++k) { v2u w; w.x = pk2(v[k].x, v[k].y); w.y = pk2(v[k].z, v[k].w); dst[i + k * st] = w; } } }
}

constexpr size_t T_LB = 0, T_CNT = 16 << 10, T_TOKE = 32 << 10, T_TOKW = 96 << 10, T_POS = 224 << 10, T_ROWW = 352 << 10, T_LISTU = 512 << 10, T_LISTD = 544 << 10, T_NUN = 552 << 10;
constexpr int NT_UP = 2 * FE / 256, NT_DN = D / 256;
typedef int i32x2 __attribute__((ext_vector_type(2)));
typedef int i32x4 __attribute__((ext_vector_type(4)));
typedef float f32x2 __attribute__((ext_vector_type(2)));
__device__ __forceinline__ int ld_agent_i(const int* p) { return (int)__hip_atomic_load((const unsigned*)p, RLX_AGENT); }
__device__ __forceinline__ void moe_tables(LAS int* T, const int* cnt, int G, int wgi, int tid) {
    const int lane = tid & 63, e = tid >> 6;
    int tot = 0, pre = 0;
    for (int t = lane; t < G; t += 64) { const int c = cnt[t * 8 + e]; tot += c; pre += (t < wgi) ? c : 0; }
    const float totf = wave_sum((float)tot, lane), pref = wave_sum((float)pre, lane);
    if (tid < 64) T[tid] = 0;
    __syncthreads();
    if (lane == 0) { T[e] = (int)totf; T[8 + e] = (int)pref; }
    __syncthreads();
    if (tid == 0) { int st = 0, ts = 0;
        for (int e = 0; e < 8; ++e) { const int tl = (T[e] + 255) >> 8; T[16 + e] = st; T[24 + e] = tl; T[32 + e] = ts; st += tl * 256; ts += tl; }
        T[40] = ts; }
    __syncthreads();
}
__device__ __forceinline__ i32x2 moe_unit(const LAS int* T, int L, int NT) {
    i32x2 r = {0, 0};
    for (int e = 0; e < 8; ++e) { const int tl = T[24 + e], ue = tl * NT;
        if (L < ue) { const int nig = 8 * NT, gid = L / nig, fm = gid * 8, gsz = (tl - fm) < 8 ? (tl - fm) : 8; r.x = T[32 + e] + fm + (L % nig) % gsz; r.y = e * NT + (L % nig) / gsz; return r; }
        L -= ue; }
    return r;
}
namespace pg8 {
struct ListOrder {
    const int* list; int n, G, c;
    __device__ __forceinline__ bool next(int i, Unit& u) const {
        const long L = (long)i * G + c; if (L >= n) return false;
        int wgid = (int)L; { const int q = n / NXCD, r = n % NXCD, xcd = wgid % NXCD, off = wgid / NXCD; wgid = (xcd < r ? xcd * (q + 1) : r * (q + 1) + (xcd - r) * q) + off; }
        u.pm = __builtin_amdgcn_readfirstlane(ld_agent_i(list + 2 * wgid)); u.pn = __builtin_amdgcn_readfirstlane(ld_agent_i(list + 2 * wgid + 1)); return true;
    }
    __device__ __forceinline__ void a_ready(const Unit&) const {}
    __device__ __forceinline__ void done(const Unit&) const {}
};
struct ListOrderL {
    const PG8_LAS int* ul; int n, G, c;
    __device__ __forceinline__ bool next(int i, Unit& u) const {
        const long L = (long)i * G + c; if (L >= n) return false;
        u.pm = __builtin_amdgcn_readfirstlane(ul[2 * i]); u.pn = __builtin_amdgcn_readfirstlane(ul[2 * i + 1]); return true;
    }
    __device__ __forceinline__ void a_ready(const Unit&) const {}
    __device__ __forceinline__ void done(const Unit&) const {}
};
}

constexpr int AT_KSTR = 72, AT_VSTR = 260;
constexpr int AT_K_OFF = 0, AT_V_OFF = 256 * AT_KSTR * 2, AT_TB_OFF = AT_V_OFF + 64 * AT_VSTR * 2, AT_LDS_END = AT_TB_OFF + 4 * 384 * 4;
static_assert(AT_LDS_END <= RING_BYTES && AT_V_OFF % 16 == 0 && AT_TB_OFF % 16 == 0, "attention LDS map");
typedef float f32x16 __attribute__((ext_vector_type(16)));
typedef short s16x4 __attribute__((ext_vector_type(4)));
__device__ __forceinline__ int t5_bucket_d(int d) {
    if (d < 16) return d;
    int large = 16 + (int)(logf((float)d / 16.f) / logf(8.f) * 16.f);
    return large < 31 ? large : 31;
}
__device__ __forceinline__ void attn_phase(LAS unsigned char* lds, const bf16* z, const float* sinks_l, const float* rel_bias, bf16* oa, int tid, int vcu, int G) {
    const int lane = tid & 63, wave = __builtin_amdgcn_readfirstlane(tid >> 6), l31 = lane & 31, h2 = lane >> 5;
    LAS bf16* Kt = (LAS bf16*)(lds + AT_K_OFF); LAS bf16* Vt = (LAS bf16*)(lds + AT_V_OFF); LAS float* tb = (LAS float*)(lds + AT_TB_OFF);
    for (int unit = vcu; unit < NB * (S / 128) * HKV; unit += G) {
        const int b = unit >> 6, n = (unit >> 1) & 31, kvh = unit & 1;
        __syncthreads();
        for (int i = tid; i < 4 * 384; i += NWAVES * 64) { const int g = i / 384, dist = i % 384 - 128;
            tb[i] = (dist >= 0 && dist < WIN) ? rel_bias[t5_bucket_d(dist) * HQ + kvh * 4 + g] : -1e30f; }
        v4u kq[4], vq[2][2];
#pragma unroll
        for (int j = 0; j < 4; ++j) { const int idx = tid + 512 * j, row = idx >> 3, ch = idx & 7; const bool valid = (n > 0) || (row >= 128);
            const size_t tok = (size_t)b * S + n * 128 - 128 + row;
            kq[j] = (v4u){0u, 0u, 0u, 0u};
            if (valid) kq[j] = *(const GAS v4u*)(z + ZIDX(tok, OFF_AK + kvh * 64 + ch * 8)); }
#pragma unroll
        for (int j = 0; j < 2; ++j) { const int gq = wave + 8 * j, p = 16 * (gq & 7) + (lane & 15), ch = 4 * (gq >> 3) + (lane >> 4); const bool valid = (n > 0) || (p >= 64);
            const size_t tok = (size_t)b * S + n * 128 - 128 + 2 * p;
            vq[j][0] = (v4u){0u, 0u, 0u, 0u}; vq[j][1] = vq[j][0];
            if (valid) { vq[j][0] = *(const GAS v4u*)(z + ZIDX(tok, OFF_AV + kvh * 64 + ch * 8)); vq[j][1] = *(const GAS v4u*)(z + ZIDX(tok + 1, OFF_AV + kvh * 64 + ch * 8)); } }
#pragma unroll
        for (int j = 0; j < 4; ++j) { const int idx = tid + 512 * j, row = idx >> 3, ch = idx & 7; *(LAS v4u*)(Kt + row * AT_KSTR + ch * 8) = kq[j]; }
#pragma unroll
        for (int j = 0; j < 2; ++j) { const int gq = wave + 8 * j, p = 16 * (gq & 7) + (lane & 15), ch = 4 * (gq >> 3) + (lane >> 4);
            LAS unsigned* vp = (LAS unsigned*)(Vt + (ch * 8) * AT_VSTR + 2 * p); const v4u va = vq[j][0], vb = vq[j][1];
            vp[0 * (AT_VSTR / 2)] = __builtin_amdgcn_perm(vb.x, va.x, 0x05040100u); vp[1 * (AT_VSTR / 2)] = __builtin_amdgcn_perm(vb.x, va.x, 0x07060302u);
            vp[2 * (AT_VSTR / 2)] = __builtin_amdgcn_perm(vb.y, va.y, 0x05040100u); vp[3 * (AT_VSTR / 2)] = __builtin_amdgcn_perm(vb.y, va.y, 0x07060302u);
            vp[4 * (AT_VSTR / 2)] = __builtin_amdgcn_perm(vb.z, va.z, 0x05040100u); vp[5 * (AT_VSTR / 2)] = __builtin_amdgcn_perm(vb.z, va.z, 0x07060302u);
            vp[6 * (AT_VSTR / 2)] = __builtin_amdgcn_perm(vb.w, va.w, 0x05040100u); vp[7 * (AT_VSTR / 2)] = __builtin_amdgcn_perm(vb.w, va.w, 0x07060302u); }
        __syncthreads();
        const int g = wave >> 1, hq = kvh * 4 + g; const float sink = sinks_l[hq];
        for (int s2 = 0; s2 < 2; ++s2) {
            const int sb = (wave & 1) * 2 + s2, q0 = 32 * sb; const size_t qtok = (size_t)b * S + n * 128 + q0 + l31;
            bf16x8 Qf[4];
#pragma unroll
            for (int d0 = 0; d0 < 4; ++d0) Qf[d0] = *(const GAS bf16x8*)(z + ZIDX(qtok, OFF_AQ + hq * 64 + 16 * d0 + 8 * h2));
            f32x16 Sc[5];
#pragma unroll
            for (int i = 0; i < 5; ++i) { f32x16 acc = {0.f, 0.f, 0.f, 0.f, 0.f, 0.f, 0.f, 0.f, 0.f, 0.f, 0.f, 0.f, 0.f, 0.f, 0.f, 0.f};
#pragma unroll
                for (int d0 = 0; d0 < 4; ++d0) { const bf16x8 kf = *(const LAS bf16x8*)(Kt + (32 * (sb + i) + l31) * AT_KSTR + 16 * d0 + 8 * h2); acc = __builtin_amdgcn_mfma_f32_32x32x16_bf16(kf, Qf[d0], acc, 0, 0, 0); }
                Sc[i] = acc; }
            float mx = sink;
#pragma unroll
            for (int i = 0; i < 5; ++i)
#pragma unroll
                for (int r = 0; r < 16; ++r) { const int kj = 32 * (sb + i) + (r & 3) + 8 * (r >> 2) + 4 * h2; float sv = Sc[i][r] * 0.125f + tb[g * 384 + (q0 + l31) + 256 - kj];
                    if (n == 0 && kj < 128) sv = -1e30f; Sc[i][r] = sv; mx = fmaxf(mx, sv); }
            mx = fmaxf(mx, __builtin_bit_cast(float, __builtin_amdgcn_ds_bpermute((lane ^ 32) << 2, __builtin_bit_cast(int, mx))));
            float sum = 0.f;
#pragma unroll
            for (int i = 0; i < 5; ++i)
#pragma unroll
                for (int r = 0; r < 16; ++r) { const float p = __expf(Sc[i][r] - mx); Sc[i][r] = p; sum += p; }
            sum += __builtin_bit_cast(float, __builtin_amdgcn_ds_bpermute((lane ^ 32) << 2, __builtin_bit_cast(int, sum)));
            sum += __expf(sink - mx);
            f32x16 O0 = {0.f, 0.f, 0.f, 0.f, 0.f, 0.f, 0.f, 0.f, 0.f, 0.f, 0.f, 0.f, 0.f, 0.f, 0.f, 0.f}, O1 = O0;
#pragma unroll
            for (int i = 0; i < 5; ++i)
#pragma unroll
                for (int ks = 0; ks < 2; ++ks) {
                    v4u pw; pw.x = pg8::cvtpk(Sc[i][8 * ks + 0], Sc[i][8 * ks + 1]); pw.y = pg8::cvtpk(Sc[i][8 * ks + 2], Sc[i][8 * ks + 3]); pw.z = pg8::cvtpk(Sc[i][8 * ks + 4], Sc[i][8 * ks + 5]); pw.w = pg8::cvtpk(Sc[i][8 * ks + 6], Sc[i][8 * ks + 7]);
                    const bf16x8 pf = __builtin_bit_cast(bf16x8, pw);
                    const int kb = 32 * (sb + i) + 16 * ks + 4 * h2;
                    { const LAS bf16* vp = Vt + l31 * AT_VSTR + kb; const s16x4 a = *(const LAS s16x4*)vp, c = *(const LAS s16x4*)(vp + 8);
                      const bf16x8 vf = {a[0], a[1], a[2], a[3], c[0], c[1], c[2], c[3]}; O0 = __builtin_amdgcn_mfma_f32_32x32x16_bf16(vf, pf, O0, 0, 0, 0); }
                    { const LAS bf16* vp = Vt + (32 + l31) * AT_VSTR + kb; const s16x4 a = *(const LAS s16x4*)vp, c = *(const LAS s16x4*)(vp + 8);
                      const bf16x8 vf = {a[0], a[1], a[2], a[3], c[0], c[1], c[2], c[3]}; O1 = __builtin_amdgcn_mfma_f32_32x32x16_bf16(vf, pf, O1, 0, 0, 0); }
                }
            const float inv = 1.f / sum;
            bf16* orow = oa + qtok * 1024 + hq * 64 + 4 * h2;
#pragma unroll
            for (int rg = 0; rg < 4; ++rg) {
                v2u w0; w0.x = pg8::cvtpk(O0[4 * rg] * inv, O0[4 * rg + 1] * inv); w0.y = pg8::cvtpk(O0[4 * rg + 2] * inv, O0[4 * rg + 3] * inv); *(GAS v2u*)(orow + 8 * rg) = w0;
                v2u w1; w1.x = pg8::cvtpk(O1[4 * rg] * inv, O1[4 * rg + 1] * inv); w1.y = pg8::cvtpk(O1[4 * rg + 2] * inv, O1[4 * rg + 3] * inv); *(GAS v2u*)(orow + 32 + 8 * rg) = w1; }
        }
    }
    __syncthreads();
}

constexpr size_t WS_QC = WS_ZT, WS_OLOC = WS_ZT + 16 * MiB, WS_SEND = WS_ZT + 48 * MiB, WS_DTOT = WS_ZT + 80 * MiB, WS_SINIT = WS_Y;
constexpr int HG_SCL = 256, HG_NSC = S / HG_SCL;
constexpr int H1_QSTR = 136, H1_TSTR = 72;
constexpr int H1_QD = 0, H1_KI = 64 * H1_QSTR * 2, H1_KT = 2 * 64 * H1_QSTR * 2, H1_VT = H1_KT + 128 * H1_TSTR * 2, H1_DC = H1_VT + 128 * H1_TSTR * 2, H1_AL = H1_DC + 2048, H1_RT = H1_AL + 2048, H1_PB = H1_RT + 512, H1_END = H1_PB + 2048;
static_assert(H1_END <= RING_BYTES, "HGRN LDS map");
typedef short s16x4v __attribute__((ext_vector_type(4)));
__device__ __forceinline__ bf16x8 cat8(s16x4v a, s16x4v b) { return (bf16x8){a[0], a[1], a[2], a[3], b[0], b[1], b[2], b[3]}; }
__device__ __forceinline__ s16x4v pack4(f32x4 v) { v2u w; w.x = pg8::cvtpk(v[0], v[1]); w.y = pg8::cvtpk(v[2], v[3]); return __builtin_bit_cast(s16x4v, w); }
__device__ __forceinline__ void hgrn_pass1(LAS unsigned char* lds, unsigned char* ws, const bf16* z, const float* lbl, int tid, int vcu, int G) {
    const int lane = tid & 63, wave = __builtin_amdgcn_readfirstlane(tid >> 6), l15 = lane & 15, q4 = lane >> 4;
    LAS bf16* QD = (LAS bf16*)(lds + H1_QD); LAS bf16* KI = (LAS bf16*)(lds + H1_KI); LAS bf16* KT = (LAS bf16*)(lds + H1_KT); LAS bf16* VT = (LAS bf16*)(lds + H1_VT);
    LAS float* DC = (LAS float*)(lds + H1_DC); LAS float* AL = (LAS float*)(lds + H1_AL); LAS float* RT = (LAS float*)(lds + H1_RT); LAS s16x4v* PB = (LAS s16x4v*)(lds + H1_PB);
    GAS bf16* qc = (GAS bf16*)(ws + WS_QC); GAS bf16* oloc = (GAS bf16*)(ws + WS_OLOC); GAS float* send = (GAS float*)(ws + WS_SEND); GAS float* dtot = (GAS float*)(ws + WS_DTOT);
    const GAS bf16* zg = (const GAS bf16*)z; const GAS float* lblg = (const GAS float*)lbl;
    for (int item = vcu; item < NB * HGH * HG_NSC; item += G) {
        const int sc = item % HG_NSC, hh = (item / HG_NSC) & 3, b = item / (HG_NSC * 4);
        const size_t tok0 = (size_t)b * S + sc * HG_SCL;
        f32x4 St[8];
#pragma unroll
        for (int i = 0; i < 8; ++i) St[i] = (f32x4){0.f, 0.f, 0.f, 0.f};
        __syncthreads();
        if (tid < 128) RT[tid] = 0.f;
        v4u vraw[2]; bf16 qraw[16], fraw[16];
        const float lbv = lblg[hh * 128 + (tid & 127)];
        const int vt2 = 16 * (wave & 1) + (lane & 15), vch = 4 * (wave >> 1) + (lane >> 4);
#define H1_LOAD(hf) do { const size_t tk_ = tok0 + 64 * (hf); \
            _Pragma("unroll") for (int j = 0; j < 2; ++j) vraw[j] = *(const GAS v4u*)(zg + ZIDX(tk_ + 2 * vt2 + j, OFF_HI + hh * 128 + 8 * vch)); \
            _Pragma("unroll") for (int t = 0; t < 16; ++t) { const size_t tq_ = tk_ + 16 * (tid >> 7) + t; fraw[t] = zg[ZIDX(tq_, OFF_HF + hh * 128 + (tid & 127))]; qraw[t] = zg[ZIDX(tq_, OFF_HQ + hh * 128 + (tid & 127))]; } } while (0)
        H1_LOAD(0);
        for (int half = 0; half < HG_SCL / 64; ++half) {
            const size_t tokh = tok0 + 64 * half;
            { const int c = tid >> 7, d = tid & 127;
              float fA[16], EA[16]; float eA = 1.f;
#pragma unroll
              for (int t = 0; t < 16; ++t) { const float f = lbv + (1.f - lbv) * pg8::sigm(bf2f(fraw[t])); eA = fmaxf(eA * f, 1e-30f); fA[t] = f; EA[t] = eA; }
              AL[c * 128 + d] = __logf(eA);
              __syncthreads();
              float base = RT[d];
              for (int cc = 0; cc < c; ++cc) base += AL[cc * 128 + d];
              const float ebase = __expf(base);
              unsigned kw[8], kprev = 0u;
#pragma unroll
              for (int t = 0; t < 16; ++t) { const size_t tok = tokh + 16 * c + t; const float q = bf2f(qraw[t]);
                  const float qd = q * EA[t], ki = (1.f - fA[t]) * __builtin_amdgcn_rcpf(EA[t]);
                  const unsigned qk = pg8::cvtpk(qd, ki); const bf16 kib = (bf16)(qk >> 16);
                  QD[(16 * c + t) * H1_QSTR + d] = (bf16)(qk & 0xffffu); KI[(16 * c + t) * H1_QSTR + d] = kib;
                  if (t & 1) kw[t >> 1] = kprev | (qk & 0xffff0000u); else kprev = qk >> 16;
                  qc[tok * 512 + hh * 128 + d] = (bf16)(pg8::cvtpk(qd * ebase, 0.f) & 0xffffu); }
              { LAS v4u* kt = (LAS v4u*)(KT + d * H1_TSTR + 16 * c); kt[0] = (v4u){kw[0], kw[1], kw[2], kw[3]}; kt[1] = (v4u){kw[4], kw[5], kw[6], kw[7]}; }
              DC[c * 128 + d] = eA;
            }
            { LAS unsigned* vp = (LAS unsigned*)(VT + (8 * vch) * H1_TSTR + 2 * vt2); const v4u va = vraw[0], vb = vraw[1];
              vp[0 * (H1_TSTR / 2)] = __builtin_amdgcn_perm(vb.x, va.x, 0x05040100u); vp[1 * (H1_TSTR / 2)] = __builtin_amdgcn_perm(vb.x, va.x, 0x07060302u);
              vp[2 * (H1_TSTR / 2)] = __builtin_amdgcn_perm(vb.y, va.y, 0x05040100u); vp[3 * (H1_TSTR / 2)] = __builtin_amdgcn_perm(vb.y, va.y, 0x07060302u);
              vp[4 * (H1_TSTR / 2)] = __builtin_amdgcn_perm(vb.z, va.z, 0x05040100u); vp[5 * (H1_TSTR / 2)] = __builtin_amdgcn_perm(vb.z, va.z, 0x07060302u);
              vp[6 * (H1_TSTR / 2)] = __builtin_amdgcn_perm(vb.w, va.w, 0x05040100u); vp[7 * (H1_TSTR / 2)] = __builtin_amdgcn_perm(vb.w, va.w, 0x07060302u); }
            __syncthreads();
            if (half + 1 < HG_SCL / 64) H1_LOAD(half + 1);
            if (tid < 128) { float r = RT[tid]; for (int cc = 0; cc < 4; ++cc) r += AL[cc * 128 + tid]; RT[tid] = r; if (half == HG_SCL / 64 - 1) dtot[(size_t)item * 128 + tid] = __expf(r); }
            if (wave < 4) { const int c = wave; f32x4 PT = {0.f, 0.f, 0.f, 0.f};
                const LAS bf16* qrow = QD + (16 * c + l15) * H1_QSTR; const LAS bf16* krow = KI + (16 * c + l15) * H1_QSTR;
#pragma unroll
                for (int kk = 0; kk < 4; ++kk) { const bf16x8 ka = *(const LAS bf16x8*)(krow + 32 * kk + 8 * q4), qb = *(const LAS bf16x8*)(qrow + 32 * kk + 8 * q4);
                    PT = __builtin_amdgcn_mfma_f32_16x16x32_bf16(ka, qb, PT, 0, 0, 0); }
#pragma unroll
                for (int i = 0; i < 4; ++i) if (4 * q4 + i > l15) PT[i] = 0.f;
                PB[c * 64 + lane] = pack4(PT); }
            __syncthreads();
            const int e0 = 16 * wave;
            for (int c = 0; c < 4; ++c) {
                f32x4 O = {0.f, 0.f, 0.f, 0.f};
                const LAS bf16* qrow = QD + (16 * c + l15) * H1_QSTR;
#pragma unroll
                for (int kk = 0; kk < 4; ++kk) {
                    const bf16x8 sb = cat8(pack4(St[2 * kk]), pack4(St[2 * kk + 1]));
                    const bf16x8 qa = cat8(*(const LAS s16x4v*)(qrow + 32 * kk + 4 * q4), *(const LAS s16x4v*)(qrow + 32 * kk + 16 + 4 * q4));
                    O = __builtin_amdgcn_mfma_f32_16x16x32_bf16(qa, sb, O, 0, 0, 0);
                }
                const s16x4v vf = *(const LAS s16x4v*)(VT + (e0 + l15) * H1_TSTR + 16 * c + 4 * q4);
                O = __builtin_amdgcn_mfma_f32_16x16x16bf16_1k(PB[c * 64 + lane], vf, O, 0, 0, 0);
#pragma unroll
                for (int db = 0; db < 8; ++db) {
                    const s16x4v kf = *(const LAS s16x4v*)(KT + (16 * db + l15) * H1_TSTR + 16 * c + 4 * q4);
                    St[db] = __builtin_amdgcn_mfma_f32_16x16x16bf16_1k(kf, vf, St[db], 0, 0, 0);
                    const f32x4 dc = *(const LAS f32x4*)(DC + c * 128 + 16 * db + 4 * q4);
                    St[db] = St[db] * dc;
                }
#pragma unroll
                for (int i = 0; i < 4; ++i) oloc[(tokh + 16 * c + 4 * q4 + i) * 512 + hh * 128 + e0 + l15] = (bf16)(pg8::cvtpk(O[i], 0.f) & 0xffffu);
            }
            __syncthreads();
        }
#pragma unroll
        for (int db = 0; db < 8; ++db) *(GAS f32x4*)(send + ((size_t)item * 128 + 16 * wave + l15) * 128 + 16 * db + 4 * q4) = St[db];
    }
    __syncthreads();
}
#undef H1_LOAD
__device__ __forceinline__ void hgrn_scan(unsigned char* ws, int tid, int vcu, int G) {
    const float* send = (const float*)(ws + WS_SEND); const float* dtot = (const float*)(ws + WS_DTOT); unsigned* sinit = (unsigned*)(ws + WS_SINIT);
    for (int gid = vcu * (NWAVES * 64) + tid; gid < NB * HGH * 64 * 128; gid += G * NWAVES * 64) {
        const int dp = gid & 63, e = (gid >> 6) & 127, bh = gid >> 13;
        float s0 = 0.f, s1 = 0.f;
#pragma unroll
        for (int sc = 0; sc < HG_NSC - 1; ++sc) { const size_t item = (size_t)bh * HG_NSC + sc;
            const f32x2 av = *(const GAS f32x2*)(send + (item * 128 + e) * 128 + 2 * dp), dv = *(const GAS f32x2*)(dtot + item * 128 + 2 * dp);
            s0 = fmaf(dv.x, s0, av.x); s1 = fmaf(dv.y, s1, av.y);
            sinit[((item + 1) * 128 + e) * 64 + dp] = pk2(s0, s1); }
    }
}
__device__ __forceinline__ void hgrn_pass3(LAS unsigned char* lds, unsigned char* ws, const bf16* z, const float* ng, bf16* ob, int tid, int vcu, int G) {
    const int lane = tid & 63, wave = __builtin_amdgcn_readfirstlane(tid >> 6), l15 = lane & 15, q4 = lane >> 4;
    const bf16* qc = (const bf16*)(ws + WS_QC); const bf16* oloc = (const bf16*)(ws + WS_OLOC); const bf16* sinit = (const bf16*)(ws + WS_SINIT);
    for (int item = vcu; item < NB * HGH * HG_NSC; item += G) {
        const int sc = item % HG_NSC, hh = (item / HG_NSC) & 3, b = item / (HG_NSC * 4);
        constexpr int TB = HG_SCL / 128;
        const size_t tokw = (size_t)b * S + sc * HG_SCL + 16 * TB * wave + l15;
        f32x4 acc[TB][8]; v2u gzv[TB][8]; f32x4 gnv[8];
#pragma unroll
        for (int tb = 0; tb < TB; ++tb)
#pragma unroll
            for (int eb = 0; eb < 8; ++eb) { { const v2u ol = *(const GAS v2u*)(oloc + (tokw + 16 * tb) * 512 + hh * 128 + 16 * eb + 4 * q4); acc[tb][eb] = (f32x4){pg8::bf_lo(ol.x), pg8::bf_hi(ol.x), pg8::bf_lo(ol.y), pg8::bf_hi(ol.y)}; }
                gzv[tb][eb] = *(const GAS v2u*)(z + ZIDX(tokw + 16 * tb, OFF_HG + hh * 128 + 16 * eb + 4 * q4)); }
#pragma unroll
        for (int eb = 0; eb < 8; ++eb) gnv[eb] = *(const GAS f32x4*)(ng + 16 * eb + 4 * q4);
        if (sc > 0) {
            __syncthreads();
            { LAS v4u* SL = (LAS v4u*)lds; const GAS v4u* sg = (const GAS v4u*)(sinit + (size_t)item * 128 * 128);
              v4u t4[4];
#pragma unroll
              for (int i = 0; i < 4; ++i) t4[i] = sg[tid + 512 * i];
#pragma unroll
              for (int i = 0; i < 4; ++i) { const int idx = tid + 512 * i, row = idx >> 4, ch = idx & 15; SL[row * 17 + ch] = t4[i]; } }
            __syncthreads();
            bf16x8 bq[TB][4];
#pragma unroll
            for (int tb = 0; tb < TB; ++tb)
#pragma unroll
                for (int kk = 0; kk < 4; ++kk) bq[tb][kk] = *(const GAS bf16x8*)(qc + (tokw + 16 * tb) * 512 + hh * 128 + 32 * kk + 8 * q4);
#pragma unroll
            for (int eb = 0; eb < 8; ++eb)
#pragma unroll
                for (int kk = 0; kk < 4; ++kk) { const bf16x8 sa = *(const LAS bf16x8*)(lds + ((16 * eb + l15) * 17 + 4 * kk + q4) * 16);
#pragma unroll
                    for (int tb = 0; tb < TB; ++tb) acc[tb][eb] = __builtin_amdgcn_mfma_f32_16x16x32_bf16(sa, bq[tb][kk], acc[tb][eb], 0, 0, 0); }
        }
#pragma unroll
        for (int tb = 0; tb < TB; ++tb) { const size_t tok = tokw + 16 * tb;
            float ss = 0.f;
#pragma unroll
            for (int eb = 0; eb < 8; ++eb) {
                ss += (acc[tb][eb][0] * acc[tb][eb][0] + acc[tb][eb][1] * acc[tb][eb][1]) + (acc[tb][eb][2] * acc[tb][eb][2] + acc[tb][eb][3] * acc[tb][eb][3]); }
            ss += __builtin_bit_cast(float, __builtin_amdgcn_ds_bpermute((lane ^ 16) << 2, __builtin_bit_cast(int, ss)));
            ss += __builtin_bit_cast(float, __builtin_amdgcn_ds_bpermute((lane ^ 32) << 2, __builtin_bit_cast(int, ss)));
            const float r = rsqrtf(ss * (1.f / DV) + EPS);
#pragma unroll
            for (int eb = 0; eb < 8; ++eb) { const int e = 16 * eb + 4 * q4;
                const f32x4 gn = gnv[eb]; const v2u gz = gzv[tb][eb];
                const float g0 = pg8::bf_lo(gz.x), g1 = pg8::bf_hi(gz.x), g2 = pg8::bf_lo(gz.y), g3 = pg8::bf_hi(gz.y);
                v2u w; w.x = pg8::cvtpk(acc[tb][eb][0] * r * gn[0] * pg8::silu(g0), acc[tb][eb][1] * r * gn[1] * pg8::silu(g1)); w.y = pg8::cvtpk(acc[tb][eb][2] * r * gn[2] * pg8::silu(g2), acc[tb][eb][3] * r * gn[3] * pg8::silu(g3));
                *(GAS v2u*)(ob + tok * 1024 + hh * 128 + e) = w; } }
    }
}
constexpr int PH_PRO = 0, PH_L0 = 1, PH_PER_LAYER = 16, PH_FINAL = PH_L0 + DEPTH * PH_PER_LAYER, PH_END = PH_FINAL + 1;
constexpr int P_N1 = 0, P_G1 = 1, P_ATT = 2, P_SCAN = 3, P_HG3 = 4, P_G2 = 5, P_G3 = 6, P_N2 = 7, P_R2 = 8, P_G4 = 9, P_G5 = 10, P_CMB = 11, P_N3 = 12, P_G6 = 13, P_G6B = 14;

__global__ void __launch_bounds__(NWAVES * 64, 2) mk_fwd(Args args) {
    extern __shared__ __attribute__((aligned(16))) unsigned char lds[];
    Frame F;
    F.lds = (LAS unsigned char*)lds;
    F.MISC = (volatile LAS unsigned*)(F.lds + MISC_OFF);
    F.tid = threadIdx.x; F.lane = F.tid & 63; F.wave = __builtin_amdgcn_readfirstlane(F.tid >> 6);
    F.G = gridDim.x; { const int bx = blockIdx.x; F.vcu = (F.G % 8 == 0) ? (bx % 8) * (F.G / 8) + bx / 8 : bx; }
    const Args* ap = (const Args*)__builtin_amdgcn_kernarg_segment_ptr();
    unsigned char* ws = ap->ws;
    F.ctl = (gu32*)(ws + WS_CTL);
    for (int u = F.tid; u < (LDS_BYTES - LDSCTL_OFF) / 4; u += NWAVES * 64) ((LAS unsigned*)(F.lds + LDSCTL_OFF))[u] = 0u;
    __syncthreads();
    XcdBarrier bar = xcd_barrier_post((unsigned*)(F.ctl + CW_BAR) + ap->li * BAR_STRIDE, F.MISC + 8);
    int lo = ap->ph_lo, hi = ap->ph_hi;
#define OPQ_RANGE() asm volatile("" : "+s"(lo), "+s"(hi), "+s"(ws), "+s"(ap))
#define IN(k) (lo <= (k) && (k) < hi)
#define SEAM(k) do { if (hi > (k) + 1) { OPQ_LANE(); xcd_barrier(bar, tidv); } } while (0)
#define ROWLOOP(m) int m = gw; asm volatile("" : "+s"(m)); for (; m < M; m += NGW)
#define OPQ_LANE() int z_ = 0; asm volatile("" : "+v"(z_)); const int ln = (int)__builtin_amdgcn_mbcnt_hi(~0u, __builtin_amdgcn_mbcnt_lo(~0u, (unsigned)z_)); const int tidv = F.wave * 64 + ln; (void)tidv; int bix = blockIdx.x; asm volatile("" : "+s"(bix)); (void)bix

    const int gw = F.vcu * NWAVES + F.wave, NGW = F.G * NWAVES;
#define RSTD_TBL(So, sspp) LAS float* rtb = (LAS float*)(F.lds + RSTD_OFF); int tpm; { pg8::Unit u0{0, 0}; (void)So.next(0, u0); tpm = u0.pm; if (ln + 64 * F.wave < 256) rtb[tidv] = pg8::row_rstd((sspp), (size_t)tpm * 256 + tidv); __syncthreads(); }
#define ULIST_FILL(listp, nn) LAS int* ulp = (LAS int*)(F.lds + LDSCTL_OFF + 4096); { const int i_ = ln + 64 * F.wave; if (i_ < 32) { const long L_ = (long)i_ * F.G + bix; if (L_ < (nn)) { int w_ = (int)L_; \
        { const int q_ = (nn) / 8, r_ = (nn) % 8, x_ = w_ % 8, o_ = w_ / 8; w_ = (x_ < r_ ? x_ * (q_ + 1) : r_ * (q_ + 1) + (x_ - r_) * q_) + o_; } ulp[2 * i_] = ld_agent_i((listp) + 2 * w_); ulp[2 * i_ + 1] = ld_agent_i((listp) + 2 * w_ + 1); } } __syncthreads(); }
#define WSPTRS() bf16* const un = (bf16*)(ws + WS_OA + 34 * MiB); (void)un;     \
    unsigned short* const hx = (unsigned short*)(ws + WS_U2); unsigned short* const hy = (unsigned short*)(ws + WS_U); (void)hx; (void)hy; bf16* const ub = (bf16*)(ws + WS_U); bf16* const zb = (bf16*)(ws + WS_Z); bf16* const oa = (bf16*)(ws + WS_OA); bf16* const ob = (bf16*)(ws + WS_OA) + 512; bf16* const mg = (bf16*)(ws + WS_MG); \
    (void)ub; (void)zb; (void)oa; (void)ob; (void)mg

    if (IN(PH_PRO)) { p0_prologue(F, *ap); SEAM(PH_PRO); }

    for (int l = 0; l < DEPTH; ++l) {
        OPQ_RANGE();
        WSPTRS();
        const int pb = PH_L0 + l * PH_PER_LAYER;
        if (IN(pb + P_G1)) {
            OPQ_LANE();
            if (bix >= 192) {
                const int rk = (bix - 192) * NWAVES + F.wave, id0 = (l & 1) ? MT_G1 + MT_G4 : 0;
                for (int k = 0; k < MT_N1; ++k) moe_cvt_tile(*ap, l >> 1, id0 + rk + k * (64 * NWAVES), ln); }
            pg8::Gemm g{(const bf16*)(ws + WS_U2), (const bf16*)(ws + W_IN) + (size_t)l * INW * D, M, INW, D}; pg8::StaticOrder So; So.init(M, INW, F.G, bix);
            RSTD_TBL(So, (const float*)(ws + WS_TBL + T_SSP2));
            pg8::EpiZG E{zb, M * 256, (unsigned char*)(ws + WS_GZ), rtb};     (void)tpm;
            pg8::gemm_phase<pg8::EpiZG, pg8::StaticOrder, true, true, 2>(F.lds + RING_OFF, g, So, E, tidv);
            SEAM(pb + P_G1);
        }
        if (IN(pb + P_ATT)) {
            OPQ_LANE();
            attn_phase(F.lds + RING_OFF, zb, ap->in[3] + l * HQ, ap->in[4], oa, tidv, F.vcu, F.G);
            hgrn_pass1(F.lds + RING_OFF, ws, zb, (const float*)(ws + WS_TBL + T_LB) + l * 512, tidv, F.vcu, F.G);
            SEAM(pb + P_ATT);
        }
        if (IN(pb + P_SCAN)) {
            OPQ_LANE();
            hgrn_scan(ws, tidv, F.vcu, F.G);
            SEAM(pb + P_SCAN);
        }
        if (IN(pb + P_HG3)) {
            OPQ_LANE();
            hgrn_pass3(F.lds + RING_OFF, ws, zb, ap->in[6] + l * DV, ob, tidv, F.vcu, F.G);
            SEAM(pb + P_HG3);
        }
        if (IN(pb + P_G2)) {
            OPQ_LANE();
            pg8::StaticOrder So; So.init(M, D, F.G, bix);
            { pg8::Gemm g{oa, (const bf16*)(ws + W_A) + (size_t)l * D * D, M, D, D};
              pg8::EpiGateM E{mg, D, (const unsigned char*)(ws + WS_GZ), 2 * D};
              pg8::gemm_phase<pg8::EpiGateM, pg8::StaticOrder, true, true, 0, true>(F.lds + RING_OFF, g, So, E, tidv); }
            SEAM(pb + P_G2);
        }
        if (IN(pb + P_G3)) {
            OPQ_LANE();
            pg8::Gemm g{mg, (const bf16*)(ws + W_OUT) + (size_t)l * D * D, M, D, D}; pg8::StaticOrder So; So.init(M, D, F.G, bix);
            pg8::EpiResH E{hx, hy, (float*)(ws + WS_TBL + T_SSP), D, 1.f};
            pg8::gemm_phase<pg8::EpiResH, pg8::StaticOrder, true, true>(F.lds + RING_OFF, g, So, E, tidv);
            SEAM(pb + P_G3);
        }
        if (IN(pb + P_N2)) {
            if (l & 1) {
                OPQ_LANE();
                LAS int* T = (LAS int*)(F.lds + RING_OFF);
                if (tidv < 8) T[tidv] = 0;
                __syncthreads();
                const float* rw = ap->in[16] + (size_t)(l >> 1) * D * NE; const float* gn = ap->in[11] + l * D;
                LAS f32x4* RW = (LAS f32x4*)(F.lds + RING_OFF + 1024);
#pragma unroll
                for (int i = 0; i < 4; ++i) { const int j = tidv + 512 * i, k = j >> 1;
                    RW[((((k >> 8) * 4 + (k & 3)) * 2 + (j & 1)) << 6) + ((k >> 2) & 63)] = ((const GAS f32x4*)rw)[j]; }
                f32x4 gv[4];
#pragma unroll
                for (int q = 0; q < 4; ++q) gv[q] = ((const GAS f32x4*)gn)[ln + 64 * q];
                __syncthreads();
                const int tpw = M / F.G / NWAVES;
                int* toke = (int*)(ws + WS_TBL + T_TOKE); f32x2* tokw = (f32x2*)(ws + WS_TBL + T_TOKW);
                const int tw0 = (F.vcu * NWAVES + F.wave) * tpw;
                v2u hn[2][4];
#pragma unroll
                for (int r = 0; r < 2; ++r) { const GAS v2u* xr = (const GAS v2u*)(hy + (size_t)(tw0 + r) * D) + ln;
#pragma unroll
                    for (int q = 0; q < 4; ++q) hn[r][q] = xr[64 * q]; }
                for (int j = 0; j < tpw; j += 2) {
                    const int t0 = tw0 + j;
                    f32x4 v[2][4]; float ss[2] = {0.f, 0.f};
#pragma unroll
                    for (int r = 0; r < 2; ++r)
#pragma unroll
                        for (int q = 0; q < 4; ++q) { const v2u hv = hn[r][q]; v[r][q] = (f32x4){pg8::f16_lo(hv.x), pg8::f16_hi(hv.x), pg8::f16_lo(hv.y), pg8::f16_hi(hv.y)}; }
                    if (j + 2 < tpw) {
#pragma unroll
                        for (int r = 0; r < 2; ++r) { const GAS v2u* xr = (const GAS v2u*)(hy + (size_t)(t0 + 2 + r) * D) + ln;
#pragma unroll
                            for (int q = 0; q < 4; ++q) hn[r][q] = xr[64 * q]; } }
#pragma unroll
                    for (int r = 0; r < 2; ++r) {
#pragma unroll
                        for (int q = 0; q < 4; ++q) ss[r] += (v[r][q].x * v[r][q].x + v[r][q].y * v[r][q].y) + (v[r][q].z * v[r][q].z + v[r][q].w * v[r][q].w); }
                    float rstd[2]; rstd[0] = rsqrtf(wave_sum(ss[0], ln) * (1.f / D) + EPS); rstd[1] = rsqrtf(wave_sum(ss[1], ln) * (1.f / D) + EPS);
                    float lg[2][8];
#pragma unroll
                    for (int r = 0; r < 2; ++r)
#pragma unroll
                        for (int e = 0; e < 8; ++e) lg[r][e] = 0.f;
#pragma unroll
                    for (int q = 0; q < 4; ++q) { f32x4 uu[2];
#pragma unroll
                        for (int r = 0; r < 2; ++r) { uu[r] = v[r][q] * rstd[r] * gv[q]; ((GAS unsigned*)((unsigned char*)un + (size_t)(t0 + r) * D) + ln)[64 * q] = pg8::pk4_fp8(uu[r].x, uu[r].y, uu[r].z, uu[r].w); }
                        const LAS f32x4* wr4 = RW + q * 512 + ln;
#pragma unroll
                        for (int c = 0; c < 4; ++c) { const f32x4 w0 = wr4[128 * c], w1 = wr4[128 * c + 64];
#pragma unroll
                            for (int r = 0; r < 2; ++r) { const float xv = uu[r][c];
                                lg[r][0] = fmaf(xv, w0.x, lg[r][0]); lg[r][1] = fmaf(xv, w0.y, lg[r][1]); lg[r][2] = fmaf(xv, w0.z, lg[r][2]); lg[r][3] = fmaf(xv, w0.w, lg[r][3]);
                                lg[r][4] = fmaf(xv, w1.x, lg[r][4]); lg[r][5] = fmaf(xv, w1.y, lg[r][5]); lg[r][6] = fmaf(xv, w1.z, lg[r][6]); lg[r][7] = fmaf(xv, w1.w, lg[r][7]); } } }
#pragma unroll
                    for (int r = 0; r < 2; ++r)
#pragma unroll
                        for (int e = 0; e < 8; ++e) lg[r][e] = wave_sum(lg[r][e], ln);
#pragma unroll
                    for (int r = 0; r < 2; ++r) {
                        int i1 = 0; float v1 = lg[r][0];
#pragma unroll
                        for (int e = 1; e < 8; ++e) if (lg[r][e] > v1) { v1 = lg[r][e]; i1 = e; }
                        int i2 = -1; float v2 = -INFINITY;
#pragma unroll
                        for (int e = 0; e < 8; ++e) if (e != i1 && lg[r][e] > v2) { v2 = lg[r][e]; i2 = e; }
                        const float e2 = __expf(v2 - v1), w1g = 1.f / (1.f + e2), w2g = e2 / (1.f + e2);
                        if (ln == 0) { toke[t0 + r] = i1 | (i2 << 8); tokw[t0 + r] = (f32x2){w1g, w2g}; atomicAdd((int*)&T[i1], 1); atomicAdd((int*)&T[i2], 1); } }
                }
                __syncthreads();
                if (tidv < 8) ((int*)(ws + WS_TBL + T_CNT))[F.vcu * 8 + tidv] = T[tidv];
            }
            if (l & 1) SEAM(pb + P_N2);
        }
        if (IN(pb + P_R2)) {
            if (l & 1) {
                OPQ_LANE();
                LAS int* T = (LAS int*)(F.lds + RING_OFF);
                moe_tables(T, (const int*)(ws + WS_TBL + T_CNT), F.G, F.vcu, tidv);
                const int tpg = M / F.G;
                const int* toke = (const int*)(ws + WS_TBL + T_TOKE); const f32x2* tokw = (const f32x2*)(ws + WS_TBL + T_TOKW);
                i32x2* posg = (i32x2*)(ws + WS_TBL + T_POS); float* roww = (float*)(ws + WS_TBL + T_ROWW);
                bf16* ag = (bf16*)(ws + WS_AG);
                LAS int* P = T + 64;
                if (F.wave == 0) {
                    for (int t0 = 0; t0 < tpg; t0 += 64) {
                        const int tl = t0 + ln, t = F.vcu * tpg + tl; const bool ok = tl < tpg;
                        const int ee = ok ? toke[t] : 0x0808; const int e1 = ee & 255, e2 = ee >> 8;
                        int p1 = 0, p2 = 0;
#pragma unroll
                        for (int e = 0; e < 8; ++e) { const unsigned long long mk = __ballot(ok && (e1 == e || e2 == e)); const int rk = __popcll(mk & ((1ull << ln) - 1ull));
                            const int base = T[16 + e] + T[8 + e] + T[48 + e];
                            if (e1 == e) p1 = base + rk; if (e2 == e) p2 = base + rk;
                            if (ln == 0) T[48 + e] += __popcll(mk); }
                        if (ok) { P[2 * tl] = p1; P[2 * tl + 1] = p2; posg[t] = (i32x2){p1, p2}; const f32x2 w = tokw[t]; roww[p1] = w.x; roww[p2] = w.y; }
                    }
                }
                __syncthreads();
                for (int r0 = F.wave; r0 < 2 * tpg; r0 += 16 * NWAVES) {
                    v4u a4[16]; int pp[16];
#pragma unroll
                    for (int k = 0; k < 16; ++k) { const int r = r0 + k * NWAVES, t = F.vcu * tpg + (r >> 1); pp[k] = P[r]; a4[k] = ((const GAS v4u*)((const unsigned char*)un + (size_t)t * D))[ln]; }
#pragma unroll
                    for (int k = 0; k < 16; ++k) ((GAS v4u*)((unsigned char*)ag + (size_t)pp[k] * D))[ln] = a4[k];
                }
                if (F.vcu < 8) {
                    const int e = F.vcu, r0 = T[16 + e] + T[e], r1 = T[16 + e] + T[24 + e] * 256;
                    for (int r = r0 + F.wave; r < r1; r += NWAVES) { GAS v2u* dst = (GAS v2u*)((unsigned char*)ag + (size_t)r * D) + ln; dst[0] = (v2u){0u, 0u}; dst[64] = (v2u){0u, 0u}; if (ln == 0) roww[r] = 0.f; }
                }
                if (F.vcu == 8 % F.G) {
                    const int nu = T[40] * NT_UP, nd = T[40] * NT_DN;
                    i32x2* lu = (i32x2*)(ws + WS_TBL + T_LISTU); i32x2* ld = (i32x2*)(ws + WS_TBL + T_LISTD);
                    for (int L = tidv; L < nu; L += NWAVES * 64) lu[L] = moe_unit(T, L, NT_UP);
                    for (int L = tidv; L < nd; L += NWAVES * 64) ld[L] = moe_unit(T, L, NT_DN);
                    if (tidv == 0) { ((int*)(ws + WS_TBL + T_NUN))[0] = nu; ((int*)(ws + WS_TBL + T_NUN))[1] = nd; }
                }
                __syncthreads();
            }
            if (l & 1) SEAM(pb + P_R2);
        }
        if (IN(pb + P_G4)) {
            OPQ_LANE();
            if (l & 1) {
                OPQ_LANE();
                const int nu = __builtin_amdgcn_readfirstlane(ld_agent_i((const int*)(ws + WS_TBL + T_NUN)));
                pg8::Gemm g{(const bf16*)(ws + WS_AG), (const bf16*)(ws + W_13M + (size_t)(l >> 1) * NE * 2 * FE * D), MOE_ROWS, NE * 2 * FE, D / 2};
                ULIST_FILL((const int*)(ws + WS_TBL + T_LISTU), nu);
                pg8::ListOrderL So{ulp, nu, F.G, bix};
                pg8::EpiSwiglu8 E{(unsigned char*)zb, FE, NT_UP, 1.f / 32.f};
                pg8::gemm_phase<pg8::EpiSwiglu8, pg8::ListOrderL, true, true, true>(F.lds + RING_OFF, g, So, E, tidv);
            }
            if ((l & 1) == 0) {
                if (bix >= 128) { const int rk = (bix - 128) * NWAVES + F.wave;
                    for (int k = 0; k < MT_N4; ++k) moe_cvt_tile(*ap, l >> 1, MT_G1 + rk + k * (128 * NWAVES), ln); }
                { OPQ_LANE();
                  const int nun = (M / 256) * (2 * FD / 256), nfull = nun / F.G, nbusy = nun - nfull * F.G, nsub = F.G - nbusy;
                  pg8::SubOrder Sp{nsub > 0 ? (bix >= nbusy ? bix - nbusy : -1) : bix, nsub > 0 ? nsub : F.G, (M / 256) * (D / 256)};
                  int kple = PLE; asm volatile("" : "+s"(kple));
                  pg8::Gemm gp{(const bf16*)(ws + WS_PB) + (size_t)l * M * PLE, (const bf16*)(ws + W_PP) + (size_t)l * D * PLE, M, D, kple};
                  pg8::EpiBfPlain Ep{mg, D};
                  pg8::gemm_phase<pg8::EpiBfPlain, pg8::SubOrder, true, true>(F.lds + RING_OFF, gp, Sp, Ep, tidv); }
                OPQ_LANE();
                pg8::Gemm g{ub, (const bf16*)(ws + W_13D) + (size_t)(l >> 1) * 2 * FD * D, M, 2 * FD, D}; pg8::StaticOrder So; So.init(M, 2 * FD, F.G, bix);
                RSTD_TBL(So, (const float*)(ws + WS_TBL + T_SSP));
                pg8::EpiSwigluN E{zb, FD, (const float*)(ws + WS_TBL + T_SSP), rtb, tpm};
                pg8::gemm_phase<pg8::EpiSwigluN, pg8::StaticOrder, true, true, 2>(F.lds + RING_OFF, g, So, E, tidv);

            }
            SEAM(pb + P_G4);
        }
        if (IN(pb + P_G5)) {
            OPQ_LANE();
            if (l & 1) {
                { OPQ_LANE(); const int nd = __builtin_amdgcn_readfirstlane(ld_agent_i((const int*)(ws + WS_TBL + T_NUN) + 1));
                  const int nfull = nd / F.G, nbusy = nd - nfull * F.G, nsub = F.G - nbusy;
                  pg8::SubOrder Sp{nsub > 0 ? (bix >= nbusy ? bix - nbusy : -1) : bix, nsub > 0 ? nsub : F.G, (M / 256) * (D / 256)};
                  int kple = PLE; asm volatile("" : "+s"(kple));
                  pg8::Gemm gp{(const bf16*)(ws + WS_PB) + (size_t)l * M * PLE, (const bf16*)(ws + W_PP) + (size_t)l * D * PLE, M, D, kple};
                  pg8::EpiBfPlain Ep{mg, D};
                  pg8::gemm_phase<pg8::EpiBfPlain, pg8::SubOrder, true, true>(F.lds + RING_OFF, gp, Sp, Ep, tidv); }
                { OPQ_LANE(); const int nd = __builtin_amdgcn_readfirstlane(ld_agent_i((const int*)(ws + WS_TBL + T_NUN) + 1));
                  pg8::Gemm g{zb, (const bf16*)(ws + W_2M + (size_t)(l >> 1) * NE * D * FE), MOE_ROWS, NE * D, FE / 2};
                  ULIST_FILL((const int*)(ws + WS_TBL + T_LISTD), nd);
                  pg8::ListOrderL So{ulp, nd, F.G, bix};
                  pg8::EpiMoeDown E{(bf16*)(ws + WS_Y), D, (const float*)(ws + WS_TBL + T_ROWW), NT_DN, 1.f / 256.f};
                  pg8::gemm_phase<pg8::EpiMoeDown, pg8::ListOrderL, true, true, true>(F.lds + RING_OFF, g, So, E, tidv); }

            }
            if ((l & 1) == 0) {
                OPQ_LANE();
                pg8::Gemm g{zb, (const bf16*)(ws + W_2D) + (size_t)(l >> 1) * D * FD, M, D, FD}; pg8::StaticOrder So; So.init(M, D, F.G, bix);
                pg8::EpiResH E{hy, hy, (float*)(ws + WS_TBL + T_SSP), D, 1.f};
                pg8::gemm_phase<pg8::EpiResH, pg8::StaticOrder, true, true>(F.lds + RING_OFF, g, So, E, tidv);
            }
            SEAM(pb + P_G5);
        }
        if (IN(pb + P_CMB)) {
            if (l & 1) {
                OPQ_LANE();
                const bf16* Y = (const bf16*)(ws + WS_Y); const int* posg = (const int*)(ws + WS_TBL + T_POS);
                int gwo = gw; asm volatile("" : "+s"(gwo));
                const int pr = gwo + (ln & 7) * NGW; const int p1v = ld_agent_i(posg + 2 * pr), p2v = ld_agent_i(posg + 2 * pr + 1);
                for (int k0 = 0; k0 < M / NGW; k0 += 4) {
                    v2u hv[4][4], ya[4][4], yb[4][4];
#pragma unroll
                    for (int r = 0; r < 4; ++r) { const int p1 = __builtin_amdgcn_readlane(p1v, k0 + r), p2 = __builtin_amdgcn_readlane(p2v, k0 + r);
                        const GAS v2u* xr = (const GAS v2u*)(hy + (size_t)(gwo + (k0 + r) * NGW) * D) + ln;
                        const GAS v2u* y1 = (const GAS v2u*)(Y + (size_t)p1 * D) + ln; const GAS v2u* y2 = (const GAS v2u*)(Y + (size_t)p2 * D) + ln;
#pragma unroll
                        for (int q = 0; q < 4; ++q) { hv[r][q] = xr[64 * q]; ya[r][q] = y1[64 * q]; yb[r][q] = y2[64 * q]; } }
#pragma unroll
                    for (int r = 0; r < 4; ++r) { const int mr = gwo + (k0 + r) * NGW; float ss = 0.f; f32x4 v[4];
#pragma unroll
                        for (int q = 0; q < 4; ++q) { const v2u h = hv[r][q], a = ya[r][q], b = yb[r][q];
                            v[q].x = pg8::f16_lo(h.x) + (pg8::bf_lo(a.x) + pg8::bf_lo(b.x)); v[q].y = pg8::f16_hi(h.x) + (pg8::bf_hi(a.x) + pg8::bf_hi(b.x));
                            v[q].z = pg8::f16_lo(h.y) + (pg8::bf_lo(a.y) + pg8::bf_lo(b.y)); v[q].w = pg8::f16_hi(h.y) + (pg8::bf_hi(a.y) + pg8::bf_hi(b.y));
                            ss += (v[q].x * v[q].x + v[q].y * v[q].y) + (v[q].z * v[q].z + v[q].w * v[q].w); }
                        ss = wave_sum(ss, ln);
                        GAS v2u* o8 = (GAS v2u*)(ub + (size_t)mr * D) + ln;
#pragma unroll
                        for (int q = 0; q < 4; ++q) { v2u w; w.x = pg8::pk_f16(v[q].x, v[q].y); w.y = pg8::pk_f16(v[q].z, v[q].w); o8[64 * q] = w; }
                        if (ln < 16) ((float*)(ws + WS_TBL + T_SSP))[(size_t)mr * 16 + ln] = (ln == 0) ? ss : 0.f; }
                }
            }
            if (l & 1) SEAM(pb + P_CMB);
        }
        if (IN(pb + P_G6)) {
            OPQ_LANE();
            pg8::StaticOrder So; So.init(M, D, F.G, bix);
            { pg8::Gemm g{ub, (const bf16*)(ws + W_PG) + (size_t)l * D * D, M, D, D};
              RSTD_TBL(So, (const float*)(ws + WS_TBL + T_SSP)); (void)tpm;
              pg8::EpiPleH E{hy, hx, mg, (float*)(ws + WS_TBL + T_SSP2), D, rtb};
              pg8::gemm_phase<pg8::EpiPleH, pg8::StaticOrder, true, true, 2>(F.lds + RING_OFF, g, So, E, tidv); }
            SEAM(pb + P_G6B);
        }
    }
    OPQ_RANGE();
    if (IN(PH_FINAL)) {
        WSPTRS();
        OPQ_LANE();
        { int m = gw; asm volatile("" : "+s"(m)); const GAS f32x4* gr = (const GAS f32x4*)ap->in[22] + ln;
          for (; m < M; m += 2 * NGW) { f32x4 v[2][4]; float ss[2] = {0.f, 0.f};
#pragma unroll
              for (int r = 0; r < 2; ++r) { const GAS v2u* xr = (const GAS v2u*)(hx + (size_t)(m + r * NGW) * D) + ln;
#pragma unroll
                  for (int q = 0; q < 4; ++q) { const v2u hv = xr[64 * q]; v[r][q] = (f32x4){pg8::f16_lo(hv.x), pg8::f16_hi(hv.x), pg8::f16_lo(hv.y), pg8::f16_hi(hv.y)}; } }
#pragma unroll
              for (int r = 0; r < 2; ++r) {
#pragma unroll
                  for (int q = 0; q < 4; ++q) ss[r] += (v[r][q].x * v[r][q].x + v[r][q].y * v[r][q].y) + (v[r][q].z * v[r][q].z + v[r][q].w * v[r][q].w);
                  const float rstd = rsqrtf(wave_sum(ss[r], ln) * (1.f / D) + EPS); GAS f32x4* o = (GAS f32x4*)(ap->out + (size_t)(m + r * NGW) * D) + ln;
#pragma unroll
                  for (int q = 0; q < 4; ++q) o[64 * q] = v[r][q] * rstd * gr[64 * q]; } } }
    }
#undef IN
#undef SEAM
#undef OPQ_LANE
#undef ROWLOOP
#undef OPQ_RANGE
#undef WSPTRS
#undef ULIST_FILL
#undef RSTD_TBL
}

extern "C" void kernel_launch(void* const* d_in, const int* in_sizes, int n_in, void* d_out, int out_size, void* d_ws, size_t ws_size, hipStream_t stream) {
    static int grid = 0;
    if (grid == 0) {
        if (n_in != 23 || out_size != M * D || ws_size < WS_END) { fprintf(stderr, "kernel_launch: unexpected sizes (n_in %d out %d ws %zu need %zu)\n", n_in, out_size, ws_size, (size_t)WS_END); grid = -1; return; }
        int dev = 0, cus = 0, per_cu = 0;
        if (hipGetDevice(&dev) != hipSuccess || hipDeviceGetAttribute(&cus, hipDeviceAttributeMultiprocessorCount, dev) != hipSuccess) { grid = -1; return; }
        if (hipFuncSetAttribute((const void*)mk_fwd, hipFuncAttributeMaxDynamicSharedMemorySize, LDS_BYTES) != hipSuccess) { fprintf(stderr, "hipFuncSetAttribute failed\n"); grid = -1; return; }
        if (hipOccupancyMaxActiveBlocksPerMultiprocessor(&per_cu, (const void*)mk_fwd, NWAVES * 64, LDS_BYTES) != hipSuccess || per_cu < 1) { fprintf(stderr, "occupancy query: %d\n", per_cu); }
        (void)hipGetLastError();
        if (cus != 256) { fprintf(stderr, "kernel_launch: built for a 256-CU device (one workgroup per CU; the unit deal and the row-rstd tables assume it), found %d CUs; nothing launched\n", cus); grid = -1; return; }
        grid = cus;
    }
    if (grid < 0) return;
    if (hipMemsetAsync((char*)d_ws + WS_CTL, 0, CTL_ZERO_BYTES, stream) != hipSuccess) return;
    Args a{};
    for (int i = 0; i < 23; ++i) a.in[i] = (const float*)d_in[i];
    a.out = (float*)d_out; a.ws = (unsigned char*)d_ws;
    int li = 0;
    auto run = [&](int lo, int hi) { a.ph_lo = lo; a.ph_hi = hi; a.li = li++; hipLaunchKernelGGL(mk_fwd, dim3(grid), dim3(NWAVES * 64), LDS_BYTES, stream, a); };

    run(PH_PRO, PH_END);
}
```
